# Optimizing an MI355X kernel written in HIP

```python
import jax
import jax.numpy as jnp
from jax import lax
import numpy as np

D_MODEL = 1024
BATCH = 8
SEQ = 8192
DEPTH = 1

D_RNN = 1024
RNN_BLOCKS = 8
RNN_BW = D_RNN // RNN_BLOCKS
CONV_WIDTH = 4
LRU_C = 8.0
HEAD_DIM = 128
HEADS_PER_GROUP = 4
ATTN_GROUPS = ((128, 1), (512, 4), (2048, 16))
N_GROUPS = 3
ATTN_WIDTH = HEADS_PER_GROUP * HEAD_DIM
ROPE_THETA = 500000.0
ROPE_DIM = HEAD_DIM // 4
ATTN_BLK = 64
NEG_INF = -1e30
D_IN = 2 * D_RNN + 3 * N_GROUPS * ATTN_WIDTH + 2 * D_MODEL
N_EXPERTS = 16
CAPACITY_FACTOR = 2
D_FF = 2048
RMS_EPS = 1e-6

kernel_name = 'hybrid_rglru_dilated_attn_ec_moe'


def _rmsnorm(x, g):
    xf = x.astype(jnp.float32)
    y = xf * lax.rsqrt(jnp.mean(xf * xf, axis=-1, keepdims=True) + RMS_EPS)
    return (y * g.astype(jnp.float32)).astype(x.dtype)


def _split_points():
    widths = [D_RNN, D_RNN] + [ATTN_WIDTH] * (3 * N_GROUPS) + [D_MODEL, D_MODEL]
    pts, acc = [], 0
    for w in widths[:-1]:
        acc += w
        pts.append(acc)
    return pts


def _centred_depthwise_conv(x, w, b):
    S = x.shape[1]
    left = CONV_WIDTH // 2
    right = CONV_WIDTH - 1 - left
    xp = jnp.pad(x, ((0, 0), (left, right), (0, 0)))
    y = b
    for tap in range(CONV_WIDTH):
        y = y + w[tap] * xp[:, tap:tap + S]
    return y


def _linear_scan_combine(earlier, later):
    a1, b1 = earlier
    a2, b2 = later
    return a1 * a2, a2 * b1 + b2


def _rg_lru(x, w_gates, b_gates, lam, reverse):
    B, S, C = x.shape
    xb = x.reshape(B, S, RNN_BLOCKS, RNN_BW)
    gates = jnp.einsum('bsni,gnij->gbsnj', xb, w_gates).reshape(2, B, S, C)
    gates = gates.astype(jnp.float32) + b_gates.astype(jnp.float32)[:, None, None, :]
    r = jax.nn.sigmoid(gates[0])
    i = jax.nn.sigmoid(gates[1])
    log_a = -LRU_C * r * jax.nn.softplus(-lam.astype(jnp.float32))
    a = jnp.exp(log_a)
    u = x.astype(jnp.float32) * i * jnp.sqrt(-jnp.expm1(2.0 * log_a))
    _, h = lax.associative_scan(_linear_scan_combine, (a, u), axis=1, reverse=reverse)
    return h


def _rotary_tables(S):
    pos = jnp.arange(S, dtype=jnp.float32)
    inv = ROPE_THETA ** (-jnp.arange(0, ROPE_DIM, 2, dtype=jnp.float32) / ROPE_DIM)
    ang = pos[:, None] * inv[None, :]
    return jnp.cos(ang), jnp.sin(ang)


def _partial_rotary(t, cos, sin):
    half = ROPE_DIM // 2
    tf = t.astype(jnp.float32)
    x1, x2, rest = tf[..., :half], tf[..., half:ROPE_DIM], tf[..., ROPE_DIM:]
    c = cos[None, :, None, :]
    s = sin[None, :, None, :]
    out = jnp.concatenate([x1 * c - x2 * s, x2 * c + x1 * s, rest], axis=-1)
    return out.astype(t.dtype)


def _dilated_window_attention(q, k, v, radius, dilation):
    B, S, H, Dh = q.shape
    L = S // dilation
    nblk = -(-L // ATTN_BLK)
    Lp = nblk * ATTN_BLK

    def split(t):
        return t.reshape(B, L, dilation, H, Dh).transpose(0, 2, 3, 1, 4)

    qb = jnp.pad(split(q), ((0, 0), (0, 0), (0, 0), (0, Lp - L), (0, 0)))
    qb = qb.reshape(B, dilation, H, nblk, ATTN_BLK, Dh)

    def windows(t):
        tp = jnp.pad(split(t), ((0, 0), (0, 0), (0, 0), (ATTN_BLK, ATTN_BLK + Lp - L), (0, 0)))
        tp = tp.reshape(B, dilation, H, nblk + 2, ATTN_BLK, Dh)
        return jnp.concatenate([tp[:, :, :, :-2], tp[:, :, :, 1:-1], tp[:, :, :, 2:]], axis=4)

    kw = windows(k)
    vw = windows(v)
    s = jnp.einsum('brhnqd,brhnkd->brhnqk', qb, kw).astype(jnp.float32) * (Dh ** -0.5)
    jq = jnp.arange(nblk)[:, None] * ATTN_BLK + jnp.arange(ATTN_BLK)[None, :]
    jk = (jnp.arange(nblk)[:, None] - 1) * ATTN_BLK + jnp.arange(3 * ATTN_BLK)[None, :]
    rel = jk[:, None, :] - jq[:, :, None]
    valid = (jnp.abs(rel) <= radius) & (jk[:, None, :] >= 0) & (jk[:, None, :] < L)
    s = jnp.where(valid, s, NEG_INF)
    m = jnp.max(s, axis=-1, keepdims=True)
    p = jnp.exp(s - m)
    l = jnp.sum(p, axis=-1, keepdims=True)
    o = jnp.einsum('brhnqk,brhnkd->brhnqd', p, vw.astype(jnp.float32)) / l
    lse = (m + jnp.log(l))[..., 0]

    def merge(t):
        t = t.reshape((B, dilation, H, Lp) + t.shape[5:])[:, :, :, :L]
        t = jnp.moveaxis(t, 3, 1)
        return t.reshape((B, S, H) + t.shape[4:])

    return merge(o), merge(lse)


def _mixer_sublayer(x, cos, sin, norm_g, w_in, b_in, conv_w, conv_b, rg_w, rg_b, rg_lambda,
                    p_rnn, p_attn, w_out):
    B, S, _ = x.shape
    h = _rmsnorm(x, norm_g)
    proj = jnp.einsum('bsd,de->bse', h, w_in) + b_in
    parts = jnp.split(proj, _split_points(), axis=-1)
    xr, gr = parts[0], parts[1]
    q_parts = parts[2:2 + N_GROUPS]
    k_parts = parts[2 + N_GROUPS:2 + 2 * N_GROUPS]
    v_parts = parts[2 + 2 * N_GROUPS:2 + 3 * N_GROUPS]
    gate_a, gate_b = parts[-2], parts[-1]

    xc = _centred_depthwise_conv(xr, conv_w, conv_b)
    h_rnn = (_rg_lru(xc, rg_w[0], rg_b[0], rg_lambda[0], False)
             + _rg_lru(xc, rg_w[1], rg_b[1], rg_lambda[1], True))
    y_rnn = (jax.nn.gelu(gr.astype(jnp.float32)) * h_rnn).astype(x.dtype)
    branch_a = jnp.einsum('bsc,cd->bsd', y_rnn, p_rnn)

    outs, lses = [], []
    for g, (window, dilation) in enumerate(ATTN_GROUPS):
        shp = (B, S, HEADS_PER_GROUP, HEAD_DIM)
        q = _partial_rotary(q_parts[g].reshape(shp), cos, sin)
        k = _partial_rotary(k_parts[g].reshape(shp), cos, sin)
        v = v_parts[g].reshape(shp)
        o, lse = _dilated_window_attention(q, k, v, window // (2 * dilation), dilation)
        outs.append(o)
        lses.append(lse)
    wts = jax.nn.softmax(jnp.stack(lses, axis=0), axis=0)
    o = jnp.sum(wts[..., None] * jnp.stack(outs, axis=0), axis=0)
    y_attn = o.reshape(B, S, ATTN_WIDTH).astype(x.dtype)
    branch_b = jnp.einsum('bsc,cd->bsd', y_attn, p_attn)

    merged = jax.nn.sigmoid(gate_a) * branch_a + jax.nn.sigmoid(gate_b) * branch_b
    return x + jnp.einsum('bsd,de->bse', merged, w_out)


def _expert_choice_sublayer(x, norm_g, w_router, b_router, w_gate, w_up, w_down):
    B, S, _ = x.shape
    h = _rmsnorm(x, norm_g)
    logits = jnp.einsum('bsd,de->bse', h, w_router).astype(jnp.float32) + b_router.astype(jnp.float32)
    aff = jax.nn.softmax(logits, axis=-1)
    cap = CAPACITY_FACTOR * S // N_EXPERTS
    gates, idx = lax.top_k(jnp.swapaxes(aff, 1, 2), cap)
    bidx = jnp.arange(B)[:, None, None]
    xg = h[bidx, idx]
    hid = jax.nn.silu(jnp.einsum('becd,edf->becf', xg, w_gate)) * jnp.einsum('becd,edf->becf', xg, w_up)
    eo = jnp.einsum('becf,efd->becd', hid, w_down) * gates[..., None].astype(x.dtype)
    y = jnp.zeros_like(x).at[bidx, idx].add(eo)
    return x + y


def setup_inputs(seed: int = 0) -> dict:
    key = jax.random.key(seed)
    ks = jax.random.split(key, 20)
    f32 = jnp.float32
    nrm = lambda k, shape, scale: jax.random.normal(k, shape, f32) * scale
    u = jax.random.uniform(ks[8], (DEPTH, 2, D_RNN), f32, 0.9, 0.999)
    s_init = u ** (1.0 / LRU_C)
    return {
        'x': jax.random.normal(ks[0], (BATCH, SEQ, D_MODEL), f32),
        'norm_mix': 1.0 + nrm(ks[1], (DEPTH, D_MODEL), 0.05),
        'w_in': nrm(ks[2], (DEPTH, D_MODEL, D_IN), D_MODEL ** -0.5),
        'b_in': nrm(ks[3], (DEPTH, D_IN), 0.02),
        'conv_w': nrm(ks[4], (DEPTH, CONV_WIDTH, D_RNN), CONV_WIDTH ** -0.5),
        'conv_b': nrm(ks[5], (DEPTH, D_RNN), 0.02),
        'rg_w': nrm(ks[6], (DEPTH, 2, 2, RNN_BLOCKS, RNN_BW, RNN_BW), RNN_BW ** -0.5),
        'rg_b': nrm(ks[7], (DEPTH, 2, 2, D_RNN), 0.02),
        'rg_lambda': jnp.log(s_init) - jnp.log1p(-s_init),
        'p_rnn': nrm(ks[9], (DEPTH, D_RNN, D_MODEL), D_RNN ** -0.5),
        'p_attn': nrm(ks[10], (DEPTH, ATTN_WIDTH, D_MODEL), ATTN_WIDTH ** -0.5),
        'w_out': nrm(ks[11], (DEPTH, D_MODEL, D_MODEL), D_MODEL ** -0.5),
        'norm_ffn': 1.0 + nrm(ks[12], (DEPTH, D_MODEL), 0.05),
        'w_router': nrm(ks[13], (DEPTH, D_MODEL, N_EXPERTS), D_MODEL ** -0.5),
        'b_router': nrm(ks[14], (DEPTH, N_EXPERTS), 0.01),
        'w_gate': nrm(ks[15], (DEPTH, N_EXPERTS, D_MODEL, D_FF), D_MODEL ** -0.5),
        'w_up': nrm(ks[16], (DEPTH, N_EXPERTS, D_MODEL, D_FF), D_MODEL ** -0.5),
        'w_down': nrm(ks[17], (DEPTH, N_EXPERTS, D_FF, D_MODEL), D_FF ** -0.5),
        'norm_final': 1.0 + nrm(ks[18], (D_MODEL,), 0.05),
    }


def reference(x, norm_mix, w_in, b_in, conv_w, conv_b, rg_w, rg_b, rg_lambda, p_rnn, p_attn,
              w_out, norm_ffn, w_router, b_router, w_gate, w_up, w_down, norm_final):
    cos, sin = _rotary_tables(x.shape[1])
    for layer in range(DEPTH):
        x = _mixer_sublayer(x, cos, sin, norm_mix[layer], w_in[layer], b_in[layer],
                            conv_w[layer], conv_b[layer], rg_w[layer], rg_b[layer],
                            rg_lambda[layer], p_rnn[layer], p_attn[layer], w_out[layer])
        x = _expert_choice_sublayer(x, norm_ffn[layer], w_router[layer], b_router[layer],
                                    w_gate[layer], w_up[layer], w_down[layer])
    return _rmsnorm(x, norm_final)
```

```cpp
#include <hip/hip_runtime.h>
#include <cstdio>
#include <cstdint>

#define GAS __attribute__((address_space(1)))
#define LAS __attribute__((address_space(3)))

namespace pg8 {
#define PG8_LAS __attribute__((address_space(3)))
typedef unsigned short bf16_t;
typedef short bf16x8 __attribute__((ext_vector_type(8)));
typedef float f32x4 __attribute__((ext_vector_type(4)));
typedef unsigned u32x4 __attribute__((ext_vector_type(4)));
constexpr int BM = 256, BK = 64, HALF = 128, HTB = HALF * BK * 2  , STAGE_BYTES = 8 * HTB, NXCD = 8, WGM = 8;

__host__ __device__ __forceinline__ int lds_byte(int r, int c) { const int st = (r >> 4) * 2 + (c >> 5), rr = r & 15, cc = c & 31, ob = rr * 64 + cc * 2; return st * 1024 + (ob ^ (((ob >> 9) & 1) << 5)); }
__host__ __device__ __forceinline__ void stage_rc(int b, int& R, int& C) { const int st = b / 1024, sb = b % 1024, swz = sb ^ (((sb >> 9) & 1) << 5); R = (st >> 1) * 16 + swz / 64; C = (st & 1) * 32 + (swz % 64) / 2; }
__host__ __device__ __forceinline__ int perm32(int rho) { const int n = rho >> 4, i = rho & 15; return 8 * (i >> 2) + 4 * n + (i & 3); }

struct Unit { int pm, pn; };
struct Gemm { const bf16_t* A; const bf16_t* Bt; int M, N, K; };

struct StaticOrder {
    int nM, nN, nwg, G, c;
    __host__ __device__ void init(int M, int N, int G_, int c_) { nM = M / BM; nN = N / BM; nwg = nM * nN; G = G_; c = c_; }
    __host__ __device__ bool next(int i, Unit& u) const {
        const long L = (long)i * G + c; if (L >= nwg) return false;
        int wgid = (int)L; { const int q = nwg / NXCD, r = nwg % NXCD, xcd = wgid % NXCD, off = wgid / NXCD; wgid = (xcd < r ? xcd * (q + 1) : r * (q + 1) + (xcd - r) * q) + off; }
        const int nig = WGM * nN, gid = wgid / nig, fm = gid * WGM, gsz = (nM - fm) < WGM ? (nM - fm) : WGM;
        u.pm = fm + ((wgid % nig) % gsz); u.pn = (wgid % nig) / gsz; return true;
    }
    __device__ __forceinline__ void a_ready(const Unit&) const {}
    __device__ __forceinline__ void done(const Unit&) const {}
};

__device__ __forceinline__ unsigned cvt_pk_bf16(float lo, float hi) { unsigned r; asm volatile("v_cvt_pk_bf16_f32 %0, %1, %2" : "=v"(r) : "v"(lo), "v"(hi)); return r; }
typedef float f32x2 __attribute__((ext_vector_type(2)));
template <class Epi, class Sched, bool ALIGN_EPI = false, bool SP2 = false>
__device__ __forceinline__ void gemm_phase(PG8_LAS unsigned char* lds, const Gemm g, const Sched& S, const Epi& E) {
    int tid_ = threadIdx.x; asm volatile("" : "+v"(tid_));
    const int tid = tid_, wid = __builtin_amdgcn_readfirstlane(tid >> 6), lane = tid & 63, wr = wid >> 2, wc = wid & 3, fr = lane & 15, fq = lane >> 4;
    const int K = g.K, nt = K / BK;
    unsigned voffA[2], voffB[2];
#pragma unroll
    for (int i = 0; i < 2; ++i) { int R, C; stage_rc(tid * 16 + i * 8192, R, C); const int Rb = Epi::PERM ? ((R & ~31) + perm32(R & 31)) : R;
        voffA[i] = (unsigned)(R * K + C) * 2u; voffB[i] = (unsigned)(Rb * K + C) * 2u; }
    const size_t kstep = (size_t)(BK * 2);
    const size_t hstep = (size_t)HALF * K * 2;
    const size_t tstep = 2 * hstep;
    const unsigned ldsw = (unsigned)wid * 1024u;
    const int aoff = lds_byte(wr * 64 + fr, fq * 8), boff = lds_byte(wc * 32 + fr, fq * 8);
#define PG8_SA(b, h) (((b) * 2 + (h)) * HTB)
#define PG8_SB(b, h) ((4 + (b) * 2 + (h)) * HTB)
#define PG8_STAGE(bufoff, gbase, voff) do { _Pragma("unroll") for (int _i = 0; _i < 2; ++_i) \
        __builtin_amdgcn_global_load_lds((const unsigned*)((const char*)(gbase) + (voff)[_i]), (PG8_LAS unsigned*)(lds + (bufoff) + ldsw + _i * 8192), 16, 0, 0); } while (0)
#define PG8_LDA(dst, b, h) do { _Pragma("unroll") for (int m = 0; m < 4; ++m) _Pragma("unroll") for (int k = 0; k < 2; ++k) dst[m][k] = *(const PG8_LAS bf16x8*)(lds + PG8_SA(b, h) + aoff + m * 2048 + k * 1024); } while (0)
#define PG8_LDB(dst, b, h) do { _Pragma("unroll") for (int n = 0; n < 2; ++n) _Pragma("unroll") for (int k = 0; k < 2; ++k) dst[n][k] = *(const PG8_LAS bf16x8*)(lds + PG8_SB(b, h) + boff + n * 2048 + k * 1024); } while (0)
#define PG8_MMA(ai, bj, At, Bt) do { __builtin_amdgcn_s_setprio(1); _Pragma("unroll") for (int m = 0; m < 4; ++m) _Pragma("unroll") for (int n = 0; n < 2; ++n) _Pragma("unroll") for (int k = 0; k < 2; ++k) \
        acc[ai][bj][m][n] = __builtin_amdgcn_mfma_f32_16x16x32_bf16(Bt[n][k], At[m][k], acc[ai][bj][m][n], 0, 0, 0); __builtin_amdgcn_s_setprio(0); } while (0)
#define PG8_WAIT_V(n) asm volatile("s_waitcnt vmcnt(" #n ")" ::: "memory")
#define PG8_WAIT_L(n) asm volatile("s_waitcnt lgkmcnt(" #n ")" ::: "memory")
#define PG8_BAR __builtin_amdgcn_s_barrier()
#define PG8_SCHED __builtin_amdgcn_sched_barrier(0)
    Unit cur, nxt; int ui = 0;
    if (!S.next(0, cur)) return;
    f32x4 acc[2][2][4][2];
#pragma unroll
    for (int a = 0; a < 2; ++a)
#pragma unroll
        for (int b = 0; b < 2; ++b)
#pragma unroll
            for (int m = 0; m < 4; ++m)
#pragma unroll
                for (int n = 0; n < 2; ++n) acc[a][b][m][n] = (f32x4){0.f, 0.f, 0.f, 0.f};
    bf16x8 At[4][2], B0[2][2], B1[2][2];
    const char* cA = (const char*)g.A + (size_t)cur.pm * tstep; const char* cB = (const char*)g.Bt + (size_t)cur.pn * tstep;
    S.a_ready(cur);
    if constexpr (SP2) {
        PG8_STAGE(PG8_SB(0, 0), cB, voffB); PG8_STAGE(PG8_SB(0, 1), cB + hstep, voffB); PG8_STAGE(PG8_SA(0, 0), cA, voffA); PG8_STAGE(PG8_SA(0, 1), cA + hstep, voffA);
        if (wr == 1) PG8_BAR;
        PG8_WAIT_V(2); PG8_BAR;
        PG8_STAGE(PG8_SB(1, 0), cB + kstep, voffB); PG8_STAGE(PG8_SA(1, 0), cA + kstep, voffA); PG8_STAGE(PG8_SB(1, 1), cB + hstep + kstep, voffB);
        PG8_WAIT_V(6); PG8_BAR;
    } else {
        PG8_STAGE(PG8_SB(0, 0), cB, voffB); PG8_STAGE(PG8_SA(0, 0), cA, voffA); PG8_STAGE(PG8_SB(0, 1), cB + hstep, voffB); PG8_STAGE(PG8_SA(0, 1), cA + hstep, voffA);
        if (wr == 1) PG8_BAR;
        PG8_WAIT_V(4); PG8_BAR;
        PG8_STAGE(PG8_SB(1, 0), cB + kstep, voffB); PG8_STAGE(PG8_SA(1, 0), cA + kstep, voffA); PG8_STAGE(PG8_SB(1, 1), cB + hstep + kstep, voffB);
        PG8_WAIT_V(6); PG8_BAR;
    }
    for (;;) {
        const bool has_next = S.next(ui + 1, nxt);
        const char* nA = has_next ? (const char*)g.A + (size_t)nxt.pm * tstep : cA; const char* nB = has_next ? (const char*)g.Bt + (size_t)nxt.pn * tstep : cB;
        for (int t = 0; t < nt; t += 2) {
            const bool last = (t == nt - 2);
            const char* a1 = cA + (size_t)(t + 1) * kstep;
            const char* a2 = last ? nA : cA + (size_t)(t + 2) * kstep; const char* b2 = last ? nB : cB + (size_t)(t + 2) * kstep;
            const char* a3 = a2 + kstep; const char* b3 = b2 + kstep;
            if (last && has_next) S.a_ready(nxt);
            if constexpr (SP2) {
            PG8_LDB(B0, 0, 0); PG8_LDB(B1, 0, 1); PG8_SCHED; PG8_LDA(At, 0, 0); PG8_STAGE(PG8_SA(1, 1), a1 + hstep, voffA);
            PG8_WAIT_V(8); PG8_WAIT_L(0); PG8_BAR; PG8_MMA(0, 0, At, B0); PG8_MMA(0, 1, At, B1); PG8_BAR; PG8_SCHED;
            PG8_LDA(At, 0, 1); PG8_STAGE(PG8_SB(0, 0), b2, voffB); PG8_STAGE(PG8_SB(0, 1), b2 + hstep, voffB); PG8_STAGE(PG8_SA(0, 0), a2, voffA);
            PG8_WAIT_V(8); PG8_WAIT_L(0); PG8_BAR; PG8_MMA(1, 0, At, B0); PG8_MMA(1, 1, At, B1); PG8_BAR; PG8_SCHED;
            PG8_LDB(B0, 1, 0); PG8_LDB(B1, 1, 1); PG8_SCHED; PG8_LDA(At, 1, 0); PG8_STAGE(PG8_SA(0, 1), a2 + hstep, voffA);
            PG8_WAIT_V(8); PG8_WAIT_L(0); PG8_BAR; PG8_MMA(0, 0, At, B0); PG8_MMA(0, 1, At, B1); PG8_BAR; PG8_SCHED;
            PG8_LDA(At, 1, 1); PG8_STAGE(PG8_SB(1, 0), b3, voffB); PG8_STAGE(PG8_SB(1, 1), b3 + hstep, voffB); PG8_STAGE(PG8_SA(1, 0), a3, voffA);
            PG8_WAIT_V(8); PG8_WAIT_L(0); PG8_BAR; PG8_MMA(1, 0, At, B0); PG8_MMA(1, 1, At, B1); PG8_BAR; PG8_SCHED;
            } else {
            PG8_LDB(B0, 0, 0); PG8_SCHED; PG8_LDA(At, 0, 0); PG8_STAGE(PG8_SA(1, 1), a1 + hstep, voffA);
            PG8_WAIT_L(8); PG8_BAR; PG8_WAIT_L(0); PG8_MMA(0, 0, At, B0); PG8_BAR; PG8_SCHED;
            PG8_LDB(B1, 0, 1); PG8_STAGE(PG8_SB(0, 0), b2, voffB);
            PG8_BAR; PG8_WAIT_L(0); PG8_MMA(0, 1, At, B1); PG8_BAR;
            PG8_LDA(At, 0, 1); PG8_STAGE(PG8_SA(0, 0), a2, voffA);
            PG8_BAR; PG8_WAIT_L(0); PG8_MMA(1, 0, At, B0); PG8_BAR; PG8_SCHED;
            PG8_STAGE(PG8_SB(0, 1), b2 + hstep, voffB);
            PG8_WAIT_V(6); PG8_BAR; PG8_MMA(1, 1, At, B1); PG8_BAR;
            PG8_LDB(B0, 1, 0); PG8_SCHED; PG8_LDA(At, 1, 0); PG8_STAGE(PG8_SA(0, 1), a2 + hstep, voffA);
            PG8_WAIT_L(8); PG8_BAR; PG8_WAIT_L(0); PG8_MMA(0, 0, At, B0); PG8_BAR; PG8_SCHED;
            PG8_LDB(B1, 1, 1); PG8_STAGE(PG8_SB(1, 0), b3, voffB);
            PG8_BAR; PG8_WAIT_L(0); PG8_MMA(0, 1, At, B1); PG8_BAR;
            PG8_LDA(At, 1, 1); PG8_STAGE(PG8_SA(1, 0), a3, voffA);
            PG8_BAR; PG8_WAIT_L(0); PG8_MMA(1, 0, At, B0); PG8_BAR; PG8_SCHED;
            PG8_STAGE(PG8_SB(1, 1), b3 + hstep, voffB);
            PG8_WAIT_V(6); PG8_BAR; PG8_MMA(1, 1, At, B1); PG8_BAR;
            }
        }
        if constexpr (ALIGN_EPI) { if (wr == 0) PG8_BAR; }
        if constexpr (!Epi::AFTER_DRAIN) { E(acc, cur, wr, wc, fr, fq); S.done(cur); }
        if (!has_next) break;
#pragma unroll
        for (int a = 0; a < 2; ++a)
#pragma unroll
            for (int b = 0; b < 2; ++b)
#pragma unroll
                for (int m = 0; m < 4; ++m)
#pragma unroll
                    for (int n = 0; n < 2; ++n) acc[a][b][m][n] = (f32x4){0.f, 0.f, 0.f, 0.f};
        cur = nxt; cA = nA; cB = nB; ++ui;
        if constexpr (ALIGN_EPI) { if (wr == 1) PG8_BAR; }
    }
    PG8_WAIT_V(0);
    if constexpr (!ALIGN_EPI) { if (wr == 0) PG8_BAR; }
    PG8_BAR;
    if constexpr (Epi::AFTER_DRAIN) { E.fused(acc, cur, wr, wc, fr, fq, lds, wid, lane); S.done(cur); }
#undef PG8_SA
#undef PG8_SB
#undef PG8_STAGE
#undef PG8_LDA
#undef PG8_LDB
#undef PG8_MMA
#undef PG8_WAIT_V
#undef PG8_WAIT_L
#undef PG8_BAR
#undef PG8_SCHED
}
}

constexpr int DM = 1024, BATCH = 8, SEQ = 8192, TALL = BATCH * SEQ;
constexpr int HBATCH = 4, TH = HBATCH * SEQ;
constexpr int D_IN = 8704, NEXP = 16, CAP = 1024, DFF = 2048;
constexpr float RMS_EPS = 1e-6f;

typedef unsigned short bf16;
typedef unsigned v4u __attribute__((ext_vector_type(4)));
typedef unsigned v2u __attribute__((ext_vector_type(2)));
typedef float f32x4 __attribute__((ext_vector_type(4)));
typedef short bf16x8 __attribute__((ext_vector_type(8)));

constexpr size_t MiB = 1u << 20;
constexpr size_t WS_CTL = 0, CTL_ZERO_BYTES = 64 * 1024;
constexpr size_t WS_COS = 1 * MiB, WS_SIN = WS_COS + 512 * 1024;
constexpr size_t WS_WIN = 2 * MiB, WS_PRNN = 19 * MiB, WS_PATT = 21 * MiB, WS_WOUT = 22 * MiB;
constexpr size_t WS_AFF = 24 * MiB, WS_IDX = 28 * MiB, WS_GATEV = WS_IDX + 512 * 1024, WS_LSE = 29 * MiB, WS_SLOT = 32 * MiB;
constexpr size_t WS_XN = 36 * MiB;
constexpr size_t WS_XR = 164 * MiB, WS_GGR = 228 * MiB, WS_QKV = 292 * MiB, WS_SGA = 580 * MiB, WS_SGB = 644 * MiB, WS_YRNN = 708 * MiB, WS_HF = 772 * MiB;
constexpr size_t WS_OG = WS_XR;
constexpr size_t WS_YATT = WS_QKV, WS_MERGED = WS_QKV + 32 * MiB;
constexpr size_t WS_H2 = WS_XN, WS_XG = 164 * MiB, WS_HID = 292 * MiB, WS_EO = 548 * MiB, WS_WGU = 804 * MiB, WS_WD = 932 * MiB, WS_END = 996 * MiB;
constexpr int CW_BAR = 1024;

constexpr int LDS_BYTES = 147456, MISC_OFF = 131072 + 320;

__device__ __forceinline__ unsigned f2bf(float f) { unsigned u = __builtin_bit_cast(unsigned, f); return (u + 0x7fffu + ((u >> 16) & 1u)) >> 16; }
__device__ __forceinline__ unsigned pk2(float lo, float hi) { return f2bf(lo) | (f2bf(hi) << 16); }
__device__ __forceinline__ float bflo(unsigned w) { return __builtin_bit_cast(float, w << 16); }
__device__ __forceinline__ float bfhi(unsigned w) { return __builtin_bit_cast(float, w & 0xffff0000u); }
__device__ __forceinline__ float bf2f(unsigned short b) { return __builtin_bit_cast(float, (unsigned)b << 16); }
__device__ __forceinline__ float wave_sum(float v) {
#pragma unroll
    for (int o = 1; o < 64; o <<= 1) v += __shfl_xor(v, o);
    return v;
}
__device__ __forceinline__ float sigmoidf_(float v) { return 1.0f / (1.0f + __expf(-v)); }
__device__ __forceinline__ float gelu_tanh(float v) { const float u = 0.7978845608028654f * (v + 0.044715f * v * v * v); return v / (1.0f + __expf(-2.0f * u)); }
#define LDS_WAIT() asm volatile("s_waitcnt lgkmcnt(0)" ::: "memory")

#define XB_TMO      128
#define XB_XCNT(j)  (256  + 64 * (j))
#define XB_XSUB(j)  (1280 + 64 * (j))
#define XB_XGEN(j)  (2304 + 64 * (j))
#define XB_TOP      3328
#define XB_TOPGEN   3392
#define XCD_BAR_WORDS 3456
#define XB_SPIN_CAP (1u << 22)

__device__ __forceinline__ unsigned xb_ld(unsigned* p)              { return __hip_atomic_load(p, __ATOMIC_RELAXED, __HIP_MEMORY_SCOPE_AGENT); }
__device__ __forceinline__ unsigned xb_add(unsigned* p, unsigned v) { return __hip_atomic_fetch_add(p, v, __ATOMIC_RELAXED, __HIP_MEMORY_SCOPE_AGENT); }
__device__ __forceinline__ unsigned xb_xcc_id() { return (unsigned)__builtin_amdgcn_s_getreg((3 << 11) | 20) & 0xFu; }
#define XB_SPIN(cond, bar) do { unsigned _sp = 0; while (cond) { __builtin_amdgcn_s_sleep(1); \
    if ((++_sp & 255u) == 0u) { if (xb_ld(&(bar)[XB_TMO])) break; if (_sp > XB_SPIN_CAP) { atomicAdd(&(bar)[XB_TMO], 1u); break; } } } } while (0)

struct XcdBarrier { unsigned* bar; unsigned x; volatile LAS unsigned* st; };

__device__ __forceinline__ XcdBarrier xcd_barrier_post(unsigned* bar, volatile LAS unsigned* st) {
    XcdBarrier b; b.bar = bar; b.x = xb_xcc_id(); b.st = st;
    if (threadIdx.x == 0) (void)xb_add(&bar[XB_XCNT(b.x)], 1u);
    return b;
}
__device__ __forceinline__ void xcd_barrier_complete(unsigned* bar, unsigned x, unsigned& nloc, unsigned& nx) {
    const unsigned G = gridDim.x * gridDim.y * gridDim.z;
    unsigned sum, cnt, mine, sp = 0u;
    for (;;) {
        sum = 0u; cnt = 0u; mine = 0u;
#pragma unroll
        for (unsigned j = 0; j < 16; ++j) { const unsigned c = xb_ld(&bar[XB_XCNT(j)]); sum += c; cnt += (c > 0u) ? 1u : 0u; mine = (j == x) ? c : mine; }
        if (sum == G) break;
        __builtin_amdgcn_s_sleep(1);
        if ((++sp & 255u) == 0u) { if (xb_ld(&bar[XB_TMO])) break; if (sp > XB_SPIN_CAP) { atomicAdd(&bar[XB_TMO], 1u); break; } }
    }
    nloc = mine > 0u ? mine : 1u; nx = cnt > 0u ? cnt : 1u;
}
__device__ __forceinline__ void xcd_barrier(const XcdBarrier& b) {
    asm volatile("s_waitcnt vmcnt(0)" ::: "memory");
    __syncthreads();
    if (threadIdx.x == 0) {
        unsigned* bar = b.bar;
        __builtin_amdgcn_s_waitcnt(0);
        unsigned nloc = b.st[0], nx = b.st[1];
        if (nloc == 0u) { xcd_barrier_complete(bar, b.x, nloc, nx); b.st[0] = nloc; b.st[1] = nx; }
        const unsigned old = xb_add(&bar[XB_XSUB(b.x)], 1u);
        const unsigned gen = old / nloc;
        if (old + 1u == (gen + 1u) * nloc) {
            __builtin_amdgcn_fence(__ATOMIC_RELEASE, "agent");
            asm volatile("s_waitcnt vmcnt(0)" ::: "memory");
            const unsigned og = xb_add(&bar[XB_TOP], 1u);
            const unsigned tg = og / nx;
            if (og + 1u == (tg + 1u) * nx) xb_add(&bar[XB_TOPGEN], 1u);
            else XB_SPIN(xb_ld(&bar[XB_TOPGEN]) == tg, bar);
            __builtin_amdgcn_fence(__ATOMIC_ACQUIRE, "agent");
            xb_add(&bar[XB_XGEN(b.x)], 1u);
            asm volatile("s_waitcnt vmcnt(0)" ::: "memory");
        } else {
            XB_SPIN(xb_ld(&bar[XB_XGEN(b.x)]) == gen, bar);
            __builtin_amdgcn_fence(__ATOMIC_ACQUIRE, "agent");
            asm volatile("s_waitcnt vmcnt(0)" ::: "memory");
        }
    }
    __syncthreads();
}

struct Params {
    const float* in[19];
    float* out;
    unsigned char* ws;
    int ph_lo, ph_hi;
    int li, pad;
};
enum { I_X = 0, I_NORM_MIX, I_W_IN, I_B_IN, I_CONV_W, I_CONV_B, I_RG_W, I_RG_B, I_RG_LAM, I_P_RNN, I_P_ATTN, I_W_OUT, I_NORM_FFN, I_W_ROUTER, I_B_ROUTER, I_W_GATE, I_W_UP, I_W_DOWN, I_NORM_FINAL };

__device__ __forceinline__ unsigned long long karg_u64(int byte_off) {
    const auto ka = __builtin_amdgcn_kernarg_segment_ptr();
    unsigned long long v;
    asm volatile("s_load_dwordx2 %0, %1, %2\n\ts_waitcnt lgkmcnt(0)" : "=s"(v) : "s"(ka), "i"(byte_off) : "memory");
    return v;
}
#define KIN(i) ((const float*)karg_u64(8 * (i)))
#define KOUT() ((float*)karg_u64(152))
#define KWS() ((unsigned char*)karg_u64(160))
static_assert(sizeof(Params) == 184, "Params layout");

struct EpiInProj {
    static constexpr bool PERM = true, AFTER_DRAIN = false;
    const float* bias; bf16* xr; bf16* ggr; bf16* qkv; bf16* sga; bf16* sgb; const float* cosT; const float* sinT;
    __device__ __forceinline__ void operator()(const f32x4 (&acc)[2][2][4][2], const pg8::Unit& u, int wr, int wc, int fr, int fq) const {
        const int pn = u.pn;
        const int row0 = u.pm * 256 + wr * 64 + fr, ccol = wc * 32 + 8 * fq, bcol0 = pn * 256 + ccol;
        f32x4 bv[2][2];
#pragma unroll
        for (int bj = 0; bj < 2; ++bj)
#pragma unroll
            for (int n = 0; n < 2; ++n) bv[bj][n] = *(const f32x4*)(bias + bcol0 + bj * 128 + 4 * n);
        if (pn < 8 || pn >= 26) {
            bf16* O; int colt; int act;
            if (pn < 4) { O = xr; colt = pn * 256; act = 0; } else if (pn < 8) { O = ggr; colt = (pn - 4) * 256; act = 1; }
            else if (pn < 30) { O = sga; colt = (pn - 26) * 256; act = 2; } else { O = sgb; colt = (pn - 30) * 256; act = 2; }
#pragma unroll
            for (int ai = 0; ai < 2; ++ai)
#pragma unroll
                for (int m = 0; m < 4; ++m) { bf16* rowp = O + (size_t)(row0 + ai * 128 + m * 16) * 1024 + colt + ccol;
#pragma unroll
                    for (int bj = 0; bj < 2; ++bj) { f32x4 v0 = acc[ai][bj][m][0] + bv[bj][0], v1 = acc[ai][bj][m][1] + bv[bj][1];
                        if (act == 1) {
#pragma unroll
                            for (int e = 0; e < 4; ++e) { v0[e] = gelu_tanh(v0[e]); v1[e] = gelu_tanh(v1[e]); } }
                        if (act == 2) {
#pragma unroll
                            for (int e = 0; e < 4; ++e) { v0[e] = sigmoidf_(v0[e]); v1[e] = sigmoidf_(v1[e]); } }
                        v4u w; w.x = pk2(v0[0], v0[1]); w.y = pk2(v0[2], v0[3]); w.z = pk2(v1[0], v1[1]); w.w = pk2(v1[2], v1[3]);
                        *(v4u*)(rowp + bj * 128) = w; } }
        } else {
            const int q = pn - 8, sec = q / 6, g = (q % 6) >> 1, tig = q & 1;
            const int lg = 2 * g, dil = 1 << lg, L = SEQ >> lg;
            bf16* base = qkv + (size_t)(sec * 3 + g) * ((size_t)TH * 512);
            const bool rot = (sec < 2) && (wc == 0);
            const float sgn = (fq < 2) ? -1.0f : 1.0f;
#pragma unroll
            for (int ai = 0; ai < 2; ++ai)
#pragma unroll
                for (int m = 0; m < 4; ++m) {
                    const int row = row0 + ai * 128 + m * 16, b = row >> 13, s = row & (SEQ - 1), rr = s & (dil - 1), j = s >> lg;
                    f32x4 cs0 = {1.f, 1.f, 1.f, 1.f}, cs1 = cs0, sn0 = {0.f, 0.f, 0.f, 0.f}, sn1 = sn0;
                    if (rot) { const float* cp = cosT + s * 16 + 8 * (fq & 1); const float* sp = sinT + s * 16 + 8 * (fq & 1);
                        cs0 = *(const f32x4*)cp; cs1 = *(const f32x4*)(cp + 4); sn0 = *(const f32x4*)sp; sn1 = *(const f32x4*)(sp + 4); }
#pragma unroll
                    for (int bj = 0; bj < 2; ++bj) { const int h = 2 * tig + bj;
                        f32x4 v0 = acc[ai][bj][m][0] + bv[bj][0], v1 = acc[ai][bj][m][1] + bv[bj][1];
                        if (rot) {
#pragma unroll
                            for (int e = 0; e < 4; ++e) { const float p0 = __shfl_xor(v0[e], 32), p1 = __shfl_xor(v1[e], 32);
                                v0[e] = v0[e] * cs0[e] + sgn * p0 * sn0[e]; v1[e] = v1[e] * cs1[e] + sgn * p1 * sn1[e]; } }
                        bf16* dst = base + ((size_t)(((b * 4 + h) * dil + rr) * L + j)) * 128 + ccol;
                        v4u w; w.x = pk2(v0[0], v0[1]); w.y = pk2(v0[2], v0[3]); w.z = pk2(v1[0], v1[1]); w.w = pk2(v1[2], v1[3]);
                        *(v4u*)dst = w; } }
        }
    }
};
struct EpiGate {
    static constexpr bool PERM = true, AFTER_DRAIN = false;
    const bf16* gate; const bf16* add; bf16* out;
    __device__ __forceinline__ void operator()(const f32x4 (&acc)[2][2][4][2], const pg8::Unit& u, int wr, int wc, int fr, int fq) const {
        const int row0 = u.pm * 256 + wr * 64 + fr, col0 = u.pn * 256 + wc * 32 + 8 * fq;
#pragma unroll
        for (int ai = 0; ai < 2; ++ai)
#pragma unroll
            for (int m = 0; m < 4; ++m) { const size_t off = (size_t)(row0 + ai * 128 + m * 16) * 1024 + col0;
#pragma unroll
                for (int bj = 0; bj < 2; ++bj) { const v4u gw = *(const v4u*)(gate + off + bj * 128);
                    v4u aw = {0u, 0u, 0u, 0u}; if (add) aw = *(const v4u*)(add + off + bj * 128);
                    const f32x4 v0 = acc[ai][bj][m][0], v1 = acc[ai][bj][m][1];
                    v4u w;
                    w.x = pk2(bflo(aw.x) + bflo(gw.x) * v0[0], bfhi(aw.x) + bfhi(gw.x) * v0[1]);
                    w.y = pk2(bflo(aw.y) + bflo(gw.y) * v0[2], bfhi(aw.y) + bfhi(gw.y) * v0[3]);
                    w.z = pk2(bflo(aw.z) + bflo(gw.z) * v1[0], bfhi(aw.z) + bfhi(gw.z) * v1[1]);
                    w.w = pk2(bflo(aw.w) + bflo(gw.w) * v1[2], bfhi(aw.w) + bfhi(gw.w) * v1[3]);
                    *(v4u*)(out + off + bj * 128) = w; } }
    }
};
struct EpiResid {
    static constexpr bool PERM = false, AFTER_DRAIN = false;
    const float* res; float* out;
    __device__ __forceinline__ void operator()(const f32x4 (&acc)[2][2][4][2], const pg8::Unit& u, int wr, int wc, int fr, int fq) const {
        const int row0 = u.pm * 256 + wr * 64 + fr, col0 = u.pn * 256 + wc * 32 + 4 * fq;
#pragma unroll
        for (int ai = 0; ai < 2; ++ai)
#pragma unroll
            for (int m = 0; m < 4; ++m) { const size_t off = (size_t)(row0 + ai * 128 + m * 16) * 1024 + col0;
#pragma unroll
                for (int bj = 0; bj < 2; ++bj)
#pragma unroll
                    for (int n = 0; n < 2; ++n) { const f32x4 r = *(const f32x4*)(res + off + bj * 128 + n * 16); *(f32x4*)(out + off + bj * 128 + n * 16) = r + acc[ai][bj][m][n]; } }
    }
};
struct MoeOrder {
    int G, c, nJ, nunits;
    __device__ __forceinline__ bool next(int i, pg8::Unit& u) const {
        const int L = i * G + c; if (L >= nunits) return false;
        const int per_e = 16 * nJ, e = L / per_e, rem = L % per_e, panel = rem / nJ, j = rem % nJ;
        u.pm = ((panel >> 2) * 16 + e) * 4 + (panel & 3); u.pn = e * nJ + j; return true;
    }
    __device__ __forceinline__ void a_ready(const pg8::Unit&) const {}
    __device__ __forceinline__ void done(const pg8::Unit&) const {}
};
struct EpiSwiglu {
    static constexpr bool PERM = true, AFTER_DRAIN = false;
    bf16* hid;
    __device__ __forceinline__ void operator()(const f32x4 (&acc)[2][2][4][2], const pg8::Unit& u, int wr, int wc, int fr, int fq) const {
        const int row0 = u.pm * 256 + wr * 64 + fr, col0 = (u.pn & 15) * 128 + wc * 32 + 8 * fq;
#pragma unroll
        for (int ai = 0; ai < 2; ++ai)
#pragma unroll
            for (int m = 0; m < 4; ++m) { bf16* dst = hid + (size_t)(row0 + ai * 128 + m * 16) * DFF + col0;
                float o[8];
#pragma unroll
                for (int n = 0; n < 2; ++n)
#pragma unroll
                    for (int e = 0; e < 4; ++e) { const float gt = acc[ai][0][m][n][e], up = acc[ai][1][m][n][e]; o[4 * n + e] = gt * sigmoidf_(gt) * up; }
                v4u w; w.x = pk2(o[0], o[1]); w.y = pk2(o[2], o[3]); w.z = pk2(o[4], o[5]); w.w = pk2(o[6], o[7]);
                *(v4u*)dst = w; }
    }
};
struct EpiDown {
    static constexpr bool PERM = true, AFTER_DRAIN = false;
    bf16* eo; const float* gatev;
    __device__ __forceinline__ void operator()(const f32x4 (&acc)[2][2][4][2], const pg8::Unit& u, int wr, int wc, int fr, int fq) const {
        const int row0 = u.pm * 256 + wr * 64 + fr, col0 = (u.pn & 3) * 256 + wc * 32 + 8 * fq;
#pragma unroll
        for (int ai = 0; ai < 2; ++ai)
#pragma unroll
            for (int m = 0; m < 4; ++m) { const int row = row0 + ai * 128 + m * 16; const float gt = gatev[row]; bf16* dst = eo + (size_t)row * 1024 + col0;
#pragma unroll
                for (int bj = 0; bj < 2; ++bj) { const f32x4 v0 = acc[ai][bj][m][0] * gt, v1 = acc[ai][bj][m][1] * gt;
                    v4u w; w.x = pk2(v0[0], v0[1]); w.y = pk2(v0[2], v0[3]); w.z = pk2(v1[0], v1[1]); w.w = pk2(v1[2], v1[3]);
                    *(v4u*)(dst + bj * 128) = w; } }
    }
};

__device__ __forceinline__ void tr_item(const float* W, int ldw, int k0, int n0, bf16* dst, size_t drow0, int ldd, LAS float* scr, int lane) {
#pragma unroll 8
    for (int i = 0; i < 32; ++i) { const int kk = 2 * i + (lane >> 5); scr[kk * 33 + (lane & 31)] = W[(size_t)(k0 + kk) * ldw + n0 + (lane & 31)]; }
    LDS_WAIT(); asm volatile("" ::: "memory");
    const int c = lane & 7;
#pragma unroll
    for (int j = 0; j < 4; ++j) { const int n = (lane >> 3) + 8 * j; const LAS float* s = scr + (8 * c) * 33 + n;
        v4u o; o.x = pk2(s[0 * 33], s[1 * 33]); o.y = pk2(s[2 * 33], s[3 * 33]); o.z = pk2(s[4 * 33], s[5 * 33]); o.w = pk2(s[6 * 33], s[7 * 33]);
        *(v4u*)(dst + (drow0 + n) * (size_t)ldd + k0 + 8 * c) = o; }
    LDS_WAIT(); asm volatile("" ::: "memory");
}
__device__ __forceinline__ void rms_row(const float* xrow, const float* gain, int lane, f32x4 (&o)[4]) {
    const f32x4* xr = (const f32x4*)xrow + lane; float s = 0.f;
#pragma unroll
    for (int j = 0; j < 4; ++j) { o[j] = xr[64 * j]; s += (o[j].x * o[j].x + o[j].y * o[j].y) + (o[j].z * o[j].z + o[j].w * o[j].w); }
    const float rstd = 1.0f / sqrtf(wave_sum(s) * (1.0f / DM) + RMS_EPS);
#pragma unroll
    for (int j = 0; j < 4; ++j) { const f32x4 g = ((const f32x4*)gain)[64 * j + lane]; o[j] = o[j] * rstd * g; }
}
__device__ __forceinline__ void store_row_bf16(bf16* orow, int lane, const f32x4 (&o)[4]) {
    unsigned long long* o8 = (unsigned long long*)orow + lane;
#pragma unroll
    for (int j = 0; j < 4; ++j) o8[64 * j] = (unsigned long long)pk2(o[j].x, o[j].y) | ((unsigned long long)pk2(o[j].z, o[j].w) << 32);
}

__device__ const float ROPE_INV[16] = {1.0f, 0.44036659598350525f, 0.1939227432012558f, 0.08539710193872452f, 0.03760603070259094f, 0.01656043902039528f, 0.007292664609849453f, 0.0032114458736032248f,
    0.0014142135623842478f, 0.000622772378847003f, 0.00027424818836152554f, 0.00012076973507646471f, 5.318296098266728e-05f, 2.34199997066753e-05f, 1.0313386155758053e-05f, 4.541670477919979e-06f};

__device__ __forceinline__ void phase_prep(LAS unsigned char* lds, int tid) {
    const int wave = tid >> 6, lane = tid & 63, G = gridDim.x;
    LAS float* scr = (LAS float*)(lds + wave * 16384);
    const int gw = blockIdx.x * 8 + wave, NGW = G * 8;
    unsigned char* ws = KWS();
    const float* w_in = KIN(I_W_IN); const float* p_rnn = KIN(I_P_RNN); const float* p_attn = KIN(I_P_ATTN); const float* w_out = KIN(I_W_OUT);
    constexpr int I_WIN = 16 * 272, I_PR = 16 * 32, I_PA = 8 * 32, I_WO = 16 * 32, NIT = I_WIN + I_PR + I_PA + I_WO;
    for (int it = gw; it < NIT; it += NGW) {
        int r = it;
        if (r < I_WIN) { const int kb = r / 272, nb = r % 272; tr_item(w_in, D_IN, kb * 64, nb * 32, (bf16*)(ws + WS_WIN), nb * 32, 1024, scr, lane); continue; } r -= I_WIN;
        if (r < I_PR) { const int kb = r / 32, nb = r % 32; tr_item(p_rnn, 1024, kb * 64, nb * 32, (bf16*)(ws + WS_PRNN), nb * 32, 1024, scr, lane); continue; } r -= I_PR;
        if (r < I_PA) { const int kb = r / 32, nb = r % 32; tr_item(p_attn, 1024, kb * 64, nb * 32, (bf16*)(ws + WS_PATT), nb * 32, 512, scr, lane); continue; } r -= I_PA;
        { const int kb = r / 32, nb = r % 32; tr_item(w_out, 1024, kb * 64, nb * 32, (bf16*)(ws + WS_WOUT), nb * 32, 1024, scr, lane); }
    }
    for (int i = blockIdx.x * 512 + tid; i < SEQ * 16; i += G * 512) {
        const int pos = i >> 4, k = i & 15;
        const float ang = (float)pos * ROPE_INV[k];
        const double a = (double)ang;
        const double kq = __builtin_rint(a * 0.63661977236758134308);
        double y = __builtin_fma(-kq, 1.57079632679489655800e+00, a); y = __builtin_fma(-kq, 6.12323399573676603587e-17, y);
        const int q = ((int)kq) & 3;
        const double y2 = y * y;
        const double sp = y * (1.0 + y2 * (-1.0 / 6 + y2 * (1.0 / 120 + y2 * (-1.0 / 5040 + y2 * (1.0 / 362880 + y2 * (-1.0 / 39916800 + y2 * (1.0 / 6227020800.0)))))));
        const double cp = 1.0 + y2 * (-0.5 + y2 * (1.0 / 24 + y2 * (-1.0 / 720 + y2 * (1.0 / 40320 + y2 * (-1.0 / 3628800 + y2 * (1.0 / 479001600.0 + y2 * (-1.0 / 87178291200.0)))))));
        double sv, cv;
        if (q == 0) { sv = sp; cv = cp; } else if (q == 1) { sv = cp; cv = -sp; } else if (q == 2) { sv = -sp; cv = -cp; } else { sv = -cp; cv = sp; }
        ((float*)(ws + WS_COS))[i] = (float)cv; ((float*)(ws + WS_SIN))[i] = (float)sv;
    }
    const float* xin = KIN(I_X); const float* nmix = KIN(I_NORM_MIX);
    for (int m = gw; m < TALL; m += NGW) { f32x4 o[4]; rms_row(xin + (size_t)m * DM, nmix, lane, o); store_row_bf16((bf16*)(ws + WS_XN) + (size_t)m * DM, lane, o); }
}

__device__ __forceinline__ void rnn_unit(LAS unsigned char* lds, int tid, int bl, int n, int cg,
                                         const bf16* xr, const bf16* ggr, bf16* hf, bf16* yrnn) {
    const int wave = tid >> 6, lane = tid & 63, fr = lane & 15, fq = lane >> 4;
    const int chan0 = n * 128, cgrp = tid & 15, ctok = tid >> 4;
    const size_t rowb = (size_t)bl * SEQ;
    const float* conv_w = KIN(I_CONV_W); const float* conv_b = KIN(I_CONV_B);
    float cw[4][8], cb[8];
#pragma unroll
    for (int k = 0; k < 8; ++k) { cb[k] = conv_b[chan0 + cgrp * 8 + k];
#pragma unroll
        for (int tap = 0; tap < 4; ++tap) cw[tap][k] = conv_w[tap * 1024 + chan0 + cgrp * 8 + k]; }
    const int c = chan0 + cg * 16 + fr;
    LAS unsigned char* xc = lds;
    LAS float* agg = (LAS float*)(lds + 40960);
    for (int dir = 0; dir < 2; ++dir) {
        bf16x8 bfr[2][4];
        const float* rgw = KIN(I_RG_W); const float* rgb = KIN(I_RG_B); const float* rgl = KIN(I_RG_LAM);
#pragma unroll
        for (int gate = 0; gate < 2; ++gate)
#pragma unroll
            for (int kk = 0; kk < 4; ++kk) {
                const float* wp = rgw + ((size_t)(((dir * 2 + gate) * 8 + n) * 128 + kk * 32 + 8 * fq)) * 128 + cg * 16 + fr;
                v4u w; w.x = pk2(wp[0], wp[128]); w.y = pk2(wp[256], wp[384]); w.z = pk2(wp[512], wp[640]); w.w = pk2(wp[768], wp[896]);
                bfr[gate][kk] = __builtin_bit_cast(bf16x8, w); }
        const float br = rgb[(dir * 2 + 0) * 1024 + c], bi = rgb[(dir * 2 + 1) * 1024 + c];
        const float lam = rgl[dir * 1024 + c];
        const float sp8 = 8.0f * log1pf(expf(-lam));
        float carry = 0.f;
        for (int ci = 0; ci < 64; ++ci) {
            const int chunk = dir ? 63 - ci : ci, t0 = chunk * 128;
#pragma unroll
            for (int i = 0; i < 4; ++i) {
                const int tok = ctok + 32 * i, t = t0 + tok;
                float a8[8];
#pragma unroll
                for (int k = 0; k < 8; ++k) a8[k] = cb[k];
#pragma unroll
                for (int tap = 0; tap < 4; ++tap) { const int tt = t + tap - 2;
                    if (tt >= 0 && tt < SEQ) { const v4u raw = *(const v4u*)(xr + (rowb + tt) * 1024 + chan0 + cgrp * 8);
                        a8[0] += cw[tap][0] * bflo(raw.x); a8[1] += cw[tap][1] * bfhi(raw.x); a8[2] += cw[tap][2] * bflo(raw.y); a8[3] += cw[tap][3] * bfhi(raw.y);
                        a8[4] += cw[tap][4] * bflo(raw.z); a8[5] += cw[tap][5] * bfhi(raw.z); a8[6] += cw[tap][6] * bflo(raw.w); a8[7] += cw[tap][7] * bfhi(raw.w); } }
                v4u w; w.x = pk2(a8[0], a8[1]); w.y = pk2(a8[2], a8[3]); w.z = pk2(a8[4], a8[5]); w.w = pk2(a8[6], a8[7]);
                *(LAS v4u*)(xc + tok * 272 + cgrp * 16) = w;
            }
            __syncthreads();
            f32x4 ar = {0.f, 0.f, 0.f, 0.f}, ai = ar;
#pragma unroll
            for (int kk = 0; kk < 4; ++kk) { const bf16x8 a = *(const LAS bf16x8*)(xc + (16 * wave + fr) * 272 + (kk * 32 + 8 * fq) * 2);
                ar = __builtin_amdgcn_mfma_f32_16x16x32_bf16(a, bfr[0][kk], ar, 0, 0, 0); ai = __builtin_amdgcn_mfma_f32_16x16x32_bf16(a, bfr[1][kk], ai, 0, 0, 0); }
            float av[4], uv[4];
#pragma unroll
            for (int r = 0; r < 4; ++r) { const int tl = 16 * wave + 4 * fq + r;
                const float xv = bf2f(*(const LAS unsigned short*)(xc + tl * 272 + (cg * 16 + fr) * 2));
                const float rg = sigmoidf_(ar[r] + br), ig = sigmoidf_(ai[r] + bi);
                const float la = -sp8 * rg;
                av[r] = __expf(la); uv[r] = xv * ig * sqrtf(-expm1f(2.0f * la)); }
            float hl[4], pl[4]; float H = 0.f, P = 1.f;
            if (dir == 0) {
#pragma unroll
                for (int r = 0; r < 4; ++r) { H = av[r] * H + uv[r]; P *= av[r]; hl[r] = H; pl[r] = P; }
            } else {
#pragma unroll
                for (int r = 3; r >= 0; --r) { H = av[r] * H + uv[r]; P *= av[r]; hl[r] = H; pl[r] = P; }
            }
            float Pq[4], Hq[4];
#pragma unroll
            for (int qq = 0; qq < 4; ++qq) { Pq[qq] = __shfl(P, fr + 16 * qq); Hq[qq] = __shfl(H, fr + 16 * qq); }
            float Pc = 1.f, Hc = 0.f, Pw = 1.f, Hw = 0.f;
            if (dir == 0) {
#pragma unroll
                for (int qq = 0; qq < 4; ++qq) { if (qq < fq) { Hc = Pq[qq] * Hc + Hq[qq]; Pc *= Pq[qq]; } Hw = Pq[qq] * Hw + Hq[qq]; Pw *= Pq[qq]; }
            } else {
#pragma unroll
                for (int qq = 3; qq >= 0; --qq) { if (qq > fq) { Hc = Pq[qq] * Hc + Hq[qq]; Pc *= Pq[qq]; } Hw = Pq[qq] * Hw + Hq[qq]; Pw *= Pq[qq]; }
            }
            if (fq == 0) { agg[(wave * 16 + fr) * 2] = Pw; agg[(wave * 16 + fr) * 2 + 1] = Hw; }
            __syncthreads();
            float Hin = carry, Hall = carry;
            if (dir == 0) {
#pragma unroll
                for (int w2 = 0; w2 < 8; ++w2) { const float pw = agg[(w2 * 16 + fr) * 2], hw = agg[(w2 * 16 + fr) * 2 + 1]; if (w2 < wave) Hin = pw * Hin + hw; Hall = pw * Hall + hw; }
            } else {
#pragma unroll
                for (int w2 = 7; w2 >= 0; --w2) { const float pw = agg[(w2 * 16 + fr) * 2], hw = agg[(w2 * 16 + fr) * 2 + 1]; if (w2 > wave) Hin = pw * Hin + hw; Hall = pw * Hall + hw; }
            }
            carry = Hall;
            const float Hs = Pc * Hin + Hc;
#pragma unroll
            for (int r = 0; r < 4; ++r) { const float h = pl[r] * Hs + hl[r];
                const size_t o = (rowb + t0 + 16 * wave + 4 * fq + r) * 1024 + c;
                if (dir == 0) hf[o] = (bf16)f2bf(h);
                else yrnn[o] = (bf16)f2bf(bf2f(ggr[o]) * (bf2f(hf[o]) + h)); }
        }
        __syncthreads();
    }
}

__device__ __forceinline__ void attn_unit(const bf16* Q, const bf16* K, const bf16* V, int L, int q0, bf16* og, float* lse, size_t tok_base, int dil, int rr, int h,
                                          LAS unsigned char* lds, int tid) {
    const int wave = tid >> 6, lane = tid & 63, fr = lane & 15, fq = lane >> 4;
    LAS unsigned char* kv = lds;
    LAS unsigned char* pb = lds + 73728 + wave * 5376;
    const int k0 = q0 - 64;
#pragma unroll
    for (int i = 0; i < 8; ++i) { const int idx = tid + 512 * i, row = idx >> 4, ch = idx & 15, gk = k0 + row;
        v4u v = {0u, 0u, 0u, 0u}; if (gk >= 0 && gk < L) v = *(const v4u*)(K + (size_t)gk * 128 + ch * 8);
        *(LAS v4u*)(kv + row * 272 + ch * 16) = v; }
    bf16x8 qf[4];
#pragma unroll
    for (int kk = 0; kk < 4; ++kk) qf[kk] = *(const bf16x8*)(Q + (size_t)(q0 + 16 * wave + fr) * 128 + kk * 32 + 8 * fq);
    __syncthreads();
    f32x4 s[9];
#pragma unroll
    for (int kt = 0; kt < 9; ++kt) { s[kt] = (f32x4){0.f, 0.f, 0.f, 0.f};
#pragma unroll
        for (int kk = 0; kk < 4; ++kk) { const bf16x8 b = *(const LAS bf16x8*)(kv + ((wave + kt) * 16 + fr) * 272 + (kk * 32 + 8 * fq) * 2);
            s[kt] = __builtin_amdgcn_mfma_f32_16x16x32_bf16(qf[kk], b, s[kt], 0, 0, 0); } }
    const float scale = 0.08838834764831845f;
    float mx[4] = {-1e30f, -1e30f, -1e30f, -1e30f};
#pragma unroll
    for (int kt = 0; kt < 9; ++kt) { const int lk = (wave + kt) * 16 + fr, gk = k0 + lk;
#pragma unroll
        for (int r = 0; r < 4; ++r) { const int lq = 16 * wave + 4 * fq + r, rel = lk - 64 - lq;
            const bool valid = (rel >= -64) && (rel <= 64) && (gk >= 0) && (gk < L);
            const float sv = valid ? s[kt][r] * scale : -1e30f; s[kt][r] = sv; mx[r] = fmaxf(mx[r], sv); } }
#pragma unroll
    for (int r = 0; r < 4; ++r) {
#pragma unroll
        for (int o = 1; o < 16; o <<= 1) mx[r] = fmaxf(mx[r], __shfl_xor(mx[r], o)); }
    float sum[4] = {0.f, 0.f, 0.f, 0.f};
#pragma unroll
    for (int kt = 0; kt < 9; ++kt)
#pragma unroll
        for (int r = 0; r < 4; ++r) { const float pv = __expf(s[kt][r] - mx[r]); sum[r] += pv;
            *(LAS unsigned short*)(pb + (4 * fq + r) * 336 + (kt * 16 + fr) * 2) = (unsigned short)f2bf(pv); }
#pragma unroll
    for (int r = 0; r < 4; ++r) {
#pragma unroll
        for (int o = 1; o < 16; o <<= 1) sum[r] += __shfl_xor(sum[r], o); }
    *(LAS v2u*)(pb + (lane >> 2) * 336 + 288 + (lane & 3) * 8) = (v2u){0u, 0u};
    __syncthreads();
    if (tid < 384) { const int row = tid / 3, part = tid % 3; *(LAS v4u*)(kv + row * 560 + 512 + part * 16) = (v4u){0u, 0u, 0u, 0u}; }
#pragma unroll
    for (int i = 0; i < 8; ++i) { const int idx = tid + 512 * i, row = idx >> 4, ch = idx & 15, gk = k0 + row;
        v4u v = {0u, 0u, 0u, 0u}; if (gk >= 0 && gk < L) v = *(const v4u*)(V + (size_t)gk * 128 + ch * 8);
        LAS unsigned char* d = kv + (ch * 8) * 560 + row * 2;
        *(LAS unsigned short*)(d + 0 * 560) = (unsigned short)(v.x & 0xffffu); *(LAS unsigned short*)(d + 1 * 560) = (unsigned short)(v.x >> 16);
        *(LAS unsigned short*)(d + 2 * 560) = (unsigned short)(v.y & 0xffffu); *(LAS unsigned short*)(d + 3 * 560) = (unsigned short)(v.y >> 16);
        *(LAS unsigned short*)(d + 4 * 560) = (unsigned short)(v.z & 0xffffu); *(LAS unsigned short*)(d + 5 * 560) = (unsigned short)(v.z >> 16);
        *(LAS unsigned short*)(d + 6 * 560) = (unsigned short)(v.w & 0xffffu); *(LAS unsigned short*)(d + 7 * 560) = (unsigned short)(v.w >> 16); }
    __syncthreads();
    f32x4 o[8];
#pragma unroll
    for (int nt = 0; nt < 8; ++nt) o[nt] = (f32x4){0.f, 0.f, 0.f, 0.f};
#pragma unroll
    for (int kk = 0; kk < 5; ++kk) { const bf16x8 a = *(const LAS bf16x8*)(pb + fr * 336 + (kk * 32 + 8 * fq) * 2);
#pragma unroll
        for (int nt = 0; nt < 8; ++nt) { const bf16x8 b = *(const LAS bf16x8*)(kv + (nt * 16 + fr) * 560 + (wave * 16 + kk * 32 + 8 * fq) * 2);
            o[nt] = __builtin_amdgcn_mfma_f32_16x16x32_bf16(a, b, o[nt], 0, 0, 0); } }
#pragma unroll
    for (int r = 0; r < 4; ++r) { const float inv = 1.0f / sum[r]; const int j = q0 + 16 * wave + 4 * fq + r; const size_t t = tok_base + (size_t)j * dil + rr;
#pragma unroll
        for (int nt = 0; nt < 8; ++nt) og[t * 512 + h * 128 + nt * 16 + fr] = (bf16)f2bf(o[nt][r] * inv);
        if (fr == 0) lse[t * 4 + h] = mx[r] + __logf(sum[r]); }
    __syncthreads();
}

__device__ __forceinline__ unsigned block_sum_u32(unsigned v, LAS unsigned* red, int tid) {
#pragma unroll
    for (int o = 1; o < 64; o <<= 1) v += __shfl_xor(v, o);
    if ((tid & 63) == 0) red[tid >> 6] = v;
    __syncthreads();
    unsigned t = 0;
#pragma unroll
    for (int w = 0; w < 8; ++w) t += red[w];
    __syncthreads();
    return t;
}
__device__ __forceinline__ void topk_unit(const float* aff  , int* idx  , float* gatev  , int* slot  ,
                                          LAS unsigned char* lds, int tid) {
    LAS unsigned* red = (LAS unsigned*)lds;
    LAS unsigned* wtot = (LAS unsigned*)(lds + 64);
    unsigned v[16];
    { const v4u* src = (const v4u*)(aff + tid * 16);
#pragma unroll
      for (int i = 0; i < 4; ++i) { const v4u w = src[i]; v[4 * i] = w.x; v[4 * i + 1] = w.y; v[4 * i + 2] = w.z; v[4 * i + 3] = w.w; } }
    unsigned prefix = 0u;
    for (int bit = 30; bit >= 0; --bit) {
        const unsigned cand = prefix | (1u << bit); unsigned cnt = 0;
#pragma unroll
        for (int k = 0; k < 16; ++k) cnt += (v[k] >= cand) ? 1u : 0u;
        const unsigned tot = block_sum_u32(cnt, red, tid);
        if (tot >= (unsigned)CAP) prefix = cand;
    }
    const unsigned T = prefix;
    unsigned cgt = 0, ceq = 0;
#pragma unroll
    for (int k = 0; k < 16; ++k) { cgt += (v[k] > T) ? 1u : 0u; ceq += (v[k] == T) ? 1u : 0u; }
    const unsigned packed = cgt | (ceq << 16);
    const unsigned total = block_sum_u32(packed, red, tid);
    const unsigned n_gt = total & 0xffffu, need_eq = (unsigned)CAP - n_gt;
    const int lane = tid & 63, wave = tid >> 6;
    unsigned inc = packed;
#pragma unroll
    for (int o = 1; o < 64; o <<= 1) { const unsigned t = __shfl_up(inc, o); if (lane >= o) inc += t; }
    if (lane == 63) wtot[wave] = inc;
    __syncthreads();
    unsigned wpre = 0;
#pragma unroll
    for (int w = 0; w < 8; ++w) if (w < wave) wpre += wtot[w];
    const unsigned excl = wpre + inc - packed;
    unsigned gt_before = excl & 0xffffu, eq_before = excl >> 16;
#pragma unroll
    for (int k = 0; k < 16; ++k) {
        const int t = tid * 16 + k;
        const bool isgt = v[k] > T, iseq = v[k] == T;
        const bool sel = isgt || (iseq && eq_before < need_eq);
        const unsigned c = gt_before + (eq_before < need_eq ? eq_before : need_eq);
        if (sel) { idx[c] = t; gatev[c] = __builtin_bit_cast(float, v[k]); }
        slot[(size_t)t * 16] = sel ? (int)c : -1;
        gt_before += isgt ? 1u : 0u; eq_before += iseq ? 1u : 0u;
    }
    __syncthreads();
}

#ifndef PH_MASK
#define PH_MASK 0xFFFF
#endif
#define PH_ON(c) (((PH_MASK) >> (c)) & 1)
#define PHASE_TID() int tid = threadIdx.x; asm volatile("" : "+v"(tid)); const int lane = tid & 63, wave = __builtin_amdgcn_readfirstlane(tid >> 6); const int gw = blockIdx.x * 8 + wave, NGW = G * 8; (void)lane; (void)gw; (void)NGW
__global__ void __launch_bounds__(512, 2) mega(Params p) {
    extern __shared__ __attribute__((aligned(16))) unsigned char lds_raw[];
    LAS unsigned char* lds = (LAS unsigned char*)lds_raw;
    const int G = gridDim.x;
    volatile LAS unsigned* MISC = (volatile LAS unsigned*)(lds + MISC_OFF);
    if (threadIdx.x < 32) MISC[threadIdx.x] = 0u;
    __syncthreads();
    const int lo = p.ph_lo, hi = p.ph_hi;
    XcdBarrier bar = xcd_barrier_post((unsigned*)(KWS() + WS_CTL) + CW_BAR + p.li * XCD_BAR_WORDS, MISC + 8);
#define IN(k) (lo <= (k) && (k) < hi)
#define SEAM(k) do { if (IN(k) && IN((k) + 1)) xcd_barrier(bar); } while (0)

    if (PH_ON(0) && IN(0)) { PHASE_TID(); phase_prep(lds, tid); }
    SEAM(0);

    for (int half = 0; half < 2; ++half) {
        const int pb0 = 1 + 7 * half;
        if (PH_ON(1) && IN(pb0 + 0)) {
            unsigned char* ws = KWS();
            pg8::Gemm g{(const bf16*)(ws + WS_XN) + (size_t)half * TH * DM, (const bf16*)(ws + WS_WIN), TH, D_IN, DM}; pg8::StaticOrder S; S.init(TH, D_IN, G, (int)blockIdx.x);
            EpiInProj E{KIN(I_B_IN), (bf16*)(ws + WS_XR), (bf16*)(ws + WS_GGR), (bf16*)(ws + WS_QKV), (bf16*)(ws + WS_SGA), (bf16*)(ws + WS_SGB), (const float*)(ws + WS_COS), (const float*)(ws + WS_SIN)};
            pg8::gemm_phase<EpiInProj, pg8::StaticOrder, true, true>(lds, g, S, E);
        }
        SEAM(pb0 + 0);
        if (PH_ON(2) && IN(pb0 + 1)) { PHASE_TID();
            unsigned char* ws = KWS();
            for (int unit = blockIdx.x; unit < 256; unit += G) rnn_unit(lds, tid, unit >> 6, (unit >> 3) & 7, unit & 7, (const bf16*)(ws + WS_XR), (const bf16*)(ws + WS_GGR), (bf16*)(ws + WS_HF), (bf16*)(ws + WS_YRNN));
        }
        SEAM(pb0 + 1);
        if (PH_ON(3) && IN(pb0 + 2)) { PHASE_TID();
            unsigned char* ws = KWS();
            const bf16* qkv = (const bf16*)(ws + WS_QKV); bf16* og = (bf16*)(ws + WS_OG); float* lse = (float*)(ws + WS_LSE);
            for (int unit = blockIdx.x; unit < 3072; unit += G) {
                const int g = unit >> 10, rem = unit & 1023, bl = rem >> 8, h = (rem >> 6) & 3, w = rem & 63;
                const int lg = 2 * g, dil = 1 << lg, L = SEQ >> lg, nblk = 64 >> lg, rr = w / nblk, blk = w % nblk;
                const size_t sub = ((size_t)((bl * 4 + h) * dil + rr) * L) * 128;
                const bf16* Qp = qkv + (size_t)(0 * 3 + g) * ((size_t)TH * 512) + sub;
                const bf16* Kp = qkv + (size_t)(1 * 3 + g) * ((size_t)TH * 512) + sub;
                const bf16* Vp = qkv + (size_t)(2 * 3 + g) * ((size_t)TH * 512) + sub;
                attn_unit(Qp, Kp, Vp, L, blk * 128, og + (size_t)g * ((size_t)TH * 512), lse + (size_t)g * ((size_t)TH * 4), (size_t)bl * SEQ, dil, rr, h, lds, tid);
            }
        }
        SEAM(pb0 + 2);
        if (PH_ON(4) && IN(pb0 + 3)) { PHASE_TID();
            unsigned char* ws = KWS();
            const bf16* og = (const bf16*)(ws + WS_OG); const float* lse = (const float*)(ws + WS_LSE); bf16* yatt = (bf16*)(ws + WS_YATT);
            for (int t = gw; t < TH; t += NGW) {
                const int h = lane >> 4, d0 = (lane & 15) * 8;
                const float l0 = lse[(size_t)t * 4 + h], l1 = lse[(size_t)TH * 4 + (size_t)t * 4 + h], l2 = lse[(size_t)TH * 8 + (size_t)t * 4 + h];
                const float m = fmaxf(l0, fmaxf(l1, l2)); const float e0 = __expf(l0 - m), e1 = __expf(l1 - m), e2 = __expf(l2 - m); const float inv = 1.0f / (e0 + e1 + e2);
                const float w0 = e0 * inv, w1 = e1 * inv, w2 = e2 * inv;
                const size_t o = (size_t)t * 512 + h * 128 + d0;
                const v4u a = *(const v4u*)(og + o), b = *(const v4u*)(og + (size_t)TH * 512 + o), c = *(const v4u*)(og + (size_t)TH * 1024 + o);
                v4u r;
                r.x = pk2(w0 * bflo(a.x) + w1 * bflo(b.x) + w2 * bflo(c.x), w0 * bfhi(a.x) + w1 * bfhi(b.x) + w2 * bfhi(c.x));
                r.y = pk2(w0 * bflo(a.y) + w1 * bflo(b.y) + w2 * bflo(c.y), w0 * bfhi(a.y) + w1 * bfhi(b.y) + w2 * bfhi(c.y));
                r.z = pk2(w0 * bflo(a.z) + w1 * bflo(b.z) + w2 * bflo(c.z), w0 * bfhi(a.z) + w1 * bfhi(b.z) + w2 * bfhi(c.z));
                r.w = pk2(w0 * bflo(a.w) + w1 * bflo(b.w) + w2 * bflo(c.w), w0 * bfhi(a.w) + w1 * bfhi(b.w) + w2 * bfhi(c.w));
                *(v4u*)(yatt + o) = r;
            }
        }
        SEAM(pb0 + 3);
        if (PH_ON(5) && IN(pb0 + 4)) {
            unsigned char* ws = KWS();
            pg8::Gemm g{(const bf16*)(ws + WS_YRNN), (const bf16*)(ws + WS_PRNN), TH, DM, DM}; pg8::StaticOrder S; S.init(TH, DM, G, (int)blockIdx.x);
            EpiGate E{(const bf16*)(ws + WS_SGA), nullptr, (bf16*)(ws + WS_MERGED)};
            pg8::gemm_phase<EpiGate, pg8::StaticOrder, true, true>(lds, g, S, E);
        }
        SEAM(pb0 + 4);
        if (PH_ON(6) && IN(pb0 + 5)) {
            unsigned char* ws = KWS();
            pg8::Gemm g{(const bf16*)(ws + WS_YATT), (const bf16*)(ws + WS_PATT), TH, DM, 512}; pg8::StaticOrder S; S.init(TH, DM, G, (int)blockIdx.x);
            EpiGate E{(const bf16*)(ws + WS_SGB), (const bf16*)(ws + WS_MERGED), (bf16*)(ws + WS_MERGED)};
            pg8::gemm_phase<EpiGate, pg8::StaticOrder, true, true>(lds, g, S, E);
        }
        SEAM(pb0 + 5);
        if (PH_ON(7) && IN(pb0 + 6)) {
            unsigned char* ws = KWS();
            pg8::Gemm g{(const bf16*)(ws + WS_MERGED), (const bf16*)(ws + WS_WOUT), TH, DM, DM}; pg8::StaticOrder S; S.init(TH, DM, G, (int)blockIdx.x);
            EpiResid E{KIN(I_X) + (size_t)half * TH * DM, KOUT() + (size_t)half * TH * DM};
            pg8::gemm_phase<EpiResid, pg8::StaticOrder, true, true>(lds, g, S, E);
        }
        SEAM(pb0 + 6);
    }

    if (PH_ON(8) && IN(15)) { PHASE_TID();
        unsigned char* ws = KWS();
        LAS float* scr = (LAS float*)(lds + wave * 16384);
        constexpr int I_E = 16 * 1024;
        { const float* wg = KIN(I_W_GATE); const float* wu = KIN(I_W_UP); const float* wd = KIN(I_W_DOWN);
        for (int it = gw; it < 3 * I_E; it += NGW) {
            int r = it;
            if (r < 2 * I_E) { const int up = r >= I_E; r -= up * I_E; const int e = r >> 10, rr2 = r & 1023, kb = rr2 >> 6, nb = rr2 & 63, n0 = nb * 32;
                tr_item((up ? wu : wg) + (size_t)e * DM * DFF, DFF, kb * 64, n0, (bf16*)(ws + WS_WGU), (size_t)e * 4096 + (n0 >> 7) * 256 + (n0 & 127) + up * 128, 1024, scr, lane); continue; }
            r -= 2 * I_E;
            { const int e = r >> 10, rr2 = r & 1023, kb = rr2 >> 5, nb = rr2 & 31, n0 = nb * 32;
              tr_item(wd + (size_t)e * DFF * DM, DM, kb * 64, n0, (bf16*)(ws + WS_WD), (size_t)e * 1024 + n0, 2048, scr, lane); }
        } }
        __syncthreads();
        LAS float* wrT = (LAS float*)lds;
        { const float* wrt = KIN(I_W_ROUTER);
          for (int i = tid; i < DM * NEXP; i += 512) { const int d = i >> 4, e = i & 15; wrT[e * 1024 + d] = wrt[i]; } }
        __syncthreads();
        const float* x2 = KOUT(); const float* nffn = KIN(I_NORM_FFN); const float* brt = KIN(I_B_ROUTER);
        for (int m = gw; m < TALL; m += NGW) {
            f32x4 o[4]; rms_row(x2 + (size_t)m * DM, nffn, lane, o); store_row_bf16((bf16*)(ws + WS_H2) + (size_t)m * DM, lane, o);
            float mine = -3.0e38f;
#pragma unroll 2
            for (int e = 0; e < 16; ++e) { float s = 0.f;
#pragma unroll
                for (int j = 0; j < 4; ++j) { const f32x4 w = *(const LAS f32x4*)(wrT + e * 1024 + j * 256 + 4 * lane); s += (o[j].x * w.x + o[j].y * w.y) + (o[j].z * w.z + o[j].w * w.w); }
                const float tot = wave_sum(s) + brt[e]; mine = (lane == e) ? tot : mine; }
            float mx = mine;
#pragma unroll
            for (int of = 1; of < 16; of <<= 1) mx = fmaxf(mx, __shfl_xor(mx, of));
            const float ex = expf(mine - mx); float den = ex;
#pragma unroll
            for (int of = 1; of < 16; of <<= 1) den += __shfl_xor(den, of);
            const int b = m >> 13, s = m & (SEQ - 1);
            if (lane < 16) ((float*)(ws + WS_AFF))[((size_t)(b * 16 + lane)) * SEQ + s] = ex / den;
        }
        __syncthreads();
    }
    SEAM(15);

    if (PH_ON(9) && IN(16)) { PHASE_TID();
        unsigned char* ws = KWS();
        for (int unit = blockIdx.x; unit < BATCH * NEXP; unit += G) { const int b = unit >> 4, e = unit & 15;
            topk_unit((const float*)(ws + WS_AFF) + (size_t)unit * SEQ, (int*)(ws + WS_IDX) + unit * CAP, (float*)(ws + WS_GATEV) + unit * CAP, (int*)(ws + WS_SLOT) + (size_t)b * SEQ * 16 + e, lds, tid); }
    }
    SEAM(16);

    for (int half = 0; half < 2; ++half) {
        const int pb0 = 17 + 3 * half;
        if (PH_ON(10) && IN(pb0 + 0)) { PHASE_TID();
            unsigned char* ws = KWS();
            const int* idx = (const int*)(ws + WS_IDX) + half * 65536; bf16* xg = (bf16*)(ws + WS_XG);
            for (int r = gw; r < 65536; r += NGW) { const int b = half * 4 + (r >> 14), t = idx[r];
                const v4u* src = (const v4u*)((const bf16*)(ws + WS_H2) + ((size_t)b * SEQ + t) * DM); v4u* dst = (v4u*)(xg + (size_t)r * DM);
                dst[lane] = src[lane]; dst[lane + 64] = src[lane + 64]; }
        }
        SEAM(pb0 + 0);
        if (PH_ON(11) && IN(pb0 + 1)) {
            unsigned char* ws = KWS();
            pg8::Gemm g{(const bf16*)(ws + WS_XG), (const bf16*)(ws + WS_WGU), 65536, 65536, DM}; MoeOrder S{G, (int)blockIdx.x, 16, 4096};
            EpiSwiglu E{(bf16*)(ws + WS_HID)};
            pg8::gemm_phase<EpiSwiglu, MoeOrder, true, true>(lds, g, S, E);
        }
        SEAM(pb0 + 1);
        if (PH_ON(12) && IN(pb0 + 2)) {
            unsigned char* ws = KWS();
            pg8::Gemm g{(const bf16*)(ws + WS_HID), (const bf16*)(ws + WS_WD), 65536, 16384, DFF}; MoeOrder S{G, (int)blockIdx.x, 4, 1024};
            EpiDown E{(bf16*)(ws + WS_EO) + (size_t)half * 65536 * DM, (const float*)(ws + WS_GATEV) + half * 65536};
            pg8::gemm_phase<EpiDown, MoeOrder, true, true>(lds, g, S, E);
        }
        SEAM(pb0 + 2);
    }

    if (PH_ON(13) && IN(23)) { PHASE_TID();
        unsigned char* ws = KWS();
        const bf16* eo = (const bf16*)(ws + WS_EO); float* outp = KOUT(); const float* nfin = KIN(I_NORM_FINAL);
        for (int m = gw; m < TALL; m += NGW) {
            const int b = m >> 13;
            float* xrow = outp + (size_t)m * DM;
            f32x4 v[4];
#pragma unroll
            for (int j = 0; j < 4; ++j) v[j] = ((const f32x4*)xrow)[64 * j + lane];
            const int* sl = (const int*)(ws + WS_SLOT) + (size_t)m * 16;
            for (int e = 0; e < 16; ++e) { const int c = sl[e];
                if (c >= 0) { const unsigned long long* er = (const unsigned long long*)(eo + ((size_t)(b * 16 + e) * CAP + c) * DM) + lane;
#pragma unroll
                    for (int j = 0; j < 4; ++j) { const unsigned long long w = er[64 * j]; const unsigned w0 = (unsigned)w, w1 = (unsigned)(w >> 32);
                        v[j].x += bflo(w0); v[j].y += bfhi(w0); v[j].z += bflo(w1); v[j].w += bfhi(w1); } } }
            float s = 0.f;
#pragma unroll
            for (int j = 0; j < 4; ++j) s += (v[j].x * v[j].x + v[j].y * v[j].y) + (v[j].z * v[j].z + v[j].w * v[j].w);
            const float rstd = 1.0f / sqrtf(wave_sum(s) * (1.0f / DM) + RMS_EPS);
#pragma unroll
            for (int j = 0; j < 4; ++j) { const f32x4 g = ((const f32x4*)nfin)[64 * j + lane]; ((f32x4*)xrow)[64 * j + lane] = v[j] * rstd * g; }
        }
    }
#undef IN
#undef SEAM
}

#ifndef MK_SPLIT
#define MK_SPLIT 0
#endif
constexpr int N_PHASES = 24;
extern "C" void kernel_launch(void* const* d_in, const int* in_sizes, int n_in, void* d_out, int out_size, void* d_ws, size_t ws_size, hipStream_t stream) {
    static int grid = 0;
    if (grid == 0) {
        if (n_in != 19 || out_size != TALL * DM || ws_size < WS_END) { fprintf(stderr, "kernel_launch: unexpected shapes (n_in %d out %d ws %zu)\n", n_in, out_size, ws_size); grid = -1; return; }
        int dev = 0, cus = 0, per_cu = 0;
        if (hipGetDevice(&dev) != hipSuccess || hipDeviceGetAttribute(&cus, hipDeviceAttributeMultiprocessorCount, dev) != hipSuccess) { grid = -1; return; }
        if (hipFuncSetAttribute((const void*)mega, hipFuncAttributeMaxDynamicSharedMemorySize, LDS_BYTES) != hipSuccess) { fprintf(stderr, "kernel_launch: hipFuncSetAttribute failed\n"); grid = -1; return; }
        if (hipOccupancyMaxActiveBlocksPerMultiprocessor(&per_cu, (const void*)mega, 512, LDS_BYTES) != hipSuccess || per_cu < 1) { fprintf(stderr, "kernel_launch: occupancy query says %d\n", per_cu); }
        (void)hipGetLastError();
        grid = cus;
    }
    if (grid < 0) return;
    (void)hipMemsetAsync((char*)d_ws + WS_CTL, 0, CTL_ZERO_BYTES, stream);
    Params p{};
    for (int i = 0; i < 19; ++i) p.in[i] = (const float*)d_in[i];
    p.out = (float*)d_out; p.ws = (unsigned char*)d_ws;
#if MK_SPLIT
    for (int k = 0; k < N_PHASES; ++k) { p.ph_lo = k; p.ph_hi = k + 1; p.li = 0; hipLaunchKernelGGL(mega, dim3(grid), dim3(512), LDS_BYTES, stream, p); }
#else
    p.ph_lo = 0; p.ph_hi = N_PHASES; p.li = 0;
    hipLaunchKernelGGL(mega, dim3(grid), dim3(512), LDS_BYTES, stream, p);
#endif
}
```

```cpp
#include <hip/hip_runtime.h>
#include <cstdio>
#include <cstdint>

#define GAS __attribute__((address_space(1)))
#define LAS __attribute__((address_space(3)))

namespace pg8 {
#define PG8_LAS __attribute__((address_space(3)))
typedef unsigned short bf16_t;
typedef short bf16x8 __attribute__((ext_vector_type(8)));
typedef float f32x4 __attribute__((ext_vector_type(4)));
typedef unsigned u32x4 __attribute__((ext_vector_type(4)));
constexpr int BM = 256, BK = 64, HALF = 128, HTB = HALF * BK * 2  , STAGE_BYTES = 8 * HTB, NXCD = 8, WGM = 8;

__host__ __device__ __forceinline__ int lds_byte(int r, int c) { const int st = (r >> 4) * 2 + (c >> 5), rr = r & 15, cc = c & 31, ob = rr * 64 + cc * 2; return st * 1024 + (ob ^ (((ob >> 9) & 1) << 5)); }
__host__ __device__ __forceinline__ void stage_rc(int b, int& R, int& C) { const int st = b / 1024, sb = b % 1024, swz = sb ^ (((sb >> 9) & 1) << 5); R = (st >> 1) * 16 + swz / 64; C = (st & 1) * 32 + (swz % 64) / 2; }
__host__ __device__ __forceinline__ int perm32(int rho) { const int n = rho >> 4, i = rho & 15; return 8 * (i >> 2) + 4 * n + (i & 3); }

struct Unit { int pm, pn; };
struct Gemm { const bf16_t* A; const bf16_t* Bt; int M, N, K; };

struct StaticOrder {
    int nM, nN, nwg, G, c;
    __host__ __device__ void init(int M, int N, int G_, int c_) { nM = M / BM; nN = N / BM; nwg = nM * nN; G = G_; c = c_; }
    __host__ __device__ bool next(int i, Unit& u) const {
        const long L = (long)i * G + c; if (L >= nwg) return false;
        int wgid = (int)L; { const int q = nwg / NXCD, r = nwg % NXCD, xcd = wgid % NXCD, off = wgid / NXCD; wgid = (xcd < r ? xcd * (q + 1) : r * (q + 1) + (xcd - r) * q) + off; }
        const int nig = WGM * nN, gid = wgid / nig, fm = gid * WGM, gsz = (nM - fm) < WGM ? (nM - fm) : WGM;
        u.pm = fm + ((wgid % nig) % gsz); u.pn = (wgid % nig) / gsz; return true;
    }
    __device__ __forceinline__ void a_ready(const Unit&) const {}
    __device__ __forceinline__ void done(const Unit&) const {}
};

__device__ __forceinline__ unsigned cvt_pk_bf16(float lo, float hi) { unsigned r; asm volatile("v_cvt_pk_bf16_f32 %0, %1, %2" : "=v"(r) : "v"(lo), "v"(hi)); return r; }
typedef float f32x2 __attribute__((ext_vector_type(2)));
template <class Epi, class Sched, bool ALIGN_EPI = false, bool SP2 = false>
__device__ __forceinline__ void gemm_phase(PG8_LAS unsigned char* lds, const Gemm g, const Sched& S, const Epi& E) {
    int tid_ = threadIdx.x; asm volatile("" : "+v"(tid_));
    const int tid = tid_, wid = __builtin_amdgcn_readfirstlane(tid >> 6), lane = tid & 63, wr = wid >> 2, wc = wid & 3, fr = lane & 15, fq = lane >> 4;
    const int K = g.K, nt = K / BK;
    unsigned voffA[2], voffB[2];
#pragma unroll
    for (int i = 0; i < 2; ++i) { int R, C; stage_rc(tid * 16 + i * 8192, R, C); const int Rb = Epi::PERM ? ((R & ~31) + perm32(R & 31)) : R;
        voffA[i] = (unsigned)(R * K + C) * 2u; voffB[i] = (unsigned)(Rb * K + C) * 2u; }
    const size_t kstep = (size_t)(BK * 2);
    const size_t hstep = (size_t)HALF * K * 2;
    const size_t tstep = 2 * hstep;
    const unsigned ldsw = (unsigned)wid * 1024u;
    const int aoff = lds_byte(wr * 64 + fr, fq * 8), boff = lds_byte(wc * 32 + fr, fq * 8);
#define PG8_SA(b, h) (((b) * 2 + (h)) * HTB)
#define PG8_SB(b, h) ((4 + (b) * 2 + (h)) * HTB)
#define PG8_STAGE(bufoff, gbase, voff) do { _Pragma("unroll") for (int _i = 0; _i < 2; ++_i) \
        __builtin_amdgcn_global_load_lds((const unsigned*)((const char*)(gbase) + (voff)[_i]), (PG8_LAS unsigned*)(lds + (bufoff) + ldsw + _i * 8192), 16, 0, 0); } while (0)
#define PG8_LDA(dst, b, h) do { _Pragma("unroll") for (int m = 0; m < 4; ++m) _Pragma("unroll") for (int k = 0; k < 2; ++k) dst[m][k] = *(const PG8_LAS bf16x8*)(lds + PG8_SA(b, h) + aoff + m * 2048 + k * 1024); } while (0)
#define PG8_LDB(dst, b, h) do { _Pragma("unroll") for (int n = 0; n < 2; ++n) _Pragma("unroll") for (int k = 0; k < 2; ++k) dst[n][k] = *(const PG8_LAS bf16x8*)(lds + PG8_SB(b, h) + boff + n * 2048 + k * 1024); } while (0)
#define PG8_MMA(ai, bj, At, Bt) do { __builtin_amdgcn_s_setprio(1); _Pragma("unroll") for (int m = 0; m < 4; ++m) _Pragma("unroll") for (int n = 0; n < 2; ++n) _Pragma("unroll") for (int k = 0; k < 2; ++k) \
        acc[ai][bj][m][n] = __builtin_amdgcn_mfma_f32_16x16x32_bf16(Bt[n][k], At[m][k], acc[ai][bj][m][n], 0, 0, 0); __builtin_amdgcn_s_setprio(0); } while (0)
#define PG8_WAIT_V(n) asm volatile("s_waitcnt vmcnt(" #n ")" ::: "memory")
#define PG8_WAIT_L(n) asm volatile("s_waitcnt lgkmcnt(" #n ")" ::: "memory")
#define PG8_BAR __builtin_amdgcn_s_barrier()
#define PG8_SCHED __builtin_amdgcn_sched_barrier(0)
    Unit cur, nxt; int ui = 0;
    if (!S.next(0, cur)) return;
    f32x4 acc[2][2][4][2];
#pragma unroll
    for (int a = 0; a < 2; ++a)
#pragma unroll
        for (int b = 0; b < 2; ++b)
#pragma unroll
            for (int m = 0; m < 4; ++m)
#pragma unroll
                for (int n = 0; n < 2; ++n) acc[a][b][m][n] = (f32x4){0.f, 0.f, 0.f, 0.f};
    bf16x8 At[4][2], B0[2][2], B1[2][2];
    const char* cA = (const char*)g.A + (size_t)cur.pm * tstep; const char* cB = (const char*)g.Bt + (size_t)cur.pn * tstep;
    S.a_ready(cur);
    if constexpr (SP2) {
        PG8_STAGE(PG8_SB(0, 0), cB, voffB); PG8_STAGE(PG8_SB(0, 1), cB + hstep, voffB); PG8_STAGE(PG8_SA(0, 0), cA, voffA); PG8_STAGE(PG8_SA(0, 1), cA + hstep, voffA);
        if (wr == 1) PG8_BAR;
        PG8_WAIT_V(2); PG8_BAR;
        PG8_STAGE(PG8_SB(1, 0), cB + kstep, voffB); PG8_STAGE(PG8_SA(1, 0), cA + kstep, voffA); PG8_STAGE(PG8_SB(1, 1), cB + hstep + kstep, voffB);
        PG8_WAIT_V(6); PG8_BAR;
    } else {
        PG8_STAGE(PG8_SB(0, 0), cB, voffB); PG8_STAGE(PG8_SA(0, 0), cA, voffA); PG8_STAGE(PG8_SB(0, 1), cB + hstep, voffB); PG8_STAGE(PG8_SA(0, 1), cA + hstep, voffA);
        if (wr == 1) PG8_BAR;
        PG8_WAIT_V(4); PG8_BAR;
        PG8_STAGE(PG8_SB(1, 0), cB + kstep, voffB); PG8_STAGE(PG8_SA(1, 0), cA + kstep, voffA); PG8_STAGE(PG8_SB(1, 1), cB + hstep + kstep, voffB);
        PG8_WAIT_V(6); PG8_BAR;
    }
    for (;;) {
        const bool has_next = S.next(ui + 1, nxt);
        const char* nA = has_next ? (const char*)g.A + (size_t)nxt.pm * tstep : cA; const char* nB = has_next ? (const char*)g.Bt + (size_t)nxt.pn * tstep : cB;
        for (int t = 0; t < nt; t += 2) {
            const bool last = (t == nt - 2);
            const char* a1 = cA + (size_t)(t + 1) * kstep;
            const char* a2 = last ? nA : cA + (size_t)(t + 2) * kstep; const char* b2 = last ? nB : cB + (size_t)(t + 2) * kstep;
            const char* a3 = a2 + kstep; const char* b3 = b2 + kstep;
            if (last && has_next) S.a_ready(nxt);
            if constexpr (SP2) {
            PG8_LDB(B0, 0, 0); PG8_LDB(B1, 0, 1); PG8_SCHED; PG8_LDA(At, 0, 0); PG8_STAGE(PG8_SA(1, 1), a1 + hstep, voffA);
            PG8_WAIT_V(8); PG8_WAIT_L(0); PG8_BAR; PG8_MMA(0, 0, At, B0); PG8_MMA(0, 1, At, B1); PG8_BAR; PG8_SCHED;
            PG8_LDA(At, 0, 1); PG8_STAGE(PG8_SB(0, 0), b2, voffB); PG8_STAGE(PG8_SB(0, 1), b2 + hstep, voffB); PG8_STAGE(PG8_SA(0, 0), a2, voffA);
            PG8_WAIT_V(8); PG8_WAIT_L(0); PG8_BAR; PG8_MMA(1, 0, At, B0); PG8_MMA(1, 1, At, B1); PG8_BAR; PG8_SCHED;
            PG8_LDB(B0, 1, 0); PG8_LDB(B1, 1, 1); PG8_SCHED; PG8_LDA(At, 1, 0); PG8_STAGE(PG8_SA(0, 1), a2 + hstep, voffA);
            PG8_WAIT_V(8); PG8_WAIT_L(0); PG8_BAR; PG8_MMA(0, 0, At, B0); PG8_MMA(0, 1, At, B1); PG8_BAR; PG8_SCHED;
            PG8_LDA(At, 1, 1); PG8_STAGE(PG8_SB(1, 0), b3, voffB); PG8_STAGE(PG8_SB(1, 1), b3 + hstep, voffB); PG8_STAGE(PG8_SA(1, 0), a3, voffA);
            PG8_WAIT_V(8); PG8_WAIT_L(0); PG8_BAR; PG8_MMA(1, 0, At, B0); PG8_MMA(1, 1, At, B1); PG8_BAR; PG8_SCHED;
            } else {
            PG8_LDB(B0, 0, 0); PG8_SCHED; PG8_LDA(At, 0, 0); PG8_STAGE(PG8_SA(1, 1), a1 + hstep, voffA);
            PG8_WAIT_L(8); PG8_BAR; PG8_WAIT_L(0); PG8_MMA(0, 0, At, B0); PG8_BAR; PG8_SCHED;
            PG8_LDB(B1, 0, 1); PG8_STAGE(PG8_SB(0, 0), b2, voffB);
            PG8_BAR; PG8_WAIT_L(0); PG8_MMA(0, 1, At, B1); PG8_BAR;
            PG8_LDA(At, 0, 1); PG8_STAGE(PG8_SA(0, 0), a2, voffA);
            PG8_BAR; PG8_WAIT_L(0); PG8_MMA(1, 0, At, B0); PG8_BAR; PG8_SCHED;
            PG8_STAGE(PG8_SB(0, 1), b2 + hstep, voffB);
            PG8_WAIT_V(6); PG8_BAR; PG8_MMA(1, 1, At, B1); PG8_BAR;
            PG8_LDB(B0, 1, 0); PG8_SCHED; PG8_LDA(At, 1, 0); PG8_STAGE(PG8_SA(0, 1), a2 + hstep, voffA);
            PG8_WAIT_L(8); PG8_BAR; PG8_WAIT_L(0); PG8_MMA(0, 0, At, B0); PG8_BAR; PG8_SCHED;
            PG8_LDB(B1, 1, 1); PG8_STAGE(PG8_SB(1, 0), b3, voffB);
            PG8_BAR; PG8_WAIT_L(0); PG8_MMA(0, 1, At, B1); PG8_BAR;
            PG8_LDA(At, 1, 1); PG8_STAGE(PG8_SA(1, 0), a3, voffA);
            PG8_BAR; PG8_WAIT_L(0); PG8_MMA(1, 0, At, B0); PG8_BAR; PG8_SCHED;
            PG8_STAGE(PG8_SB(1, 1), b3 + hstep, voffB);
            PG8_WAIT_V(6); PG8_BAR; PG8_MMA(1, 1, At, B1); PG8_BAR;
            }
        }
        if constexpr (ALIGN_EPI) { if (wr == 0) PG8_BAR; }
        if constexpr (!Epi::AFTER_DRAIN) { E(acc, cur, wr, wc, fr, fq); S.done(cur); }
        if (!has_next) break;
#pragma unroll
        for (int a = 0; a < 2; ++a)
#pragma unroll
            for (int b = 0; b < 2; ++b)
#pragma unroll
                for (int m = 0; m < 4; ++m)
#pragma unroll
                    for (int n = 0; n < 2; ++n) acc[a][b][m][n] = (f32x4){0.f, 0.f, 0.f, 0.f};
        cur = nxt; cA = nA; cB = nB; ++ui;
        if constexpr (ALIGN_EPI) { if (wr == 1) PG8_BAR; }
    }
    PG8_WAIT_V(0);
    if constexpr (!ALIGN_EPI) { if (wr == 0) PG8_BAR; }
    PG8_BAR;
    if constexpr (Epi::AFTER_DRAIN) { E.fused(acc, cur, wr, wc, fr, fq, lds, wid, lane); S.done(cur); }
#undef PG8_SA
#undef PG8_SB
#undef PG8_STAGE
#undef PG8_LDA
#undef PG8_LDB
#undef PG8_MMA
#undef PG8_WAIT_V
#undef PG8_WAIT_L
#undef PG8_BAR
#undef PG8_SCHED
}
}

constexpr int DM = 1024, BATCH = 8, SEQ = 8192, TALL = BATCH * SEQ;
constexpr int HBATCH = 4, TH = HBATCH * SEQ;
constexpr int D_IN = 8704, NEXP = 16, CAP = 1024, DFF = 2048;
constexpr float RMS_EPS = 1e-6f;

typedef unsigned short bf16;
typedef unsigned v4u __attribute__((ext_vector_type(4)));
typedef unsigned v2u __attribute__((ext_vector_type(2)));
typedef float f32x4 __attribute__((ext_vector_type(4)));
typedef short bf16x8 __attribute__((ext_vector_type(8)));

constexpr size_t MiB = 1u << 20;
constexpr size_t WS_CTL = 0, CTL_ZERO_BYTES = 64 * 1024;
constexpr size_t WS_COS = 1 * MiB, WS_SIN = WS_COS + 512 * 1024;
constexpr size_t WS_WIN = 2 * MiB, WS_PRNN = 19 * MiB, WS_PATT = 21 * MiB, WS_WOUT = 22 * MiB;
constexpr size_t WS_AFF = 24 * MiB, WS_IDX = 28 * MiB, WS_GATEV = WS_IDX + 512 * 1024, WS_LSE = 29 * MiB, WS_SLOT = 32 * MiB;
constexpr size_t WS_RGWF = 36 * MiB, WS_RGBIAS = 40 * MiB;
constexpr size_t WS_XN = 44 * MiB;
constexpr size_t WS_XR = 172 * MiB, WS_GGR = 300 * MiB, WS_QKV = 428 * MiB;
constexpr size_t WS_MERGED = WS_XR;
constexpr size_t WS_SGA = WS_QKV, WS_SGB = WS_QKV + 128 * MiB;
constexpr size_t WS_H2 = WS_XN, WS_XG = 172 * MiB, WS_HID = 300 * MiB, WS_EO = 556 * MiB, WS_WGU = 812 * MiB, WS_WD = 940 * MiB, WS_END = 1004 * MiB;
constexpr int CW_BAR = 1024;

constexpr int LDS_BYTES = 147456, MISC_OFF = 131072 + 320;

__device__ __forceinline__ unsigned f2bf(float f) { unsigned u = __builtin_bit_cast(unsigned, f); return (u + 0x7fffu + ((u >> 16) & 1u)) >> 16; }
__device__ __forceinline__ unsigned pk2(float lo, float hi) { return f2bf(lo) | (f2bf(hi) << 16); }
__device__ __forceinline__ float bflo(unsigned w) { return __builtin_bit_cast(float, w << 16); }
__device__ __forceinline__ float bfhi(unsigned w) { return __builtin_bit_cast(float, w & 0xffff0000u); }
__device__ __forceinline__ float bf2f(unsigned short b) { return __builtin_bit_cast(float, (unsigned)b << 16); }
__device__ __forceinline__ float wave_sum(float v) {
#pragma unroll
    for (int o = 1; o < 64; o <<= 1) v += __shfl_xor(v, o);
    return v;
}
__device__ __forceinline__ float sigmoidf_(float v) { return 1.0f / (1.0f + __expf(-v)); }
__device__ __forceinline__ float gelu_tanh(float v) { const float u = 0.7978845608028654f * (v + 0.044715f * v * v * v); return v / (1.0f + __expf(-2.0f * u)); }
#define LDS_WAIT() asm volatile("s_waitcnt lgkmcnt(0)" ::: "memory")

#define XB_TMO      128
#define XB_XCNT(j)  (256  + 64 * (j))
#define XB_XSUB(j)  (1280 + 64 * (j))
#define XB_XGEN(j)  (2304 + 64 * (j))
#define XB_TOP      3328
#define XB_TOPGEN   3392
#define XCD_BAR_WORDS 3456
#define XB_SPIN_CAP (1u << 22)

__device__ __forceinline__ unsigned xb_ld(unsigned* p)              { return __hip_atomic_load(p, __ATOMIC_RELAXED, __HIP_MEMORY_SCOPE_AGENT); }
__device__ __forceinline__ unsigned xb_add(unsigned* p, unsigned v) { return __hip_atomic_fetch_add(p, v, __ATOMIC_RELAXED, __HIP_MEMORY_SCOPE_AGENT); }
__device__ __forceinline__ unsigned xb_xcc_id() { return (unsigned)__builtin_amdgcn_s_getreg((3 << 11) | 20) & 0xFu; }
#define XB_SPIN(cond, bar) do { unsigned _sp = 0; while (cond) { __builtin_amdgcn_s_sleep(1); \
    if ((++_sp & 255u) == 0u) { if (xb_ld(&(bar)[XB_TMO])) break; if (_sp > XB_SPIN_CAP) { atomicAdd(&(bar)[XB_TMO], 1u); break; } } } } while (0)

struct XcdBarrier { unsigned* bar; unsigned x; volatile LAS unsigned* st; };

__device__ __forceinline__ XcdBarrier xcd_barrier_post(unsigned* bar, volatile LAS unsigned* st) {
    XcdBarrier b; b.bar = bar; b.x = xb_xcc_id(); b.st = st;
    if (threadIdx.x == 0) (void)xb_add(&bar[XB_XCNT(b.x)], 1u);
    return b;
}
__device__ __forceinline__ void xcd_barrier_complete(unsigned* bar, unsigned x, unsigned& nloc, unsigned& nx) {
    const unsigned G = gridDim.x * gridDim.y * gridDim.z;
    unsigned sum, cnt, mine, sp = 0u;
    for (;;) {
        sum = 0u; cnt = 0u; mine = 0u;
#pragma unroll
        for (unsigned j = 0; j < 16; ++j) { const unsigned c = xb_ld(&bar[XB_XCNT(j)]); sum += c; cnt += (c > 0u) ? 1u : 0u; mine = (j == x) ? c : mine; }
        if (sum == G) break;
        __builtin_amdgcn_s_sleep(1);
        if ((++sp & 255u) == 0u) { if (xb_ld(&bar[XB_TMO])) break; if (sp > XB_SPIN_CAP) { atomicAdd(&bar[XB_TMO], 1u); break; } }
    }
    nloc = mine > 0u ? mine : 1u; nx = cnt > 0u ? cnt : 1u;
}
__device__ __forceinline__ void xcd_barrier(const XcdBarrier& b) {
    asm volatile("s_waitcnt vmcnt(0)" ::: "memory");
    __syncthreads();
    if (threadIdx.x == 0) {
        unsigned* bar = b.bar;
        __builtin_amdgcn_s_waitcnt(0);
        unsigned nloc = b.st[0], nx = b.st[1];
        if (nloc == 0u) { xcd_barrier_complete(bar, b.x, nloc, nx); b.st[0] = nloc; b.st[1] = nx; }
        const unsigned old = xb_add(&bar[XB_XSUB(b.x)], 1u);
        const unsigned gen = old / nloc;
        if (old + 1u == (gen + 1u) * nloc) {
            __builtin_amdgcn_fence(__ATOMIC_RELEASE, "agent");
            asm volatile("s_waitcnt vmcnt(0)" ::: "memory");
            const unsigned og = xb_add(&bar[XB_TOP], 1u);
            const unsigned tg = og / nx;
            if (og + 1u == (tg + 1u) * nx) xb_add(&bar[XB_TOPGEN], 1u);
            else XB_SPIN(xb_ld(&bar[XB_TOPGEN]) == tg, bar);
            __builtin_amdgcn_fence(__ATOMIC_ACQUIRE, "agent");
            xb_add(&bar[XB_XGEN(b.x)], 1u);
            asm volatile("s_waitcnt vmcnt(0)" ::: "memory");
        } else {
            XB_SPIN(xb_ld(&bar[XB_XGEN(b.x)]) == gen, bar);
            __builtin_amdgcn_fence(__ATOMIC_ACQUIRE, "agent");
            asm volatile("s_waitcnt vmcnt(0)" ::: "memory");
        }
    }
    __syncthreads();
}

struct Params {
    const float* in[19];
    float* out;
    unsigned char* ws;
    int ph_lo, ph_hi;
    int li, pad;
};
enum { I_X = 0, I_NORM_MIX, I_W_IN, I_B_IN, I_CONV_W, I_CONV_B, I_RG_W, I_RG_B, I_RG_LAM, I_P_RNN, I_P_ATTN, I_W_OUT, I_NORM_FFN, I_W_ROUTER, I_B_ROUTER, I_W_GATE, I_W_UP, I_W_DOWN, I_NORM_FINAL };

__device__ __forceinline__ unsigned long long karg_u64(int byte_off) {
    const auto ka = __builtin_amdgcn_kernarg_segment_ptr();
    unsigned long long v;
    asm volatile("s_load_dwordx2 %0, %1, %2\n\ts_waitcnt lgkmcnt(0)" : "=s"(v) : "s"(ka), "i"(byte_off) : "memory");
    return v;
}
#define KIN(i) ((const float*)karg_u64(8 * (i)))
#define KOUT() ((float*)karg_u64(152))
#define KWS() ((unsigned char*)karg_u64(160))
static_assert(sizeof(Params) == 184, "Params layout");

__device__ __forceinline__ float xlane32(float v, bool lower_half) {
    const unsigned u = __builtin_bit_cast(unsigned, v);
    const auto r = __builtin_amdgcn_permlane32_swap(u, u, false, false);
    return __builtin_bit_cast(float, lower_half ? (unsigned)r[1] : (unsigned)r[0]);
}
struct EpiInProj {
    static constexpr bool PERM = true, AFTER_DRAIN = false;
    const float* bias; bf16* xr; bf16* ggr; bf16* qkv; bf16* sga; bf16* sgb; const float* cosT; const float* sinT; int pn_off;
    __device__ __forceinline__ void operator()(const f32x4 (&acc)[2][2][4][2], const pg8::Unit& u, int wr, int wc, int fr, int fq) const {
        const int pn = u.pn + pn_off;
        const int row0 = u.pm * 256 + wr * 64 + fr, ccol = wc * 32 + 8 * fq, bcol0 = pn * 256 + ccol;
        f32x4 bv[2][2];
#pragma unroll
        for (int bj = 0; bj < 2; ++bj)
#pragma unroll
            for (int n = 0; n < 2; ++n) bv[bj][n] = *(const f32x4*)(bias + bcol0 + bj * 128 + 4 * n);
        __builtin_amdgcn_s_waitcnt(0x0F70);
        if (pn < 8 || pn >= 26) {
            bf16* O; int colt; int act;
            if (pn < 4) { O = xr; colt = pn * 256; act = 0; } else if (pn < 8) { O = ggr; colt = (pn - 4) * 256; act = 1; }
            else if (pn < 30) { O = sga; colt = (pn - 26) * 256; act = 2; } else { O = sgb; colt = (pn - 30) * 256; act = 2; }
#pragma unroll
            for (int ai = 0; ai < 2; ++ai)
#pragma unroll
                for (int m = 0; m < 4; ++m) { bf16* rowp = O + (size_t)(row0 + ai * 128 + m * 16) * 1024 + colt + ccol;
#pragma unroll
                    for (int bj = 0; bj < 2; ++bj) { f32x4 v0 = acc[ai][bj][m][0] + bv[bj][0], v1 = acc[ai][bj][m][1] + bv[bj][1];
                        if (act == 1) {
#pragma unroll
                            for (int e = 0; e < 4; ++e) { v0[e] = gelu_tanh(v0[e]); v1[e] = gelu_tanh(v1[e]); } }
                        if (act == 2) {
#pragma unroll
                            for (int e = 0; e < 4; ++e) { v0[e] = sigmoidf_(v0[e]); v1[e] = sigmoidf_(v1[e]); } }
                        v4u w; w.x = pk2(v0[0], v0[1]); w.y = pk2(v0[2], v0[3]); w.z = pk2(v1[0], v1[1]); w.w = pk2(v1[2], v1[3]);
                        *(v4u*)(rowp + bj * 128) = w; } }
        } else {
            const int q = pn - 8, sec = q / 6, g = (q % 6) >> 1, tig = q & 1;
            const int lg = 2 * g, dil = 1 << lg, L = SEQ >> lg;
            bf16* base = qkv + (size_t)(sec * 3 + g) * ((size_t)TALL * 512);
            const bool rot = (sec < 2) && (wc == 0);
            const float sgn = (fq < 2) ? -1.0f : 1.0f;
#pragma unroll
            for (int ai = 0; ai < 2; ++ai)
#pragma unroll
                for (int m = 0; m < 4; ++m) {
                    const int row = row0 + ai * 128 + m * 16, b = row >> 13, s = row & (SEQ - 1), rr = s & (dil - 1), j = s >> lg;
                    f32x4 cs0 = {1.f, 1.f, 1.f, 1.f}, cs1 = cs0, sn0 = {0.f, 0.f, 0.f, 0.f}, sn1 = sn0;
                    if (rot) { const float* cp = cosT + s * 16 + 8 * (fq & 1); const float* sp = sinT + s * 16 + 8 * (fq & 1);
                        cs0 = *(const f32x4*)cp; cs1 = *(const f32x4*)(cp + 4); sn0 = *(const f32x4*)sp; sn1 = *(const f32x4*)(sp + 4); }
#pragma unroll
                    for (int bj = 0; bj < 2; ++bj) { const int h = 2 * tig + bj;
                        f32x4 v0 = acc[ai][bj][m][0] + bv[bj][0], v1 = acc[ai][bj][m][1] + bv[bj][1];
                        if (rot) {
#pragma unroll
                            for (int e = 0; e < 4; ++e) { const float p0 = xlane32(v0[e], fq < 2), p1 = xlane32(v1[e], fq < 2);
                                v0[e] = v0[e] * cs0[e] + sgn * p0 * sn0[e]; v1[e] = v1[e] * cs1[e] + sgn * p1 * sn1[e]; } }
                        bf16* dst = base + ((size_t)(((b * 4 + h) * dil + rr) * L + j)) * 128 + ccol;
                        v4u w; w.x = pk2(v0[0], v0[1]); w.y = pk2(v0[2], v0[3]); w.z = pk2(v1[0], v1[1]); w.w = pk2(v1[2], v1[3]);
                        *(v4u*)dst = w; } }
        }
    }
};
struct EpiGate {
    static constexpr bool PERM = true, AFTER_DRAIN = false;
    const bf16* gate; const bf16* add; bf16* out;
    __device__ __forceinline__ void operator()(const f32x4 (&acc)[2][2][4][2], const pg8::Unit& u, int wr, int wc, int fr, int fq) const {
        const int row0 = u.pm * 256 + wr * 64 + fr, col0 = u.pn * 256 + wc * 32 + 8 * fq;
#pragma unroll
        for (int ai = 0; ai < 2; ++ai)
#pragma unroll
            for (int m = 0; m < 4; ++m) { const size_t off = (size_t)(row0 + ai * 128 + m * 16) * 1024 + col0;
#pragma unroll
                for (int bj = 0; bj < 2; ++bj) { const v4u gw = *(const v4u*)(gate + off + bj * 128);
                    v4u aw = {0u, 0u, 0u, 0u}; if (add) aw = *(const v4u*)(add + off + bj * 128);
                    const f32x4 v0 = acc[ai][bj][m][0], v1 = acc[ai][bj][m][1];
                    v4u w;
                    w.x = pk2(bflo(aw.x) + bflo(gw.x) * v0[0], bfhi(aw.x) + bfhi(gw.x) * v0[1]);
                    w.y = pk2(bflo(aw.y) + bflo(gw.y) * v0[2], bfhi(aw.y) + bfhi(gw.y) * v0[3]);
                    w.z = pk2(bflo(aw.z) + bflo(gw.z) * v1[0], bfhi(aw.z) + bfhi(gw.z) * v1[1]);
                    w.w = pk2(bflo(aw.w) + bflo(gw.w) * v1[2], bfhi(aw.w) + bfhi(gw.w) * v1[3]);
                    *(v4u*)(out + off + bj * 128) = w; } }
    }
};
struct EpiResid {
    static constexpr bool PERM = false, AFTER_DRAIN = false;
    const float* res; float* out;
    __device__ __forceinline__ void operator()(const f32x4 (&acc)[2][2][4][2], const pg8::Unit& u, int wr, int wc, int fr, int fq) const {
        const int row0 = u.pm * 256 + wr * 64 + fr, col0 = u.pn * 256 + wc * 32 + 4 * fq;
#pragma unroll
        for (int ai = 0; ai < 2; ++ai)
#pragma unroll
            for (int m = 0; m < 4; ++m) { const size_t off = (size_t)(row0 + ai * 128 + m * 16) * 1024 + col0;
#pragma unroll
                for (int bj = 0; bj < 2; ++bj)
#pragma unroll
                    for (int n = 0; n < 2; ++n) { const f32x4 r = *(const f32x4*)(res + off + bj * 128 + n * 16); *(f32x4*)(out + off + bj * 128 + n * 16) = r + acc[ai][bj][m][n]; } }
    }
};
struct MoeOrder {
    int G, c, nJ, nunits;
    __device__ __forceinline__ bool next(int i, pg8::Unit& u) const {
        const int L = i * G + c; if (L >= nunits) return false;
        const int per_e = 16 * nJ, e = L / per_e, rem = L % per_e, panel = rem / nJ, j = rem % nJ;
        u.pm = ((panel >> 2) * 16 + e) * 4 + (panel & 3); u.pn = e * nJ + j; return true;
    }
    __device__ __forceinline__ void a_ready(const pg8::Unit&) const {}
    __device__ __forceinline__ void done(const pg8::Unit&) const {}
};
struct EpiSwiglu {
    static constexpr bool PERM = true, AFTER_DRAIN = false;
    bf16* hid;
    __device__ __forceinline__ void operator()(const f32x4 (&acc)[2][2][4][2], const pg8::Unit& u, int wr, int wc, int fr, int fq) const {
        const int row0 = u.pm * 256 + wr * 64 + fr, col0 = (u.pn & 15) * 128 + wc * 32 + 8 * fq;
#pragma unroll
        for (int ai = 0; ai < 2; ++ai)
#pragma unroll
            for (int m = 0; m < 4; ++m) { bf16* dst = hid + (size_t)(row0 + ai * 128 + m * 16) * DFF + col0;
                float o[8];
#pragma unroll
                for (int n = 0; n < 2; ++n)
#pragma unroll
                    for (int e = 0; e < 4; ++e) { const float gt = acc[ai][0][m][n][e], up = acc[ai][1][m][n][e]; o[4 * n + e] = gt * sigmoidf_(gt) * up; }
                v4u w; w.x = pk2(o[0], o[1]); w.y = pk2(o[2], o[3]); w.z = pk2(o[4], o[5]); w.w = pk2(o[6], o[7]);
                *(v4u*)dst = w; }
    }
};
struct EpiDown {
    static constexpr bool PERM = true, AFTER_DRAIN = false;
    bf16* eo; const float* gatev;
    __device__ __forceinline__ void operator()(const f32x4 (&acc)[2][2][4][2], const pg8::Unit& u, int wr, int wc, int fr, int fq) const {
        const int row0 = u.pm * 256 + wr * 64 + fr, col0 = (u.pn & 3) * 256 + wc * 32 + 8 * fq;
#pragma unroll
        for (int ai = 0; ai < 2; ++ai)
#pragma unroll
            for (int m = 0; m < 4; ++m) { const int row = row0 + ai * 128 + m * 16; const float gt = gatev[row]; bf16* dst = eo + (size_t)row * 1024 + col0;
#pragma unroll
                for (int bj = 0; bj < 2; ++bj) { const f32x4 v0 = acc[ai][bj][m][0] * gt, v1 = acc[ai][bj][m][1] * gt;
                    v4u w; w.x = pk2(v0[0], v0[1]); w.y = pk2(v0[2], v0[3]); w.z = pk2(v1[0], v1[1]); w.w = pk2(v1[2], v1[3]);
                    *(v4u*)(dst + bj * 128) = w; } }
    }
};

__device__ __forceinline__ void tr_item(const float* W, int ldw, int k0, int n0, bf16* dst, size_t drow0, int ldd, LAS float* scr, int lane) {
#pragma unroll 8
    for (int i = 0; i < 32; ++i) { const int kk = 2 * i + (lane >> 5); scr[kk * 33 + (lane & 31)] = W[(size_t)(k0 + kk) * ldw + n0 + (lane & 31)]; }
    LDS_WAIT(); asm volatile("" ::: "memory");
    const int c = lane & 7;
#pragma unroll
    for (int j = 0; j < 4; ++j) { const int n = (lane >> 3) + 8 * j; const LAS float* s = scr + (8 * c) * 33 + n;
        v4u o; o.x = pk2(s[0 * 33], s[1 * 33]); o.y = pk2(s[2 * 33], s[3 * 33]); o.z = pk2(s[4 * 33], s[5 * 33]); o.w = pk2(s[6 * 33], s[7 * 33]);
        *(v4u*)(dst + (drow0 + n) * (size_t)ldd + k0 + 8 * c) = o; }
    LDS_WAIT(); asm volatile("" ::: "memory");
}
__device__ __forceinline__ void rms_row(const float* xrow, const float* gain, int lane, f32x4 (&o)[4]) {
    const f32x4* xr = (const f32x4*)xrow + lane; float s = 0.f;
#pragma unroll
    for (int j = 0; j < 4; ++j) { o[j] = xr[64 * j]; s += (o[j].x * o[j].x + o[j].y * o[j].y) + (o[j].z * o[j].z + o[j].w * o[j].w); }
    const float rstd = 1.0f / sqrtf(wave_sum(s) * (1.0f / DM) + RMS_EPS);
#pragma unroll
    for (int j = 0; j < 4; ++j) { const f32x4 g = ((const f32x4*)gain)[64 * j + lane]; o[j] = o[j] * rstd * g; }
}
__device__ __forceinline__ void store_row_bf16(bf16* orow, int lane, const f32x4 (&o)[4]) {
    unsigned long long* o8 = (unsigned long long*)orow + lane;
#pragma unroll
    for (int j = 0; j < 4; ++j) o8[64 * j] = (unsigned long long)pk2(o[j].x, o[j].y) | ((unsigned long long)pk2(o[j].z, o[j].w) << 32);
}

__device__ const float ROPE_INV[16] = {1.0f, 0.44036659598350525f, 0.1939227432012558f, 0.08539710193872452f, 0.03760603070259094f, 0.01656043902039528f, 0.007292664609849453f, 0.0032114458736032248f,
    0.0014142135623842478f, 0.000622772378847003f, 0.00027424818836152554f, 0.00012076973507646471f, 5.318296098266728e-05f, 2.34199997066753e-05f, 1.0313386155758053e-05f, 4.541670477919979e-06f};

__device__ __forceinline__ void phase_prep(LAS unsigned char* lds, int tid) {
    const int wave = tid >> 6, lane = tid & 63, G = gridDim.x;
    LAS float* scr = (LAS float*)(lds + wave * 16384);
    const int gw = blockIdx.x * 8 + wave, NGW = G * 8;
    unsigned char* ws = KWS();
    const float* w_in = KIN(I_W_IN); const float* p_rnn = KIN(I_P_RNN); const float* p_attn = KIN(I_P_ATTN); const float* w_out = KIN(I_W_OUT);
    constexpr int I_WIN = 16 * 272, I_PR = 16 * 32, I_PA = 8 * 32, I_WO = 16 * 32, NIT = I_WIN + I_PR + I_PA + I_WO;
    for (int it = gw; it < NIT; it += NGW) {
        int r = it;
        if (r < I_WIN) { const int kb = r / 272, nb = r % 272; tr_item(w_in, D_IN, kb * 64, nb * 32, (bf16*)(ws + WS_WIN), nb * 32, 1024, scr, lane); continue; } r -= I_WIN;
        if (r < I_PR) { const int kb = r / 32, nb = r % 32; tr_item(p_rnn, 1024, kb * 64, nb * 32, (bf16*)(ws + WS_PRNN), nb * 32, 1024, scr, lane); continue; } r -= I_PR;
        if (r < I_PA) { const int kb = r / 32, nb = r % 32; tr_item(p_attn, 1024, kb * 64, nb * 32, (bf16*)(ws + WS_PATT), nb * 32, 512, scr, lane); continue; } r -= I_PA;
        { const int kb = r / 32, nb = r % 32; tr_item(w_out, 1024, kb * 64, nb * 32, (bf16*)(ws + WS_WOUT), nb * 32, 1024, scr, lane); }
    }
    for (int i = blockIdx.x * 512 + tid; i < SEQ * 16; i += G * 512) {
        const int pos = i >> 4, k = i & 15;
        const float ang = (float)pos * ROPE_INV[k];
        const double a = (double)ang;
        const double kq = __builtin_rint(a * 0.63661977236758134308);
        double y = __builtin_fma(-kq, 1.57079632679489655800e+00, a); y = __builtin_fma(-kq, 6.12323399573676603587e-17, y);
        const int q = ((int)kq) & 3;
        const double y2 = y * y;
        const double sp = y * (1.0 + y2 * (-1.0 / 6 + y2 * (1.0 / 120 + y2 * (-1.0 / 5040 + y2 * (1.0 / 362880 + y2 * (-1.0 / 39916800 + y2 * (1.0 / 6227020800.0)))))));
        const double cp = 1.0 + y2 * (-0.5 + y2 * (1.0 / 24 + y2 * (-1.0 / 720 + y2 * (1.0 / 40320 + y2 * (-1.0 / 3628800 + y2 * (1.0 / 479001600.0 + y2 * (-1.0 / 87178291200.0)))))));
        double sv, cv;
        if (q == 0) { sv = sp; cv = cp; } else if (q == 1) { sv = cp; cv = -sp; } else if (q == 2) { sv = -sp; cv = -cp; } else { sv = -cp; cv = sp; }
        ((float*)(ws + WS_COS))[i] = (float)cv; ((float*)(ws + WS_SIN))[i] = (float)sv;
    }
    { const float* rgw = KIN(I_RG_W); const float* cvw = KIN(I_CONV_W);
      for (int f = blockIdx.x * 512 + tid; f < 2 * 8 * 8 * 32 * 64; f += G * 512) {
        const int ln = f & 63, frag = f >> 6, kk = frag & 3, tap = (frag >> 2) & 3, g = (frag >> 4) & 1, u = frag >> 5, cg = u & 7, n = (u >> 3) & 7, dir = u >> 6, fr = ln & 15, fq = ln >> 4;
        const float* wp = rgw + ((size_t)(((dir * 2 + g) * 8 + n) * 128 + kk * 32 + 8 * fq)) * 128 + cg * 16 + fr;
        const float* cp = cvw + tap * 1024 + n * 128 + kk * 32 + 8 * fq;
        v4u w; w.x = pk2(wp[0] * cp[0], wp[128] * cp[1]); w.y = pk2(wp[256] * cp[2], wp[384] * cp[3]); w.z = pk2(wp[512] * cp[4], wp[640] * cp[5]); w.w = pk2(wp[768] * cp[6], wp[896] * cp[7]);
        ((v4u*)(ws + WS_RGWF))[f] = w; }
      const float* rgb = KIN(I_RG_B); const float* cvb = KIN(I_CONV_B);
      for (int i = blockIdx.x * 512 + tid; i < 4096; i += G * 512) { const int dg = i >> 10, cc = i & 1023, n = cc >> 7, j = cc & 127; float s = rgb[i];
        for (int k = 0; k < 128; ++k) s += cvb[n * 128 + k] * rgw[((size_t)((dg * 8 + n) * 128 + k)) * 128 + j];
        ((float*)(ws + WS_RGBIAS))[i] = s; } }
    const float* xin = KIN(I_X); const float* nmix = KIN(I_NORM_MIX);
    for (int m = gw; m < TALL; m += NGW) { f32x4 o[4]; rms_row(xin + (size_t)m * DM, nmix, lane, o); store_row_bf16((bf16*)(ws + WS_XN) + (size_t)m * DM, lane, o); }
}

constexpr int RNN_RING_BYTES = 64 * 272, RNN_FLAG_OFF = 4 * RNN_RING_BYTES;
__device__ __forceinline__ void rnn_wave(LAS unsigned char* ring, volatile LAS unsigned* myflag, volatile LAS unsigned* otherflag, unsigned epoch,
                                         int b, int n, int cg, int dir, const bf16* xr, bf16* ggr, bf16* hx, const v4u* rgwf, const float* rgbias, int lane) {
    const int fr = lane & 15, fq = lane >> 4;
    const int c = n * 128 + cg * 16 + fr;
    bf16x8 Wg[2][4][4];
    { const v4u* wp = rgwf + ((size_t)((dir * 8 + n) * 8 + cg) * 32) * 64 + lane;
#pragma unroll
      for (int g = 0; g < 2; ++g)
#pragma unroll
        for (int tap = 0; tap < 4; ++tap)
#pragma unroll
          for (int kk = 0; kk < 4; ++kk) Wg[g][tap][kk] = __builtin_bit_cast(bf16x8, wp[((g * 4 + tap) * 4 + kk) * 64]); }
    const float br = rgbias[(dir * 2 + 0) * 1024 + c], bi = rgbias[(dir * 2 + 1) * 1024 + c];
    const float* conv_w = KIN(I_CONV_W); const float* conv_b = KIN(I_CONV_B); const float* rgl = KIN(I_RG_LAM);
    const float cw0 = conv_w[c], cw1 = conv_w[1024 + c], cw2 = conv_w[2048 + c], cw3 = conv_w[3072 + c], cbv = conv_b[c];
    const float spl2 = 8.0f * log1pf(expf(-rgl[dir * 1024 + c])) * 1.4426950408889634f;
    const bf16* xb = xr + (size_t)b * SEQ * 1024 + n * 128;
    const size_t orow = (size_t)b * SEQ;
    for (int i = lane; i < RNN_RING_BYTES / 16; i += 64) *(LAS v4u*)(ring + i * 16) = (v4u){0u, 0u, 0u, 0u};
    const int lrow = lane >> 4, lch = lane & 15;
    v4u pf[4];
#define RNN_LOAD(kt) do { const int kt_ = (kt); const bool ok_ = kt_ >= 0 && kt_ < 512; _Pragma("unroll") for (int i = 0; i < 4; ++i) { pf[i] = (v4u){0u, 0u, 0u, 0u}; \
        if (ok_) pf[i] = *(const v4u*)(xb + (size_t)(kt_ * 16 + lrow + 4 * i) * 1024 + lch * 8); } } while (0)
#define RNN_WRITE(kt) do { const int kt_ = (kt); _Pragma("unroll") for (int i = 0; i < 4; ++i) *(LAS v4u*)(ring + (((kt_ & 3) * 16 + lrow + 4 * i)) * 272 + lch * 16) = pf[i]; } while (0)
    { const int k0 = dir ? 511 : 0; RNN_LOAD(k0); RNN_WRITE(k0); RNN_LOAD(dir ? 510 : 1); }
    float carry = 0.f;
    for (int s = 0; s < 512; ++s) {
        const int k = dir ? 511 - s : s, kn = dir ? k - 1 : k + 1, kn2 = dir ? k - 2 : k + 2, t0 = 16 * k;
        RNN_WRITE(kn);
        RNN_LOAD(kn2);
        if (s == 256) {
            asm volatile("s_waitcnt vmcnt(0)" ::: "memory");
            if (lane == 0) *myflag = epoch;
            unsigned spins = 0;
            while ((unsigned)__builtin_amdgcn_readfirstlane((int)*otherflag) != epoch) { __builtin_amdgcn_s_sleep(8); if (++spins > (1u << 24)) break; }
            asm volatile("" ::: "memory");
        }
        const bool second = s >= 256;
        float gv[4] = {0.f, 0.f, 0.f, 0.f}, hp[4] = {0.f, 0.f, 0.f, 0.f};
        if (second) {
#pragma unroll
            for (int r = 0; r < 4; ++r) { const size_t o = (orow + t0 + 4 * fq + r) * 1024 + c;
                gv[r] = bf2f(ggr[o]); hp[r] = bf2f(__hip_atomic_load(hx + o, __ATOMIC_RELAXED, __HIP_MEMORY_SCOPE_AGENT)); } }
        f32x4 ar = {br, br, br, br}, ai = {bi, bi, bi, bi};
#pragma unroll
        for (int tap = 0; tap < 4; ++tap)
#pragma unroll
            for (int kk = 0; kk < 4; ++kk) { const bf16x8 a = *(const LAS bf16x8*)(ring + ((t0 + fr + tap - 2) & 63) * 272 + (kk * 32 + 8 * fq) * 2);
                ar = __builtin_amdgcn_mfma_f32_16x16x32_bf16(a, Wg[0][tap][kk], ar, 0, 0, 0); ai = __builtin_amdgcn_mfma_f32_16x16x32_bf16(a, Wg[1][tap][kk], ai, 0, 0, 0); }
        float xv[7];
#pragma unroll
        for (int d = 0; d < 7; ++d) xv[d] = bf2f(*(const LAS unsigned short*)(ring + ((t0 + 4 * fq - 2 + d) & 63) * 272 + (cg * 16 + fr) * 2));
        float av[4], uv[4];
#pragma unroll
        for (int r = 0; r < 4; ++r) {
            const float xc = cbv + cw0 * xv[r] + cw1 * xv[r + 1] + cw2 * xv[r + 2] + cw3 * xv[r + 3];
            const float rg = __builtin_amdgcn_rcpf(1.0f + __builtin_amdgcn_exp2f(-1.4426950408889634f * ar[r]));
            const float ig = __builtin_amdgcn_rcpf(1.0f + __builtin_amdgcn_exp2f(-1.4426950408889634f * ai[r]));
            const float a = __builtin_amdgcn_exp2f(-spl2 * rg);
            av[r] = a; uv[r] = xc * ig * __builtin_amdgcn_sqrtf(fmaxf(1.0f - a * a, 0.f)); }
        float hl[4], pl[4]; float H = 0.f, P = 1.f;
        if (dir == 0) {
#pragma unroll
            for (int r = 0; r < 4; ++r) { H = av[r] * H + uv[r]; P *= av[r]; hl[r] = H; pl[r] = P; }
        } else {
#pragma unroll
            for (int r = 3; r >= 0; --r) { H = av[r] * H + uv[r]; P *= av[r]; hl[r] = H; pl[r] = P; }
        }
        float Pq[4], Hq[4];
#pragma unroll
        for (int qq = 0; qq < 4; ++qq) { Pq[qq] = __shfl(P, fr + 16 * qq); Hq[qq] = __shfl(H, fr + 16 * qq); }
        float Pc = 1.f, Hc = 0.f, Pw = 1.f, Hw = 0.f;
        if (dir == 0) {
#pragma unroll
            for (int qq = 0; qq < 4; ++qq) { if (qq < fq) { Hc = Pq[qq] * Hc + Hq[qq]; Pc *= Pq[qq]; } Hw = Pq[qq] * Hw + Hq[qq]; Pw *= Pq[qq]; }
        } else {
#pragma unroll
            for (int qq = 3; qq >= 0; --qq) { if (qq > fq) { Hc = Pq[qq] * Hc + Hq[qq]; Pc *= Pq[qq]; } Hw = Pq[qq] * Hw + Hq[qq]; Pw *= Pq[qq]; }
        }
        const float Hs = Pc * carry + Hc;
        carry = Pw * carry + Hw;
#pragma unroll
        for (int r = 0; r < 4; ++r) { const float h = pl[r] * Hs + hl[r]; const size_t o = (orow + t0 + 4 * fq + r) * 1024 + c;
            if (!second) hx[o] = (bf16)f2bf(h); else ggr[o] = (bf16)f2bf(gv[r] * (hp[r] + h)); }
    }
#undef RNN_LOAD
#undef RNN_WRITE
}

__device__ __forceinline__ void attn_unit(const bf16* Q, const bf16* K, const bf16* V, int L, int q0, bf16* og, float* lse, size_t tok_base, int dil, int rr, int h,
                                          LAS unsigned char* lds, int tid) {
    const int wave = tid >> 6, lane = tid & 63, fr = lane & 15, fq = lane >> 4;
    LAS unsigned char* kv = lds;
    LAS unsigned char* pb = lds + 73728 + wave * 5376;
    const int k0 = q0 - 64;
#pragma unroll
    for (int i = 0; i < 8; ++i) { const int idx = tid + 512 * i, row = idx >> 4, ch = idx & 15, gk = k0 + row;
        v4u v = {0u, 0u, 0u, 0u}; if (gk >= 0 && gk < L) v = *(const v4u*)(K + (size_t)gk * 128 + ch * 8);
        *(LAS v4u*)(kv + row * 272 + ch * 16) = v; }
    bf16x8 qf[4];
#pragma unroll
    for (int kk = 0; kk < 4; ++kk) qf[kk] = *(const bf16x8*)(Q + (size_t)(q0 + 16 * wave + fr) * 128 + kk * 32 + 8 * fq);
    __syncthreads();
    f32x4 s[9];
#pragma unroll
    for (int kt = 0; kt < 9; ++kt) { s[kt] = (f32x4){0.f, 0.f, 0.f, 0.f};
#pragma unroll
        for (int kk = 0; kk < 4; ++kk) { const bf16x8 b = *(const LAS bf16x8*)(kv + ((wave + kt) * 16 + fr) * 272 + (kk * 32 + 8 * fq) * 2);
            s[kt] = __builtin_amdgcn_mfma_f32_16x16x32_bf16(qf[kk], b, s[kt], 0, 0, 0); } }
    const float scale = 0.08838834764831845f;
    float mx[4] = {-1e30f, -1e30f, -1e30f, -1e30f};
#pragma unroll
    for (int kt = 0; kt < 9; ++kt) { const int lk = (wave + kt) * 16 + fr, gk = k0 + lk;
#pragma unroll
        for (int r = 0; r < 4; ++r) { const int lq = 16 * wave + 4 * fq + r, rel = lk - 64 - lq;
            const bool valid = (rel >= -64) && (rel <= 64) && (gk >= 0) && (gk < L);
            const float sv = valid ? s[kt][r] * scale : -1e30f; s[kt][r] = sv; mx[r] = fmaxf(mx[r], sv); } }
#pragma unroll
    for (int r = 0; r < 4; ++r) {
#pragma unroll
        for (int o = 1; o < 16; o <<= 1) mx[r] = fmaxf(mx[r], __shfl_xor(mx[r], o)); }
    float sum[4] = {0.f, 0.f, 0.f, 0.f};
#pragma unroll
    for (int kt = 0; kt < 9; ++kt)
#pragma unroll
        for (int r = 0; r < 4; ++r) { const float pv = __expf(s[kt][r] - mx[r]); sum[r] += pv;
            *(LAS unsigned short*)(pb + (4 * fq + r) * 336 + (kt * 16 + fr) * 2) = (unsigned short)f2bf(pv); }
#pragma unroll
    for (int r = 0; r < 4; ++r) {
#pragma unroll
        for (int o = 1; o < 16; o <<= 1) sum[r] += __shfl_xor(sum[r], o); }
    *(LAS v2u*)(pb + (lane >> 2) * 336 + 288 + (lane & 3) * 8) = (v2u){0u, 0u};
    __syncthreads();
    if (tid < 384) { const int row = tid / 3, part = tid % 3; *(LAS v4u*)(kv + row * 560 + 512 + part * 16) = (v4u){0u, 0u, 0u, 0u}; }
#pragma unroll
    for (int i = 0; i < 8; ++i) { const int idx = tid + 512 * i, row = idx >> 4, ch = idx & 15, gk = k0 + row;
        v4u v = {0u, 0u, 0u, 0u}; if (gk >= 0 && gk < L) v = *(const v4u*)(V + (size_t)gk * 128 + ch * 8);
        LAS unsigned char* d = kv + (ch * 8) * 560 + row * 2;
        *(LAS unsigned short*)(d + 0 * 560) = (unsigned short)(v.x & 0xffffu); *(LAS unsigned short*)(d + 1 * 560) = (unsigned short)(v.x >> 16);
        *(LAS unsigned short*)(d + 2 * 560) = (unsigned short)(v.y & 0xffffu); *(LAS unsigned short*)(d + 3 * 560) = (unsigned short)(v.y >> 16);
        *(LAS unsigned short*)(d + 4 * 560) = (unsigned short)(v.z & 0xffffu); *(LAS unsigned short*)(d + 5 * 560) = (unsigned short)(v.z >> 16);
        *(LAS unsigned short*)(d + 6 * 560) = (unsigned short)(v.w & 0xffffu); *(LAS unsigned short*)(d + 7 * 560) = (unsigned short)(v.w >> 16); }
    __syncthreads();
    f32x4 o[8];
#pragma unroll
    for (int nt = 0; nt < 8; ++nt) o[nt] = (f32x4){0.f, 0.f, 0.f, 0.f};
#pragma unroll
    for (int kk = 0; kk < 5; ++kk) { const bf16x8 a = *(const LAS bf16x8*)(pb + fr * 336 + (kk * 32 + 8 * fq) * 2);
#pragma unroll
        for (int nt = 0; nt < 8; ++nt) { const bf16x8 b = *(const LAS bf16x8*)(kv + (nt * 16 + fr) * 560 + (wave * 16 + kk * 32 + 8 * fq) * 2);
            o[nt] = __builtin_amdgcn_mfma_f32_16x16x32_bf16(a, b, o[nt], 0, 0, 0); } }
#pragma unroll
    for (int r = 0; r < 4; ++r) { const float inv = 1.0f / sum[r]; const int j = q0 + 16 * wave + 4 * fq + r; const size_t t = tok_base + (size_t)j * dil + rr;
#pragma unroll
        for (int nt = 0; nt < 8; ++nt) og[t * 512 + h * 128 + nt * 16 + fr] = (bf16)f2bf(o[nt][r] * inv);
        if (fr == 0) lse[t * 4 + h] = mx[r] + __logf(sum[r]); }
    __syncthreads();
}

__device__ __forceinline__ unsigned block_sum_u32(unsigned v, LAS unsigned* red, int tid) {
#pragma unroll
    for (int o = 1; o < 64; o <<= 1) v += __shfl_xor(v, o);
    if ((tid & 63) == 0) red[tid >> 6] = v;
    __syncthreads();
    unsigned t = 0;
#pragma unroll
    for (int w = 0; w < 8; ++w) t += red[w];
    __syncthreads();
    return t;
}
__device__ __forceinline__ void topk_unit(const float* aff  , int* idx  , float* gatev  , int* slot  ,
                                          LAS unsigned char* lds, int tid) {
    LAS unsigned* red = (LAS unsigned*)lds;
    LAS unsigned* wtot = (LAS unsigned*)(lds + 64);
    unsigned v[16];
    { const v4u* src = (const v4u*)(aff + tid * 16);
#pragma unroll
      for (int i = 0; i < 4; ++i) { const v4u w = src[i]; v[4 * i] = w.x; v[4 * i + 1] = w.y; v[4 * i + 2] = w.z; v[4 * i + 3] = w.w; } }
    unsigned prefix = 0u;
    for (int bit = 30; bit >= 0; --bit) {
        const unsigned cand = prefix | (1u << bit); unsigned cnt = 0;
#pragma unroll
        for (int k = 0; k < 16; ++k) cnt += (v[k] >= cand) ? 1u : 0u;
        const unsigned tot = block_sum_u32(cnt, red, tid);
        if (tot >= (unsigned)CAP) prefix = cand;
    }
    const unsigned T = prefix;
    unsigned cgt = 0, ceq = 0;
#pragma unroll
    for (int k = 0; k < 16; ++k) { cgt += (v[k] > T) ? 1u : 0u; ceq += (v[k] == T) ? 1u : 0u; }
    const unsigned packed = cgt | (ceq << 16);
    const unsigned total = block_sum_u32(packed, red, tid);
    const unsigned n_gt = total & 0xffffu, need_eq = (unsigned)CAP - n_gt;
    const int lane = tid & 63, wave = tid >> 6;
    unsigned inc = packed;
#pragma unroll
    for (int o = 1; o < 64; o <<= 1) { const unsigned t = __shfl_up(inc, o); if (lane >= o) inc += t; }
    if (lane == 63) wtot[wave] = inc;
    __syncthreads();
    unsigned wpre = 0;
#pragma unroll
    for (int w = 0; w < 8; ++w) if (w < wave) wpre += wtot[w];
    const unsigned excl = wpre + inc - packed;
    unsigned gt_before = excl & 0xffffu, eq_before = excl >> 16;
#pragma unroll
    for (int k = 0; k < 16; ++k) {
        const int t = tid * 16 + k;
        const bool isgt = v[k] > T, iseq = v[k] == T;
        const bool sel = isgt || (iseq && eq_before < need_eq);
        const unsigned c = gt_before + (eq_before < need_eq ? eq_before : need_eq);
        if (sel) { idx[c] = t; gatev[c] = __builtin_bit_cast(float, v[k]); }
        slot[(size_t)t * 16] = sel ? (int)c : -1;
        gt_before += isgt ? 1u : 0u; eq_before += iseq ? 1u : 0u;
    }
    __syncthreads();
}

#ifndef PH_MASK
#define PH_MASK 0xFFFFF
#endif
#define PH_ON(c) (((PH_MASK) >> (c)) & 1)
#ifndef REP_MASK
#define REP_MASK 0
#endif
#define PH_REP(c) for (int rep_ = 0; rep_ < 1 + (((REP_MASK) >> (c)) & 1); ++rep_)
#define PHASE_TID() int tid = threadIdx.x; asm volatile("" : "+v"(tid)); const int lane = tid & 63, wave = __builtin_amdgcn_readfirstlane(tid >> 6); const int gw = blockIdx.x * 8 + wave, NGW = G * 8; (void)lane; (void)gw; (void)NGW
constexpr int N_PHASES = 18;
__global__ void __launch_bounds__(512, 2) mega(Params p) {
    extern __shared__ __attribute__((aligned(16))) unsigned char lds_raw[];
    LAS unsigned char* lds = (LAS unsigned char*)lds_raw;
    const int G = gridDim.x;
    volatile LAS unsigned* MISC = (volatile LAS unsigned*)(lds + MISC_OFF);
    if (threadIdx.x < 32) MISC[threadIdx.x] = 0u;
    __syncthreads();
    const int lo = p.ph_lo, hi = p.ph_hi;
    XcdBarrier bar = xcd_barrier_post((unsigned*)(KWS() + WS_CTL) + CW_BAR + p.li * XCD_BAR_WORDS, MISC + 8);
#define IN(k) (lo <= (k) && (k) < hi)
#define SEAM(k) do { if (IN(k) && IN((k) + 1)) xcd_barrier(bar); } while (0)

    if (PH_ON(0) && IN(0)) PH_REP(0) { PHASE_TID(); phase_prep(lds, tid); }
    SEAM(0);

    if (PH_ON(1) && IN(1)) PH_REP(1) {
        unsigned char* ws = KWS();
        pg8::Gemm g{(const bf16*)(ws + WS_XN), (const bf16*)(ws + WS_WIN), TALL, 6656, DM}; pg8::StaticOrder S; S.init(TALL, 6656, G, (int)blockIdx.x);
        EpiInProj E{KIN(I_B_IN), (bf16*)(ws + WS_XR), (bf16*)(ws + WS_GGR), (bf16*)(ws + WS_QKV), (bf16*)(ws + WS_SGA), (bf16*)(ws + WS_SGB), (const float*)(ws + WS_COS), (const float*)(ws + WS_SIN), 0};
        pg8::gemm_phase<EpiInProj, pg8::StaticOrder, true, true>(lds, g, S, E);
    }
    SEAM(1);

    if (PH_ON(2) && IN(2)) PH_REP(2) { PHASE_TID();
        unsigned char* ws = KWS();
        volatile LAS unsigned* flags = (volatile LAS unsigned*)(lds + RNN_FLAG_OFF);
        if (tid < 8) flags[tid] = 0u;
        __syncthreads();
        if (wave < 4) {
            const int vcu = (G % 8 == 0) ? (int)(blockIdx.x % 8) * (G / 8) + (int)blockIdx.x / 8 : (int)blockIdx.x;
            const int pr = wave >> 1, dir = wave & 1; unsigned epoch = 0;
            for (int unit = vcu * 2 + pr; unit < 512; unit += 2 * G) { ++epoch;
                rnn_wave(lds + wave * RNN_RING_BYTES, flags + pr * 2 + dir, flags + pr * 2 + (dir ^ 1), epoch, unit >> 6, (unit >> 3) & 7, unit & 7, dir,
                         (const bf16*)(ws + WS_XR), (bf16*)(ws + WS_GGR), (bf16*)KOUT(), (const v4u*)(ws + WS_RGWF), (const float*)(ws + WS_RGBIAS), lane); }
        }
        __syncthreads();
    }
    SEAM(2);

    if (PH_ON(3) && IN(3)) PH_REP(3) { PHASE_TID();
        unsigned char* ws = KWS();
        const bf16* qkv = (const bf16*)(ws + WS_QKV); bf16* og = (bf16*)KOUT(); float* lse = (float*)(ws + WS_LSE);
        for (int unit = blockIdx.x; unit < 6144; unit += G) {
            const int g = unit >> 11, rem = unit & 2047, bl = rem >> 8, h = (rem >> 6) & 3, w = rem & 63;
            const int lg = 2 * g, dil = 1 << lg, L = SEQ >> lg, nblk = 64 >> lg, rr = w / nblk, blk = w % nblk;
            const size_t sub = ((size_t)((bl * 4 + h) * dil + rr) * L) * 128;
            const bf16* Qp = qkv + (size_t)(0 * 3 + g) * ((size_t)TALL * 512) + sub;
            const bf16* Kp = qkv + (size_t)(1 * 3 + g) * ((size_t)TALL * 512) + sub;
            const bf16* Vp = qkv + (size_t)(2 * 3 + g) * ((size_t)TALL * 512) + sub;
            attn_unit(Qp, Kp, Vp, L, blk * 128, og + (size_t)g * ((size_t)TALL * 512), lse + (size_t)g * ((size_t)TALL * 4), (size_t)bl * SEQ, dil, rr, h, lds, tid);
        }
    }
    SEAM(3);

    if (PH_ON(4) && IN(4)) PH_REP(4) { PHASE_TID();
        unsigned char* ws = KWS();
        const bf16* og = (const bf16*)KOUT(); const float* lse = (const float*)(ws + WS_LSE); bf16* yatt = (bf16*)KOUT() + (size_t)3 * TALL * 512;
        for (int t = gw; t < TALL; t += NGW) {
            const int h = lane >> 4, d0 = (lane & 15) * 8;
            const float l0 = lse[(size_t)t * 4 + h], l1 = lse[(size_t)TALL * 4 + (size_t)t * 4 + h], l2 = lse[(size_t)TALL * 8 + (size_t)t * 4 + h];
            const float m = fmaxf(l0, fmaxf(l1, l2)); const float e0 = __expf(l0 - m), e1 = __expf(l1 - m), e2 = __expf(l2 - m); const float inv = 1.0f / (e0 + e1 + e2);
            const float w0 = e0 * inv, w1 = e1 * inv, w2 = e2 * inv;
            const size_t o = (size_t)t * 512 + h * 128 + d0;
            const v4u a = *(const v4u*)(og + o), b = *(const v4u*)(og + (size_t)TALL * 512 + o), c = *(const v4u*)(og + (size_t)TALL * 1024 + o);
            v4u r;
            r.x = pk2(w0 * bflo(a.x) + w1 * bflo(b.x) + w2 * bflo(c.x), w0 * bfhi(a.x) + w1 * bfhi(b.x) + w2 * bfhi(c.x));
            r.y = pk2(w0 * bflo(a.y) + w1 * bflo(b.y) + w2 * bflo(c.y), w0 * bfhi(a.y) + w1 * bfhi(b.y) + w2 * bfhi(c.y));
            r.z = pk2(w0 * bflo(a.z) + w1 * bflo(b.z) + w2 * bflo(c.z), w0 * bfhi(a.z) + w1 * bfhi(b.z) + w2 * bfhi(c.z));
            r.w = pk2(w0 * bflo(a.w) + w1 * bflo(b.w) + w2 * bflo(c.w), w0 * bfhi(a.w) + w1 * bfhi(b.w) + w2 * bfhi(c.w));
            *(v4u*)(yatt + o) = r;
        }
    }
    SEAM(4);

    if (PH_ON(5) && IN(5)) PH_REP(5) {
        unsigned char* ws = KWS();
        pg8::Gemm g{(const bf16*)(ws + WS_XN), (const bf16*)(ws + WS_WIN) + (size_t)6656 * DM, TALL, 2048, DM}; pg8::StaticOrder S; S.init(TALL, 2048, G, (int)blockIdx.x);
        EpiInProj E{KIN(I_B_IN), (bf16*)(ws + WS_XR), (bf16*)(ws + WS_GGR), (bf16*)(ws + WS_QKV), (bf16*)(ws + WS_SGA), (bf16*)(ws + WS_SGB), (const float*)(ws + WS_COS), (const float*)(ws + WS_SIN), 26};
        pg8::gemm_phase<EpiInProj, pg8::StaticOrder, true, true>(lds, g, S, E);
    }
    SEAM(5);

    if (PH_ON(6) && IN(6)) PH_REP(6) {
        unsigned char* ws = KWS();
        pg8::Gemm g{(const bf16*)(ws + WS_GGR), (const bf16*)(ws + WS_PRNN), TALL, DM, DM}; pg8::StaticOrder S; S.init(TALL, DM, G, (int)blockIdx.x);
        EpiGate E{(const bf16*)(ws + WS_SGA), nullptr, (bf16*)(ws + WS_MERGED)};
        pg8::gemm_phase<EpiGate, pg8::StaticOrder, true, true>(lds, g, S, E);
    }
    SEAM(6);
    if (PH_ON(7) && IN(7)) {
        unsigned char* ws = KWS();
        pg8::Gemm g{(const bf16*)KOUT() + (size_t)3 * TALL * 512, (const bf16*)(ws + WS_PATT), TALL, DM, 512}; pg8::StaticOrder S; S.init(TALL, DM, G, (int)blockIdx.x);
        EpiGate E{(const bf16*)(ws + WS_SGB), (const bf16*)(ws + WS_MERGED), (bf16*)(ws + WS_MERGED)};
        pg8::gemm_phase<EpiGate, pg8::StaticOrder, true, true>(lds, g, S, E);
    }
    SEAM(7);
    if (PH_ON(8) && IN(8)) PH_REP(8) {
        unsigned char* ws = KWS();
        pg8::Gemm g{(const bf16*)(ws + WS_MERGED), (const bf16*)(ws + WS_WOUT), TALL, DM, DM}; pg8::StaticOrder S; S.init(TALL, DM, G, (int)blockIdx.x);
        EpiResid E{KIN(I_X), KOUT()};
        pg8::gemm_phase<EpiResid, pg8::StaticOrder, true, true>(lds, g, S, E);
    }
    SEAM(8);

    if (PH_ON(9) && IN(9)) PH_REP(9) { PHASE_TID();
        unsigned char* ws = KWS();
        LAS float* scr = (LAS float*)(lds + wave * 16384);
        constexpr int I_E = 16 * 1024;
        { const float* wg = KIN(I_W_GATE); const float* wu = KIN(I_W_UP); const float* wd = KIN(I_W_DOWN);
        for (int it = gw; it < 3 * I_E; it += NGW) {
            int r = it;
            if (r < 2 * I_E) { const int up = r >= I_E; r -= up * I_E; const int e = r >> 10, rr2 = r & 1023, kb = rr2 >> 6, nb = rr2 & 63, n0 = nb * 32;
                tr_item((up ? wu : wg) + (size_t)e * DM * DFF, DFF, kb * 64, n0, (bf16*)(ws + WS_WGU), (size_t)e * 4096 + (n0 >> 7) * 256 + (n0 & 127) + up * 128, 1024, scr, lane); continue; }
            r -= 2 * I_E;
            { const int e = r >> 10, rr2 = r & 1023, kb = rr2 >> 5, nb = rr2 & 31, n0 = nb * 32;
              tr_item(wd + (size_t)e * DFF * DM, DM, kb * 64, n0, (bf16*)(ws + WS_WD), (size_t)e * 1024 + n0, 2048, scr, lane); }
        } }
        __syncthreads();
        LAS float* wrT = (LAS float*)lds;
        { const float* wrt = KIN(I_W_ROUTER);
          for (int i = tid; i < DM * NEXP; i += 512) { const int d = i >> 4, e = i & 15; wrT[e * 1024 + d] = wrt[i]; } }
        __syncthreads();
        const float* x2 = KOUT(); const float* nffn = KIN(I_NORM_FFN); const float* brt = KIN(I_B_ROUTER);
        for (int m = gw; m < TALL; m += NGW) {
            f32x4 o[4]; rms_row(x2 + (size_t)m * DM, nffn, lane, o); store_row_bf16((bf16*)(ws + WS_H2) + (size_t)m * DM, lane, o);
            float mine = -3.0e38f;
#pragma unroll 2
            for (int e = 0; e < 16; ++e) { float s = 0.f;
#pragma unroll
                for (int j = 0; j < 4; ++j) { const f32x4 w = *(const LAS f32x4*)(wrT + e * 1024 + j * 256 + 4 * lane); s += (o[j].x * w.x + o[j].y * w.y) + (o[j].z * w.z + o[j].w * w.w); }
                const float tot = wave_sum(s) + brt[e]; mine = (lane == e) ? tot : mine; }
            float mx = mine;
#pragma unroll
            for (int of = 1; of < 16; of <<= 1) mx = fmaxf(mx, __shfl_xor(mx, of));
            const float ex = expf(mine - mx); float den = ex;
#pragma unroll
            for (int of = 1; of < 16; of <<= 1) den += __shfl_xor(den, of);
            const int b = m >> 13, s = m & (SEQ - 1);
            if (lane < 16) ((float*)(ws + WS_AFF))[((size_t)(b * 16 + lane)) * SEQ + s] = ex / den;
        }
        __syncthreads();
    }
    SEAM(9);

    if (PH_ON(10) && IN(10)) PH_REP(10) { PHASE_TID();
        unsigned char* ws = KWS();
        for (int unit = blockIdx.x; unit < BATCH * NEXP; unit += G) { const int b = unit >> 4, e = unit & 15;
            topk_unit((const float*)(ws + WS_AFF) + (size_t)unit * SEQ, (int*)(ws + WS_IDX) + unit * CAP, (float*)(ws + WS_GATEV) + unit * CAP, (int*)(ws + WS_SLOT) + (size_t)b * SEQ * 16 + e, lds, tid); }
    }
    SEAM(10);

    for (int half = 0; half < 2; ++half) {
        const int pb0 = 11 + 3 * half;
        if (PH_ON(11) && IN(pb0 + 0)) PH_REP(11) { PHASE_TID();
            unsigned char* ws = KWS();
            const int* idx = (const int*)(ws + WS_IDX) + half * 65536; bf16* xg = (bf16*)(ws + WS_XG);
            for (int r = gw; r < 65536; r += NGW) { const int b = half * 4 + (r >> 14), t = idx[r];
                const v4u* src = (const v4u*)((const bf16*)(ws + WS_H2) + ((size_t)b * SEQ + t) * DM); v4u* dst = (v4u*)(xg + (size_t)r * DM);
                dst[lane] = src[lane]; dst[lane + 64] = src[lane + 64]; }
        }
        SEAM(pb0 + 0);
        if (PH_ON(12) && IN(pb0 + 1)) PH_REP(12) {
            unsigned char* ws = KWS();
            pg8::Gemm g{(const bf16*)(ws + WS_XG), (const bf16*)(ws + WS_WGU), 65536, 65536, DM}; MoeOrder S{G, (int)blockIdx.x, 16, 4096};
            EpiSwiglu E{(bf16*)(ws + WS_HID)};
            pg8::gemm_phase<EpiSwiglu, MoeOrder, true, true>(lds, g, S, E);
        }
        SEAM(pb0 + 1);
        if (PH_ON(13) && IN(pb0 + 2)) PH_REP(13) {
            unsigned char* ws = KWS();
            pg8::Gemm g{(const bf16*)(ws + WS_HID), (const bf16*)(ws + WS_WD), 65536, 16384, DFF}; MoeOrder S{G, (int)blockIdx.x, 4, 1024};
            EpiDown E{(bf16*)(ws + WS_EO) + (size_t)half * 65536 * DM, (const float*)(ws + WS_GATEV) + half * 65536};
            pg8::gemm_phase<EpiDown, MoeOrder, true, true>(lds, g, S, E);
        }
        SEAM(pb0 + 2);
    }

    if (PH_ON(14) && IN(17)) { PHASE_TID();
        unsigned char* ws = KWS();
        const bf16* eo = (const bf16*)(ws + WS_EO); float* outp = KOUT(); const float* nfin = KIN(I_NORM_FINAL);
        for (int m = gw; m < TALL; m += NGW) {
            const int b = m >> 13;
            float* xrow = outp + (size_t)m * DM;
            f32x4 v[4];
#pragma unroll
            for (int j = 0; j < 4; ++j) v[j] = ((const f32x4*)xrow)[64 * j + lane];
            const int* sl = (const int*)(ws + WS_SLOT) + (size_t)m * 16;
            for (int e = 0; e < 16; ++e) { const int c = sl[e];
                if (c >= 0) { const unsigned long long* er = (const unsigned long long*)(eo + ((size_t)(b * 16 + e) * CAP + c) * DM) + lane;
#pragma unroll
                    for (int j = 0; j < 4; ++j) { const unsigned long long w = er[64 * j]; const unsigned w0 = (unsigned)w, w1 = (unsigned)(w >> 32);
                        v[j].x += bflo(w0); v[j].y += bfhi(w0); v[j].z += bflo(w1); v[j].w += bfhi(w1); } } }
            float s = 0.f;
#pragma unroll
            for (int j = 0; j < 4; ++j) s += (v[j].x * v[j].x + v[j].y * v[j].y) + (v[j].z * v[j].z + v[j].w * v[j].w);
            const float rstd = 1.0f / sqrtf(wave_sum(s) * (1.0f / DM) + RMS_EPS);
#pragma unroll
            for (int j = 0; j < 4; ++j) { const f32x4 g = ((const f32x4*)nfin)[64 * j + lane]; ((f32x4*)xrow)[64 * j + lane] = v[j] * rstd * g; }
        }
    }
#undef IN
#undef SEAM
}

#ifndef MK_SPLIT
#define MK_SPLIT 0
#endif
extern "C" void kernel_launch(void* const* d_in, const int* in_sizes, int n_in, void* d_out, int out_size, void* d_ws, size_t ws_size, hipStream_t stream) {
    static int grid = 0;
    if (grid == 0) {
        if (n_in != 19 || out_size != TALL * DM || ws_size < WS_END) { fprintf(stderr, "kernel_launch: unexpected shapes (n_in %d out %d ws %zu)\n", n_in, out_size, ws_size); grid = -1; return; }
        int dev = 0, cus = 0, per_cu = 0;
        if (hipGetDevice(&dev) != hipSuccess || hipDeviceGetAttribute(&cus, hipDeviceAttributeMultiprocessorCount, dev) != hipSuccess) { grid = -1; return; }
        if (hipFuncSetAttribute((const void*)mega, hipFuncAttributeMaxDynamicSharedMemorySize, LDS_BYTES) != hipSuccess) { fprintf(stderr, "kernel_launch: hipFuncSetAttribute failed\n"); grid = -1; return; }
        if (hipOccupancyMaxActiveBlocksPerMultiprocessor(&per_cu, (const void*)mega, 512, LDS_BYTES) != hipSuccess || per_cu < 1) { fprintf(stderr, "kernel_launch: occupancy query says %d\n", per_cu); }
        (void)hipGetLastError();
        grid = cus;
    }
    if (grid < 0) return;
    (void)hipMemsetAsync((char*)d_ws + WS_CTL, 0, CTL_ZERO_BYTES, stream);
    Params p{};
    for (int i = 0; i < 19; ++i) p.in[i] = (const float*)d_in[i];
    p.out = (float*)d_out; p.ws = (unsigned char*)d_ws;
#if MK_SPLIT
    for (int k = 0; k < N_PHASES; ++k) { p.ph_lo = k; p.ph_hi = k + 1; p.li = 0; hipLaunchKernelGGL(mega, dim3(grid), dim3(512), LDS_BYTES, stream, p); }
#else
    p.ph_lo = 0; p.ph_hi = N_PHASES; p.li = 0;
    hipLaunchKernelGGL(mega, dim3(grid), dim3(512), LDS_BYTES, stream, p);
#endif
}
```

```cpp
#include <hip/hip_runtime.h>
#include <cstdio>
#include <cstdint>

#define GAS __attribute__((address_space(1)))
#define LAS __attribute__((address_space(3)))

namespace pg8 {
#define PG8_LAS __attribute__((address_space(3)))
typedef unsigned short bf16_t;
typedef short bf16x8 __attribute__((ext_vector_type(8)));
typedef float f32x4 __attribute__((ext_vector_type(4)));
typedef unsigned u32x4 __attribute__((ext_vector_type(4)));
constexpr int BM = 256, BK = 64, HALF = 128, HTB = HALF * BK * 2  , STAGE_BYTES = 8 * HTB, NXCD = 8, WGM = 8;

__host__ __device__ __forceinline__ int lds_byte(int r, int c) { const int st = (r >> 4) * 2 + (c >> 5), rr = r & 15, cc = c & 31, ob = rr * 64 + cc * 2; return st * 1024 + (ob ^ (((ob >> 9) & 1) << 5)); }
__host__ __device__ __forceinline__ void stage_rc(int b, int& R, int& C) { const int st = b / 1024, sb = b % 1024, swz = sb ^ (((sb >> 9) & 1) << 5); R = (st >> 1) * 16 + swz / 64; C = (st & 1) * 32 + (swz % 64) / 2; }
__host__ __device__ __forceinline__ int perm32(int rho) { const int n = rho >> 4, i = rho & 15; return 8 * (i >> 2) + 4 * n + (i & 3); }

struct Unit { int pm, pn; };
struct Gemm { const bf16_t* A; const bf16_t* Bt; int M, N, K; };

struct StaticOrder {
    int nM, nN, nwg, G, c;
    __host__ __device__ void init(int M, int N, int G_, int c_) { nM = M / BM; nN = N / BM; nwg = nM * nN; G = G_; c = c_; }
    __host__ __device__ bool next(int i, Unit& u) const {
        const long L = (long)i * G + c; if (L >= nwg) return false;
        int wgid = (int)L; { const int q = nwg / NXCD, r = nwg % NXCD, xcd = wgid % NXCD, off = wgid / NXCD; wgid = (xcd < r ? xcd * (q + 1) : r * (q + 1) + (xcd - r) * q) + off; }
        const int nig = WGM * nN, gid = wgid / nig, fm = gid * WGM, gsz = (nM - fm) < WGM ? (nM - fm) : WGM;
        u.pm = fm + ((wgid % nig) % gsz); u.pn = (wgid % nig) / gsz; return true;
    }
    __device__ __forceinline__ void a_ready(const Unit&) const {}
    __device__ __forceinline__ void done(const Unit&) const {}
};

__device__ __forceinline__ unsigned cvt_pk_bf16(float lo, float hi) { unsigned r; asm volatile("v_cvt_pk_bf16_f32 %0, %1, %2" : "=v"(r) : "v"(lo), "v"(hi)); return r; }
typedef float f32x2 __attribute__((ext_vector_type(2)));
template <class Epi, class Sched, bool ALIGN_EPI = false, bool SP2 = false>
__device__ __forceinline__ void gemm_phase(PG8_LAS unsigned char* lds, const Gemm g, const Sched& S, const Epi& E) {
    int tid_ = threadIdx.x; asm volatile("" : "+v"(tid_));
    const int tid = tid_, wid = __builtin_amdgcn_readfirstlane(tid >> 6), lane = tid & 63, wr = wid >> 2, wc = wid & 3, fr = lane & 15, fq = lane >> 4;
    const int K = g.K, nt = K / BK;
    unsigned voffA[2], voffB[2];
#pragma unroll
    for (int i = 0; i < 2; ++i) { int R, C; stage_rc(tid * 16 + i * 8192, R, C); const int Rb = Epi::PERM ? ((R & ~31) + perm32(R & 31)) : R;
        voffA[i] = (unsigned)(R * K + C) * 2u; voffB[i] = (unsigned)(Rb * K + C) * 2u; }
    const size_t kstep = (size_t)(BK * 2);
    const size_t hstep = (size_t)HALF * K * 2;
    const size_t tstep = 2 * hstep;
    const unsigned ldsw = (unsigned)wid * 1024u;
    const int aoff = lds_byte(wr * 64 + fr, fq * 8), boff = lds_byte(wc * 32 + fr, fq * 8);
#define PG8_SA(b, h) (((b) * 2 + (h)) * HTB)
#define PG8_SB(b, h) ((4 + (b) * 2 + (h)) * HTB)
#define PG8_STAGE(bufoff, gbase, voff) do { _Pragma("unroll") for (int _i = 0; _i < 2; ++_i) \
        __builtin_amdgcn_global_load_lds((const unsigned*)((const char*)(gbase) + (voff)[_i]), (PG8_LAS unsigned*)(lds + (bufoff) + ldsw + _i * 8192), 16, 0, 0); } while (0)
#define PG8_LDA(dst, b, h) do { _Pragma("unroll") for (int m = 0; m < 4; ++m) _Pragma("unroll") for (int k = 0; k < 2; ++k) dst[m][k] = *(const PG8_LAS bf16x8*)(lds + PG8_SA(b, h) + aoff + m * 2048 + k * 1024); } while (0)
#define PG8_LDB(dst, b, h) do { _Pragma("unroll") for (int n = 0; n < 2; ++n) _Pragma("unroll") for (int k = 0; k < 2; ++k) dst[n][k] = *(const PG8_LAS bf16x8*)(lds + PG8_SB(b, h) + boff + n * 2048 + k * 1024); } while (0)
#define PG8_MMA(ai, bj, At, Bt) do { __builtin_amdgcn_s_setprio(1); _Pragma("unroll") for (int m = 0; m < 4; ++m) _Pragma("unroll") for (int n = 0; n < 2; ++n) _Pragma("unroll") for (int k = 0; k < 2; ++k) \
        acc[ai][bj][m][n] = __builtin_amdgcn_mfma_f32_16x16x32_bf16(Bt[n][k], At[m][k], acc[ai][bj][m][n], 0, 0, 0); __builtin_amdgcn_s_setprio(0); } while (0)
#define PG8_WAIT_V(n) asm volatile("s_waitcnt vmcnt(" #n ")" ::: "memory")
#define PG8_WAIT_L(n) asm volatile("s_waitcnt lgkmcnt(" #n ")" ::: "memory")
#define PG8_BAR __builtin_amdgcn_s_barrier()
#define PG8_SCHED __builtin_amdgcn_sched_barrier(0)
    Unit cur, nxt; int ui = 0;
    if (!S.next(0, cur)) return;
    f32x4 acc[2][2][4][2];
#pragma unroll
    for (int a = 0; a < 2; ++a)
#pragma unroll
        for (int b = 0; b < 2; ++b)
#pragma unroll
            for (int m = 0; m < 4; ++m)
#pragma unroll
                for (int n = 0; n < 2; ++n) acc[a][b][m][n] = (f32x4){0.f, 0.f, 0.f, 0.f};
    bf16x8 At[4][2], B0[2][2], B1[2][2];
    const char* cA = (const char*)g.A + (size_t)cur.pm * tstep; const char* cB = (const char*)g.Bt + (size_t)cur.pn * tstep;
    S.a_ready(cur);
    if constexpr (SP2) {
        PG8_STAGE(PG8_SB(0, 0), cB, voffB); PG8_STAGE(PG8_SB(0, 1), cB + hstep, voffB); PG8_STAGE(PG8_SA(0, 0), cA, voffA); PG8_STAGE(PG8_SA(0, 1), cA + hstep, voffA);
        if (wr == 1) PG8_BAR;
        PG8_WAIT_V(2); PG8_BAR;
        PG8_STAGE(PG8_SB(1, 0), cB + kstep, voffB); PG8_STAGE(PG8_SA(1, 0), cA + kstep, voffA); PG8_STAGE(PG8_SB(1, 1), cB + hstep + kstep, voffB);
        PG8_WAIT_V(6); PG8_BAR;
    } else {
        PG8_STAGE(PG8_SB(0, 0), cB, voffB); PG8_STAGE(PG8_SA(0, 0), cA, voffA); PG8_STAGE(PG8_SB(0, 1), cB + hstep, voffB); PG8_STAGE(PG8_SA(0, 1), cA + hstep, voffA);
        if (wr == 1) PG8_BAR;
        PG8_WAIT_V(4); PG8_BAR;
        PG8_STAGE(PG8_SB(1, 0), cB + kstep, voffB); PG8_STAGE(PG8_SA(1, 0), cA + kstep, voffA); PG8_STAGE(PG8_SB(1, 1), cB + hstep + kstep, voffB);
        PG8_WAIT_V(6); PG8_BAR;
    }
    for (;;) {
        const bool has_next = S.next(ui + 1, nxt);
        const char* nA = has_next ? (const char*)g.A + (size_t)nxt.pm * tstep : cA; const char* nB = has_next ? (const char*)g.Bt + (size_t)nxt.pn * tstep : cB;
        for (int t = 0; t < nt; t += 2) {
            const bool last = (t == nt - 2);
            const char* a1 = cA + (size_t)(t + 1) * kstep;
            const char* a2 = last ? nA : cA + (size_t)(t + 2) * kstep; const char* b2 = last ? nB : cB + (size_t)(t + 2) * kstep;
            const char* a3 = a2 + kstep; const char* b3 = b2 + kstep;
            if (last && has_next) S.a_ready(nxt);
            if constexpr (SP2) {
            PG8_LDB(B0, 0, 0); PG8_LDB(B1, 0, 1); PG8_SCHED; PG8_LDA(At, 0, 0); PG8_STAGE(PG8_SA(1, 1), a1 + hstep, voffA);
            PG8_WAIT_V(8); PG8_WAIT_L(0); PG8_BAR; PG8_MMA(0, 0, At, B0); PG8_MMA(0, 1, At, B1); PG8_BAR; PG8_SCHED;
            PG8_LDA(At, 0, 1); PG8_STAGE(PG8_SB(0, 0), b2, voffB); PG8_STAGE(PG8_SB(0, 1), b2 + hstep, voffB); PG8_STAGE(PG8_SA(0, 0), a2, voffA);
            PG8_WAIT_V(8); PG8_WAIT_L(0); PG8_BAR; PG8_MMA(1, 0, At, B0); PG8_MMA(1, 1, At, B1); PG8_BAR; PG8_SCHED;
            PG8_LDB(B0, 1, 0); PG8_LDB(B1, 1, 1); PG8_SCHED; PG8_LDA(At, 1, 0); PG8_STAGE(PG8_SA(0, 1), a2 + hstep, voffA);
            PG8_WAIT_V(8); PG8_WAIT_L(0); PG8_BAR; PG8_MMA(0, 0, At, B0); PG8_MMA(0, 1, At, B1); PG8_BAR; PG8_SCHED;
            PG8_LDA(At, 1, 1); PG8_STAGE(PG8_SB(1, 0), b3, voffB); PG8_STAGE(PG8_SB(1, 1), b3 + hstep, voffB); PG8_STAGE(PG8_SA(1, 0), a3, voffA);
            PG8_WAIT_V(8); PG8_WAIT_L(0); PG8_BAR; PG8_MMA(1, 0, At, B0); PG8_MMA(1, 1, At, B1); PG8_BAR; PG8_SCHED;
            } else {
            PG8_LDB(B0, 0, 0); PG8_SCHED; PG8_LDA(At, 0, 0); PG8_STAGE(PG8_SA(1, 1), a1 + hstep, voffA);
            PG8_WAIT_L(8); PG8_BAR; PG8_WAIT_L(0); PG8_MMA(0, 0, At, B0); PG8_BAR; PG8_SCHED;
            PG8_LDB(B1, 0, 1); PG8_STAGE(PG8_SB(0, 0), b2, voffB);
            PG8_BAR; PG8_WAIT_L(0); PG8_MMA(0, 1, At, B1); PG8_BAR;
            PG8_LDA(At, 0, 1); PG8_STAGE(PG8_SA(0, 0), a2, voffA);
            PG8_BAR; PG8_WAIT_L(0); PG8_MMA(1, 0, At, B0); PG8_BAR; PG8_SCHED;
            PG8_STAGE(PG8_SB(0, 1), b2 + hstep, voffB);
            PG8_WAIT_V(6); PG8_BAR; PG8_MMA(1, 1, At, B1); PG8_BAR;
            PG8_LDB(B0, 1, 0); PG8_SCHED; PG8_LDA(At, 1, 0); PG8_STAGE(PG8_SA(0, 1), a2 + hstep, voffA);
            PG8_WAIT_L(8); PG8_BAR; PG8_WAIT_L(0); PG8_MMA(0, 0, At, B0); PG8_BAR; PG8_SCHED;
            PG8_LDB(B1, 1, 1); PG8_STAGE(PG8_SB(1, 0), b3, voffB);
            PG8_BAR; PG8_WAIT_L(0); PG8_MMA(0, 1, At, B1); PG8_BAR;
            PG8_LDA(At, 1, 1); PG8_STAGE(PG8_SA(1, 0), a3, voffA);
            PG8_BAR; PG8_WAIT_L(0); PG8_MMA(1, 0, At, B0); PG8_BAR; PG8_SCHED;
            PG8_STAGE(PG8_SB(1, 1), b3 + hstep, voffB);
            PG8_WAIT_V(6); PG8_BAR; PG8_MMA(1, 1, At, B1); PG8_BAR;
            }
        }
        if constexpr (ALIGN_EPI) { if (wr == 0) PG8_BAR; }
        if constexpr (!Epi::AFTER_DRAIN) { E(acc, cur, wr, wc, fr, fq); S.done(cur); }
        if (!has_next) break;
#pragma unroll
        for (int a = 0; a < 2; ++a)
#pragma unroll
            for (int b = 0; b < 2; ++b)
#pragma unroll
                for (int m = 0; m < 4; ++m)
#pragma unroll
                    for (int n = 0; n < 2; ++n) acc[a][b][m][n] = (f32x4){0.f, 0.f, 0.f, 0.f};
        cur = nxt; cA = nA; cB = nB; ++ui;
        if constexpr (ALIGN_EPI) { if (wr == 1) PG8_BAR; }
    }
    PG8_WAIT_V(0);
    if constexpr (!ALIGN_EPI) { if (wr == 0) PG8_BAR; }
    PG8_BAR;
    if constexpr (Epi::AFTER_DRAIN) { E.fused(acc, cur, wr, wc, fr, fq, lds, wid, lane); S.done(cur); }
#undef PG8_SA
#undef PG8_SB
#undef PG8_STAGE
#undef PG8_LDA
#undef PG8_LDB
#undef PG8_MMA
#undef PG8_WAIT_V
#undef PG8_WAIT_L
#undef PG8_BAR
#undef PG8_SCHED
}
}

constexpr int DM = 1024, BATCH = 8, SEQ = 8192, TALL = BATCH * SEQ;
constexpr int HBATCH = 4, TH = HBATCH * SEQ;
constexpr int D_IN = 8704, NEXP = 16, CAP = 1024, DFF = 2048;
constexpr float RMS_EPS = 1e-6f;

typedef unsigned short bf16;
typedef unsigned v4u __attribute__((ext_vector_type(4)));
typedef unsigned v2u __attribute__((ext_vector_type(2)));
typedef float f32x4 __attribute__((ext_vector_type(4)));
typedef short bf16x8 __attribute__((ext_vector_type(8)));

constexpr size_t MiB = 1u << 20;
constexpr size_t WS_CTL = 0, CTL_ZERO_BYTES = 64 * 1024;
constexpr size_t WS_COS = 1 * MiB, WS_SIN = WS_COS + 512 * 1024;
constexpr size_t WS_WIN = 2 * MiB, WS_PRNN = 19 * MiB, WS_PATT = 21 * MiB, WS_WOUT = 22 * MiB;
constexpr size_t WS_AFF = 24 * MiB, WS_IDX = 28 * MiB, WS_GATEV = WS_IDX + 512 * 1024, WS_LSE = 29 * MiB, WS_SLOT = 32 * MiB;
constexpr size_t WS_RGWF = 36 * MiB, WS_RGBIAS = 40 * MiB;
constexpr size_t WS_XN = 44 * MiB;
constexpr size_t WS_XR = 172 * MiB, WS_GGR = 300 * MiB, WS_QKV = 428 * MiB;
constexpr size_t WS_MERGED = WS_XR;
constexpr size_t WS_SGA = WS_QKV, WS_SGB = WS_QKV + 128 * MiB;
constexpr size_t WS_H2 = WS_XN, WS_XG = 172 * MiB, WS_HID = 300 * MiB, WS_EO = 556 * MiB, WS_WGU = 812 * MiB, WS_WD = 940 * MiB, WS_END = 1004 * MiB;
constexpr int CW_BAR = 1024;

constexpr int LDS_BYTES = 147456, MISC_OFF = 131072 + 320;

__device__ __forceinline__ unsigned f2bf(float f) { unsigned u = __builtin_bit_cast(unsigned, f); return (u + 0x7fffu + ((u >> 16) & 1u)) >> 16; }
__device__ __forceinline__ unsigned pk2(float lo, float hi) { unsigned r; asm volatile("v_cvt_pk_bf16_f32 %0, %1, %2" : "=v"(r) : "v"(lo), "v"(hi)); return r; }
__device__ __forceinline__ float bflo(unsigned w) { return __builtin_bit_cast(float, w << 16); }
__device__ __forceinline__ float bfhi(unsigned w) { return __builtin_bit_cast(float, w & 0xffff0000u); }
__device__ __forceinline__ float bf2f(unsigned short b) { return __builtin_bit_cast(float, (unsigned)b << 16); }
__device__ __forceinline__ float wave_sum(float v) {
#pragma unroll
    for (int o = 1; o < 64; o <<= 1) v += __shfl_xor(v, o);
    return v;
}
__device__ __forceinline__ float sigmoidf_(float v) { return 1.0f / (1.0f + __expf(-v)); }
__device__ __forceinline__ float gelu_tanh(float v) { const float u = 0.7978845608028654f * (v + 0.044715f * v * v * v); return v / (1.0f + __expf(-2.0f * u)); }
#define LDS_WAIT() asm volatile("s_waitcnt lgkmcnt(0)" ::: "memory")

#define XB_TMO      128
#define XB_XCNT(j)  (256  + 64 * (j))
#define XB_XSUB(j)  (1280 + 64 * (j))
#define XB_XGEN(j)  (2304 + 64 * (j))
#define XB_TOP      3328
#define XB_TOPGEN   3392
#define XCD_BAR_WORDS 3456
#define XB_SPIN_CAP (1u << 22)

__device__ __forceinline__ unsigned xb_ld(unsigned* p)              { return __hip_atomic_load(p, __ATOMIC_RELAXED, __HIP_MEMORY_SCOPE_AGENT); }
__device__ __forceinline__ unsigned xb_add(unsigned* p, unsigned v) { return __hip_atomic_fetch_add(p, v, __ATOMIC_RELAXED, __HIP_MEMORY_SCOPE_AGENT); }
__device__ __forceinline__ unsigned xb_xcc_id() { return (unsigned)__builtin_amdgcn_s_getreg((3 << 11) | 20) & 0xFu; }
#define XB_SPIN(cond, bar) do { unsigned _sp = 0; while (cond) { __builtin_amdgcn_s_sleep(1); \
    if ((++_sp & 255u) == 0u) { if (xb_ld(&(bar)[XB_TMO])) break; if (_sp > XB_SPIN_CAP) { atomicAdd(&(bar)[XB_TMO], 1u); break; } } } } while (0)

struct XcdBarrier { unsigned* bar; unsigned x; volatile LAS unsigned* st; };

__device__ __forceinline__ XcdBarrier xcd_barrier_post(unsigned* bar, volatile LAS unsigned* st) {
    XcdBarrier b; b.bar = bar; b.x = xb_xcc_id(); b.st = st;
    if (threadIdx.x == 0) (void)xb_add(&bar[XB_XCNT(b.x)], 1u);
    return b;
}
__device__ __forceinline__ void xcd_barrier_complete(unsigned* bar, unsigned x, unsigned& nloc, unsigned& nx) {
    const unsigned G = gridDim.x * gridDim.y * gridDim.z;
    unsigned sum, cnt, mine, sp = 0u;
    for (;;) {
        sum = 0u; cnt = 0u; mine = 0u;
#pragma unroll
        for (unsigned j = 0; j < 16; ++j) { const unsigned c = xb_ld(&bar[XB_XCNT(j)]); sum += c; cnt += (c > 0u) ? 1u : 0u; mine = (j == x) ? c : mine; }
        if (sum == G) break;
        __builtin_amdgcn_s_sleep(1);
        if ((++sp & 255u) == 0u) { if (xb_ld(&bar[XB_TMO])) break; if (sp > XB_SPIN_CAP) { atomicAdd(&bar[XB_TMO], 1u); break; } }
    }
    nloc = mine > 0u ? mine : 1u; nx = cnt > 0u ? cnt : 1u;
}
__device__ __forceinline__ void xcd_barrier(const XcdBarrier& b) {
    asm volatile("s_waitcnt vmcnt(0)" ::: "memory");
    __syncthreads();
    if (threadIdx.x == 0) {
        unsigned* bar = b.bar;
        __builtin_amdgcn_s_waitcnt(0);
        unsigned nloc = b.st[0], nx = b.st[1];
        if (nloc == 0u) { xcd_barrier_complete(bar, b.x, nloc, nx); b.st[0] = nloc; b.st[1] = nx; }
        const unsigned old = xb_add(&bar[XB_XSUB(b.x)], 1u);
        const unsigned gen = old / nloc;
        if (old + 1u == (gen + 1u) * nloc) {
            __builtin_amdgcn_fence(__ATOMIC_RELEASE, "agent");
            asm volatile("s_waitcnt vmcnt(0)" ::: "memory");
            const unsigned og = xb_add(&bar[XB_TOP], 1u);
            const unsigned tg = og / nx;
            if (og + 1u == (tg + 1u) * nx) xb_add(&bar[XB_TOPGEN], 1u);
            else XB_SPIN(xb_ld(&bar[XB_TOPGEN]) == tg, bar);
            __builtin_amdgcn_fence(__ATOMIC_ACQUIRE, "agent");
            xb_add(&bar[XB_XGEN(b.x)], 1u);
            asm volatile("s_waitcnt vmcnt(0)" ::: "memory");
        } else {
            XB_SPIN(xb_ld(&bar[XB_XGEN(b.x)]) == gen, bar);
            __builtin_amdgcn_fence(__ATOMIC_ACQUIRE, "agent");
            asm volatile("s_waitcnt vmcnt(0)" ::: "memory");
        }
    }
    __syncthreads();
}

struct Params {
    const float* in[19];
    float* out;
    unsigned char* ws;
    int ph_lo, ph_hi;
    int li, pad;
};
enum { I_X = 0, I_NORM_MIX, I_W_IN, I_B_IN, I_CONV_W, I_CONV_B, I_RG_W, I_RG_B, I_RG_LAM, I_P_RNN, I_P_ATTN, I_W_OUT, I_NORM_FFN, I_W_ROUTER, I_B_ROUTER, I_W_GATE, I_W_UP, I_W_DOWN, I_NORM_FINAL };

__device__ __forceinline__ unsigned long long karg_u64(int byte_off) {
    const auto ka = __builtin_amdgcn_kernarg_segment_ptr();
    unsigned long long v;
    asm volatile("s_load_dwordx2 %0, %1, %2\n\ts_waitcnt lgkmcnt(0)" : "=s"(v) : "s"(ka), "i"(byte_off) : "memory");
    return v;
}
#define KIN(i) ((const float*)(const GAS float*)karg_u64(8 * (i)))
#define KOUT() ((float*)(GAS float*)karg_u64(152))
#define KWS() ((unsigned char*)(GAS unsigned char*)karg_u64(160))
static_assert(sizeof(Params) == 184, "Params layout");

__device__ __forceinline__ float xlane32(float v, bool lower_half) {
    const unsigned u = __builtin_bit_cast(unsigned, v);
    const auto r = __builtin_amdgcn_permlane32_swap(u, u, false, false);
    return __builtin_bit_cast(float, lower_half ? (unsigned)r[1] : (unsigned)r[0]);
}
struct EpiInProj {
    static constexpr bool PERM = true, AFTER_DRAIN = false;
    const float* bias; bf16* xr; bf16* ggr; bf16* qkv; bf16* sga; bf16* sgb; const float* cosT; const float* sinT; int pn_off;
    __device__ __forceinline__ void operator()(const f32x4 (&acc)[2][2][4][2], const pg8::Unit& u, int wr, int wc, int fr, int fq) const {
        const int pn = u.pn + pn_off;
        const int row0 = u.pm * 256 + wr * 64 + fr, ccol = wc * 32 + 8 * fq, bcol0 = pn * 256 + ccol;
        f32x4 bv[2][2];
#pragma unroll
        for (int bj = 0; bj < 2; ++bj)
#pragma unroll
            for (int n = 0; n < 2; ++n) bv[bj][n] = *(const f32x4*)(bias + bcol0 + bj * 128 + 4 * n);
        __builtin_amdgcn_s_waitcnt(0x0F70);
        if (pn < 8 || pn >= 26) {
            bf16* O; int colt; int act;
            if (pn < 4) { O = xr; colt = pn * 256; act = 0; } else if (pn < 8) { O = ggr; colt = (pn - 4) * 256; act = 1; }
            else if (pn < 30) { O = sga; colt = (pn - 26) * 256; act = 2; } else { O = sgb; colt = (pn - 30) * 256; act = 2; }
#pragma unroll
            for (int ai = 0; ai < 2; ++ai)
#pragma unroll
                for (int m = 0; m < 4; ++m) { bf16* rowp = O + (size_t)(row0 + ai * 128 + m * 16) * 1024 + colt + ccol;
#pragma unroll
                    for (int bj = 0; bj < 2; ++bj) { f32x4 v0 = acc[ai][bj][m][0] + bv[bj][0], v1 = acc[ai][bj][m][1] + bv[bj][1];
                        if (act == 1) {
#pragma unroll
                            for (int e = 0; e < 4; ++e) { v0[e] = gelu_tanh(v0[e]); v1[e] = gelu_tanh(v1[e]); } }
                        if (act == 2) {
#pragma unroll
                            for (int e = 0; e < 4; ++e) { v0[e] = sigmoidf_(v0[e]); v1[e] = sigmoidf_(v1[e]); } }
                        v4u w; w.x = pk2(v0[0], v0[1]); w.y = pk2(v0[2], v0[3]); w.z = pk2(v1[0], v1[1]); w.w = pk2(v1[2], v1[3]);
                        *(v4u*)(rowp + bj * 128) = w; } }
        } else {
            const int q = pn - 8, sec = q / 6, g = (q % 6) >> 1, tig = q & 1;
            const int lg = 2 * g, dil = 1 << lg, L = SEQ >> lg;
            bf16* base = qkv + (size_t)(sec * 3 + g) * ((size_t)TALL * 512);
            const bool rot = (sec < 2) && (wc == 0);
            const float sgn = (fq < 2) ? -1.0f : 1.0f;
#pragma unroll
            for (int ai = 0; ai < 2; ++ai)
#pragma unroll
                for (int m = 0; m < 4; ++m) {
                    const int row = row0 + ai * 128 + m * 16, b = row >> 13, s = row & (SEQ - 1), rr = s & (dil - 1), j = s >> lg;
                    f32x4 cs0 = {1.f, 1.f, 1.f, 1.f}, cs1 = cs0, sn0 = {0.f, 0.f, 0.f, 0.f}, sn1 = sn0;
                    if (rot) { const float* cp = cosT + s * 16 + 8 * (fq & 1); const float* sp = sinT + s * 16 + 8 * (fq & 1);
                        cs0 = *(const f32x4*)cp; cs1 = *(const f32x4*)(cp + 4); sn0 = *(const f32x4*)sp; sn1 = *(const f32x4*)(sp + 4); }
#pragma unroll
                    for (int bj = 0; bj < 2; ++bj) { const int h = 2 * tig + bj;
                        f32x4 v0 = acc[ai][bj][m][0] + bv[bj][0], v1 = acc[ai][bj][m][1] + bv[bj][1];
                        if (rot) {
#pragma unroll
                            for (int e = 0; e < 4; ++e) { const float p0 = xlane32(v0[e], fq < 2), p1 = xlane32(v1[e], fq < 2);
                                v0[e] = v0[e] * cs0[e] + sgn * p0 * sn0[e]; v1[e] = v1[e] * cs1[e] + sgn * p1 * sn1[e]; } }
                        bf16* dst = base + ((size_t)(((b * 4 + h) * dil + rr) * L + j)) * 128 + ccol;
                        v4u w; w.x = pk2(v0[0], v0[1]); w.y = pk2(v0[2], v0[3]); w.z = pk2(v1[0], v1[1]); w.w = pk2(v1[2], v1[3]);
                        *(v4u*)dst = w; } }
        }
        __builtin_amdgcn_s_waitcnt(0x0F70);
    }
};
struct EpiGate {
    static constexpr bool PERM = true, AFTER_DRAIN = false;
    const bf16* gate; const bf16* add; bf16* out;
    __device__ __forceinline__ void operator()(const f32x4 (&acc)[2][2][4][2], const pg8::Unit& u, int wr, int wc, int fr, int fq) const {
        const int row0 = u.pm * 256 + wr * 64 + fr, col0 = u.pn * 256 + wc * 32 + 8 * fq;
#pragma unroll
        for (int ai = 0; ai < 2; ++ai)
#pragma unroll
            for (int m = 0; m < 4; ++m) { const size_t off = (size_t)(row0 + ai * 128 + m * 16) * 1024 + col0;
#pragma unroll
                for (int bj = 0; bj < 2; ++bj) { const v4u gw = *(const v4u*)(gate + off + bj * 128);
                    v4u aw = {0u, 0u, 0u, 0u}; if (add) aw = *(const v4u*)(add + off + bj * 128);
                    const f32x4 v0 = acc[ai][bj][m][0], v1 = acc[ai][bj][m][1];
                    v4u w;
                    w.x = pk2(bflo(aw.x) + bflo(gw.x) * v0[0], bfhi(aw.x) + bfhi(gw.x) * v0[1]);
                    w.y = pk2(bflo(aw.y) + bflo(gw.y) * v0[2], bfhi(aw.y) + bfhi(gw.y) * v0[3]);
                    w.z = pk2(bflo(aw.z) + bflo(gw.z) * v1[0], bfhi(aw.z) + bfhi(gw.z) * v1[1]);
                    w.w = pk2(bflo(aw.w) + bflo(gw.w) * v1[2], bfhi(aw.w) + bfhi(gw.w) * v1[3]);
                    *(v4u*)(out + off + bj * 128) = w; } }
    }
};
struct EpiResid {
    static constexpr bool PERM = false, AFTER_DRAIN = false;
    const float* res; float* out;
    __device__ __forceinline__ void operator()(const f32x4 (&acc)[2][2][4][2], const pg8::Unit& u, int wr, int wc, int fr, int fq) const {
        const int row0 = u.pm * 256 + wr * 64 + fr, col0 = u.pn * 256 + wc * 32 + 4 * fq;
#pragma unroll
        for (int ai = 0; ai < 2; ++ai)
#pragma unroll
            for (int m = 0; m < 4; ++m) { const size_t off = (size_t)(row0 + ai * 128 + m * 16) * 1024 + col0;
#pragma unroll
                for (int bj = 0; bj < 2; ++bj)
#pragma unroll
                    for (int n = 0; n < 2; ++n) { const f32x4 r = *(const f32x4*)(res + off + bj * 128 + n * 16); *(f32x4*)(out + off + bj * 128 + n * 16) = r + acc[ai][bj][m][n]; } }
    }
};
struct MoeOrder {
    int G, c, nJ, nunits;
    __device__ __forceinline__ bool next(int i, pg8::Unit& u) const {
        const int L = i * G + c; if (L >= nunits) return false;
        const int per_e = 16 * nJ, e = L / per_e, rem = L % per_e, panel = rem / nJ, j = rem % nJ;
        u.pm = ((panel >> 2) * 16 + e) * 4 + (panel & 3); u.pn = e * nJ + j; return true;
    }
    __device__ __forceinline__ void a_ready(const pg8::Unit&) const {}
    __device__ __forceinline__ void done(const pg8::Unit&) const {}
};
struct EpiSwiglu {
    static constexpr bool PERM = true, AFTER_DRAIN = false;
    bf16* hid;
    __device__ __forceinline__ void operator()(const f32x4 (&acc)[2][2][4][2], const pg8::Unit& u, int wr, int wc, int fr, int fq) const {
        const int row0 = u.pm * 256 + wr * 64 + fr, col0 = (u.pn & 15) * 128 + wc * 32 + 8 * fq;
#pragma unroll
        for (int ai = 0; ai < 2; ++ai)
#pragma unroll
            for (int m = 0; m < 4; ++m) { bf16* dst = hid + (size_t)(row0 + ai * 128 + m * 16) * DFF + col0;
                float o[8];
#pragma unroll
                for (int n = 0; n < 2; ++n)
#pragma unroll
                    for (int e = 0; e < 4; ++e) { const float gt = acc[ai][0][m][n][e], up = acc[ai][1][m][n][e]; o[4 * n + e] = gt * sigmoidf_(gt) * up; }
                v4u w; w.x = pk2(o[0], o[1]); w.y = pk2(o[2], o[3]); w.z = pk2(o[4], o[5]); w.w = pk2(o[6], o[7]);
                *(v4u*)dst = w; }
    }
};
struct EpiDown {
    static constexpr bool PERM = true, AFTER_DRAIN = false;
    bf16* eo; const float* gatev;
    __device__ __forceinline__ void operator()(const f32x4 (&acc)[2][2][4][2], const pg8::Unit& u, int wr, int wc, int fr, int fq) const {
        const int row0 = u.pm * 256 + wr * 64 + fr, col0 = (u.pn & 3) * 256 + wc * 32 + 8 * fq;
#pragma unroll
        for (int ai = 0; ai < 2; ++ai)
#pragma unroll
            for (int m = 0; m < 4; ++m) { const int row = row0 + ai * 128 + m * 16; const float gt = gatev[row]; bf16* dst = eo + (size_t)row * 1024 + col0;
#pragma unroll
                for (int bj = 0; bj < 2; ++bj) { const f32x4 v0 = acc[ai][bj][m][0] * gt, v1 = acc[ai][bj][m][1] * gt;
                    v4u w; w.x = pk2(v0[0], v0[1]); w.y = pk2(v0[2], v0[3]); w.z = pk2(v1[0], v1[1]); w.w = pk2(v1[2], v1[3]);
                    *(v4u*)(dst + bj * 128) = w; } }
    }
};

__device__ __forceinline__ void tr_item(const float* W, int ldw, int k0, int n0, bf16* dst, size_t drow0, int ldd, LAS float* scr, int lane) {
#pragma unroll 8
    for (int i = 0; i < 32; ++i) { const int kk = 2 * i + (lane >> 5); scr[kk * 33 + (lane & 31)] = W[(size_t)(k0 + kk) * ldw + n0 + (lane & 31)]; }
    LDS_WAIT(); asm volatile("" ::: "memory");
    const int c = lane & 7;
#pragma unroll
    for (int j = 0; j < 4; ++j) { const int n = (lane >> 3) + 8 * j; const LAS float* s = scr + (8 * c) * 33 + n;
        v4u o; o.x = pk2(s[0 * 33], s[1 * 33]); o.y = pk2(s[2 * 33], s[3 * 33]); o.z = pk2(s[4 * 33], s[5 * 33]); o.w = pk2(s[6 * 33], s[7 * 33]);
        *(v4u*)(dst + (drow0 + n) * (size_t)ldd + k0 + 8 * c) = o; }
    LDS_WAIT(); asm volatile("" ::: "memory");
}
__device__ __forceinline__ void rms_row(const float* xrow, const float* gain, int lane, f32x4 (&o)[4]) {
    const f32x4* xr = (const f32x4*)xrow + lane; float s = 0.f;
#pragma unroll
    for (int j = 0; j < 4; ++j) { o[j] = xr[64 * j]; s += (o[j].x * o[j].x + o[j].y * o[j].y) + (o[j].z * o[j].z + o[j].w * o[j].w); }
    const float rstd = 1.0f / sqrtf(wave_sum(s) * (1.0f / DM) + RMS_EPS);
#pragma unroll
    for (int j = 0; j < 4; ++j) { const f32x4 g = ((const f32x4*)gain)[64 * j + lane]; o[j] = o[j] * rstd * g; }
}
__device__ __forceinline__ void store_row_bf16(bf16* orow, int lane, const f32x4 (&o)[4]) {
    unsigned long long* o8 = (unsigned long long*)orow + lane;
#pragma unroll
    for (int j = 0; j < 4; ++j) o8[64 * j] = (unsigned long long)pk2(o[j].x, o[j].y) | ((unsigned long long)pk2(o[j].z, o[j].w) << 32);
}

__device__ const float ROPE_INV[16] = {1.0f, 0.44036659598350525f, 0.1939227432012558f, 0.08539710193872452f, 0.03760603070259094f, 0.01656043902039528f, 0.007292664609849453f, 0.0032114458736032248f,
    0.0014142135623842478f, 0.000622772378847003f, 0.00027424818836152554f, 0.00012076973507646471f, 5.318296098266728e-05f, 2.34199997066753e-05f, 1.0313386155758053e-05f, 4.541670477919979e-06f};

__device__ __forceinline__ void phase_prep(LAS unsigned char* lds, int tid) {
    const int wave = tid >> 6, lane = tid & 63, G = gridDim.x;
    LAS float* scr = (LAS float*)(lds + wave * 16384);
    const int gw = blockIdx.x * 8 + wave, NGW = G * 8;
    unsigned char* ws = KWS();
    const float* w_in = KIN(I_W_IN); const float* p_rnn = KIN(I_P_RNN); const float* p_attn = KIN(I_P_ATTN); const float* w_out = KIN(I_W_OUT);
    constexpr int I_WIN = 16 * 272, I_PR = 16 * 32, I_PA = 8 * 32, I_WO = 16 * 32, NIT = I_WIN + I_PR + I_PA + I_WO;
    for (int it = gw; it < NIT; it += NGW) {
        int r = it;
        if (r < I_WIN) { const int kb = r / 272, nb = r % 272; tr_item(w_in, D_IN, kb * 64, nb * 32, (bf16*)(ws + WS_WIN), nb * 32, 1024, scr, lane); continue; } r -= I_WIN;
        if (r < I_PR) { const int kb = r / 32, nb = r % 32; tr_item(p_rnn, 1024, kb * 64, nb * 32, (bf16*)(ws + WS_PRNN), nb * 32, 1024, scr, lane); continue; } r -= I_PR;
        if (r < I_PA) { const int kb = r / 32, nb = r % 32; tr_item(p_attn, 1024, kb * 64, nb * 32, (bf16*)(ws + WS_PATT), nb * 32, 512, scr, lane); continue; } r -= I_PA;
        { const int kb = r / 32, nb = r % 32; tr_item(w_out, 1024, kb * 64, nb * 32, (bf16*)(ws + WS_WOUT), nb * 32, 1024, scr, lane); }
    }
    for (int i = blockIdx.x * 512 + tid; i < SEQ * 16; i += G * 512) {
        const int pos = i >> 4, k = i & 15;
        const float ang = (float)pos * ROPE_INV[k];
        const double a = (double)ang;
        const double kq = __builtin_rint(a * 0.63661977236758134308);
        double y = __builtin_fma(-kq, 1.57079632679489655800e+00, a); y = __builtin_fma(-kq, 6.12323399573676603587e-17, y);
        const int q = ((int)kq) & 3;
        const double y2 = y * y;
        const double sp = y * (1.0 + y2 * (-1.0 / 6 + y2 * (1.0 / 120 + y2 * (-1.0 / 5040 + y2 * (1.0 / 362880 + y2 * (-1.0 / 39916800 + y2 * (1.0 / 6227020800.0)))))));
        const double cp = 1.0 + y2 * (-0.5 + y2 * (1.0 / 24 + y2 * (-1.0 / 720 + y2 * (1.0 / 40320 + y2 * (-1.0 / 3628800 + y2 * (1.0 / 479001600.0 + y2 * (-1.0 / 87178291200.0)))))));
        double sv, cv;
        if (q == 0) { sv = sp; cv = cp; } else if (q == 1) { sv = cp; cv = -sp; } else if (q == 2) { sv = -sp; cv = -cp; } else { sv = -cp; cv = sp; }
        ((float*)(ws + WS_COS))[i] = (float)cv; ((float*)(ws + WS_SIN))[i] = (float)sv;
    }
    { const float* rgw = KIN(I_RG_W); const float* cvw = KIN(I_CONV_W);
      for (int f = blockIdx.x * 512 + tid; f < 2 * 8 * 8 * 32 * 64; f += G * 512) {
        const int ln = f & 63, frag = f >> 6, kk = frag & 3, tap = (frag >> 2) & 3, g = (frag >> 4) & 1, u = frag >> 5, cg = u & 7, n = (u >> 3) & 7, dir = u >> 6, fr = ln & 15, fq = ln >> 4;
        const float* wp = rgw + ((size_t)(((dir * 2 + g) * 8 + n) * 128 + kk * 32 + 8 * fq)) * 128 + cg * 16 + fr;
        const float* cp = cvw + tap * 1024 + n * 128 + kk * 32 + 8 * fq;
        v4u w; w.x = pk2(wp[0] * cp[0], wp[128] * cp[1]); w.y = pk2(wp[256] * cp[2], wp[384] * cp[3]); w.z = pk2(wp[512] * cp[4], wp[640] * cp[5]); w.w = pk2(wp[768] * cp[6], wp[896] * cp[7]);
        ((v4u*)(ws + WS_RGWF))[f] = w; }
      const float* rgb = KIN(I_RG_B); const float* cvb = KIN(I_CONV_B);
      for (int i = blockIdx.x * 512 + tid; i < 4096; i += G * 512) { const int dg = i >> 10, cc = i & 1023, n = cc >> 7, j = cc & 127; float s = rgb[i];
        for (int k = 0; k < 128; ++k) s += cvb[n * 128 + k] * rgw[((size_t)((dg * 8 + n) * 128 + k)) * 128 + j];
        ((float*)(ws + WS_RGBIAS))[i] = s; } }
    const float* xin = KIN(I_X); const float* nmix = KIN(I_NORM_MIX);
    for (int m = gw; m < TALL; m += NGW) { f32x4 o[4]; rms_row(xin + (size_t)m * DM, nmix, lane, o); store_row_bf16((bf16*)(ws + WS_XN) + (size_t)m * DM, lane, o); }
}

constexpr int RNN_RING_BYTES = 128 * 256, RNN_FLAG_OFF = 131072 + 64;
__device__ __forceinline__ int rnn_cell(int row, int j) { return ((row >> 4) & 7) * 4096 + ((j * 16 + (row & 15)) << 4); }
__device__ __forceinline__ void rnn_gates1(const LAS unsigned char* ring, const bf16x8 (&Wg)[2][4][4], unsigned cw0, unsigned cw1, unsigned cw2, unsigned cw3, float br, float bi, float cbv, int fr, int fq, int kkc, int jsel, int tA, f32x4& arA, f32x4& aiA, f32x4& axA) {
    asm volatile("" : "+v"(br), "+v"(bi), "+v"(cbv));
    arA = (f32x4){br, br, br, br}; aiA = (f32x4){bi, bi, bi, bi}; axA = (f32x4){cbv, cbv, cbv, cbv};
#pragma unroll
    for (int tap = 0; tap < 4; ++tap) {
        unsigned cwt = tap == 0 ? cw0 : tap == 1 ? cw1 : tap == 2 ? cw2 : cw3; asm volatile("" : "+v"(cwt));
        v4u dv; dv.x = jsel == 0 ? cwt : 0u; dv.y = jsel == 1 ? cwt : 0u; dv.z = jsel == 2 ? cwt : 0u; dv.w = jsel == 3 ? cwt : 0u; const bf16x8 Dt = __builtin_bit_cast(bf16x8, dv);
        const LAS unsigned char* pa = ring + rnn_cell(tA + fr + tap - 2, fq);
        { const bf16x8 ac = *(const LAS bf16x8*)(pa + kkc * 1024); axA = __builtin_amdgcn_mfma_f32_16x16x32_bf16(ac, Dt, axA, 0, 0, 0); }
#pragma unroll
        for (int kk = 0; kk < 4; ++kk) {
            const bf16x8 a = *(const LAS bf16x8*)(pa + kk * 1024);
            arA = __builtin_amdgcn_mfma_f32_16x16x32_bf16(a, Wg[0][tap][kk], arA, 0, 0, 0); aiA = __builtin_amdgcn_mfma_f32_16x16x32_bf16(a, Wg[1][tap][kk], aiA, 0, 0, 0); }
        __builtin_amdgcn_sched_barrier(0);
    }
}
__device__ __forceinline__ void rnn_tile(const f32x4& ar, const f32x4& ai, const f32x4& ax, float spl2, int dir, float (&hl)[4], float (&pl)[4], float& P, float& H) {
    float av[4], uv[4];
#pragma unroll
    for (int r = 0; r < 4; ++r) {
        const float rg = __builtin_amdgcn_rcpf(1.0f + __builtin_amdgcn_exp2f(-1.4426950408889634f * ar[r]));
        const float ig = __builtin_amdgcn_rcpf(1.0f + __builtin_amdgcn_exp2f(-1.4426950408889634f * ai[r]));
        const float a = __builtin_amdgcn_exp2f(-spl2 * rg);
        av[r] = a; uv[r] = ax[r] * ig * __builtin_amdgcn_sqrtf(fmaxf(1.0f - a * a, 0.f)); }
    H = 0.f; P = 1.f;
    if (dir == 0) {
#pragma unroll
        for (int r = 0; r < 4; ++r) { H = av[r] * H + uv[r]; P *= av[r]; hl[r] = H; pl[r] = P; }
    } else {
#pragma unroll
        for (int r = 3; r >= 0; --r) { H = av[r] * H + uv[r]; P *= av[r]; hl[r] = H; pl[r] = P; }
    }
}
__device__ __forceinline__ void rnn_quads(float P, float H, int fr, int fq, int dir, float& Pc, float& Hc, float& Pw, float& Hw) {
    float Pq[4], Hq[4];
#pragma unroll
    for (int qq = 0; qq < 4; ++qq) { Pq[qq] = __shfl(P, fr + 16 * qq); Hq[qq] = __shfl(H, fr + 16 * qq); }
    Pc = 1.f; Hc = 0.f; Pw = 1.f; Hw = 0.f;
    if (dir == 0) {
#pragma unroll
        for (int qq = 0; qq < 4; ++qq) { if (qq < fq) { Hc = Pq[qq] * Hc + Hq[qq]; Pc *= Pq[qq]; } Hw = Pq[qq] * Hw + Hq[qq]; Pw *= Pq[qq]; }
    } else {
#pragma unroll
        for (int qq = 3; qq >= 0; --qq) { if (qq > fq) { Hc = Pq[qq] * Hc + Hq[qq]; Pc *= Pq[qq]; } Hw = Pq[qq] * Hw + Hq[qq]; Pw *= Pq[qq]; }
    }
}
__device__ __forceinline__ void rnn_wave(LAS unsigned char* ring, volatile LAS unsigned* myflag, volatile LAS unsigned* otherflag, unsigned epoch,
                                         int unit, int dir, const bf16* xr, const bf16* ggr, bf16* yout, unsigned long long* hx, const v4u* rgwf, const float* rgbias, int lane) {
    const int b = unit >> 6, n = (unit >> 3) & 7, cg = unit & 7;
    const int fr = lane & 15, fq = lane >> 4;
    const int c = n * 128 + cg * 16 + fr;
    bf16x8 Wg[2][4][4];
    { const v4u* wp = rgwf + ((size_t)((dir * 8 + n) * 8 + cg) * 32) * 64 + lane;
#pragma unroll
      for (int g = 0; g < 2; ++g)
#pragma unroll
        for (int tap = 0; tap < 4; ++tap)
#pragma unroll
          for (int kk = 0; kk < 4; ++kk) Wg[g][tap][kk] = __builtin_bit_cast(bf16x8, wp[((g * 4 + tap) * 4 + kk) * 64]); }
    const float* conv_w = KIN(I_CONV_W); const float* conv_b = KIN(I_CONV_B); const float* rgl = KIN(I_RG_LAM);
    const bool mine = fq == ((cg & 1) * 2 + (fr >> 3));
    unsigned cq0, cq1, cq2, cq3;
    { const unsigned w0 = f2bf(conv_w[c]), w1 = f2bf(conv_w[1024 + c]), w2 = f2bf(conv_w[2048 + c]), w3 = f2bf(conv_w[3072 + c]); const int sh = (fr & 1) * 16;
      cq0 = mine ? (w0 << sh) : 0u; cq1 = mine ? (w1 << sh) : 0u; cq2 = mine ? (w2 << sh) : 0u; cq3 = mine ? (w3 << sh) : 0u; }
    const float br = rgbias[(dir * 2 + 0) * 1024 + c], bi = rgbias[(dir * 2 + 1) * 1024 + c], cbv = conv_b[c];
    const float spl2 = 8.0f * log1pf(expf(-rgl[dir * 1024 + c])) * 1.4426950408889634f;
    const int kkc = cg >> 1, jsel = (fr & 7) >> 1;
    const bf16* xb = xr + (size_t)b * SEQ * 1024 + n * 128;
    const unsigned obase = (unsigned)(((size_t)b * SEQ + 4 * fq) * 1024 + c) * 2u;
    unsigned long long* hxu = hx + (size_t)unit * 512 * 64;
    for (int i = lane; i < RNN_RING_BYTES / 16; i += 64) *(LAS v4u*)(ring + i * 16) = (v4u){0u, 0u, 0u, 0u};
    const unsigned lofs = (unsigned)(lane & 15) * 2048u + (unsigned)(lane >> 4) * 16u;
#define RNN_TILE(i) (dir ? 511 - (i) : (i))
#define RNN_FILL(kt) do { const int kt_ = (kt); LAS unsigned char* dst_ = ring + (kt_ & 7) * 4096; \
        if (kt_ >= 0 && kt_ < 512) { _Pragma("unroll") for (int i = 0; i < 4; ++i) \
            __builtin_amdgcn_global_load_lds((const unsigned*)((const char*)(xb + (size_t)kt_ * 16384) + (lofs + (unsigned)i * 64u)), (LAS unsigned*)(dst_ + i * 1024), 16, 0, 0); } \
        else { _Pragma("unroll") for (int i = 0; i < 4; ++i) *(LAS v4u*)(dst_ + i * 1024 + lane * 16) = (v4u){0u, 0u, 0u, 0u}; } } while (0)
#define RNN_STEP(SECOND) do { \
        const int kA = RNN_TILE(2 * s), kB = RNN_TILE(2 * s + 1), tA = 16 * kA, tB = 16 * kB; \
        asm volatile("s_waitcnt vmcnt(0)" ::: "memory");     \
        if (s > 0) { if (SECOND && s > 128) { _Pragma("unroll") for (int r = 0; r < 4; ++r) { *(bf16*)((char*)yout + obase + (unsigned)(otA + r) * 2048u) = (bf16)(oAB[r] & 0xffffu); *(bf16*)((char*)yout + obase + (unsigned)(otB + r) * 2048u) = (bf16)(oAB[r] >> 16); } } \
                     else { hxu[(otA >> 4) * 64 + lane] = (unsigned long long)(oAB[0] & 0xffffu) | ((unsigned long long)(oAB[1] & 0xffffu) << 16) | ((unsigned long long)(oAB[2] & 0xffffu) << 32) | ((unsigned long long)(oAB[3] & 0xffffu) << 48); \
                            hxu[(otB >> 4) * 64 + lane] = (unsigned long long)(oAB[0] >> 16) | ((unsigned long long)(oAB[1] >> 16) << 16) | ((unsigned long long)(oAB[2] >> 16) << 32) | ((unsigned long long)(oAB[3] >> 16) << 48); } } \
        if (SECOND && s == 128) {                                                \
            asm volatile("s_waitcnt vmcnt(0)" ::: "memory"); \
            if (lane == 0) *myflag = epoch; \
            unsigned spins = 0; \
            while ((unsigned)__builtin_amdgcn_readfirstlane((int)*otherflag) != epoch) { __builtin_amdgcn_s_sleep(8); if (++spins > (1u << 24)) break; } \
            asm volatile("" ::: "memory"); } \
        RNN_FILL(RNN_TILE(2 * s + 3)); RNN_FILL(RNN_TILE(2 * s + 4)); \
        unsigned long long hpA = 0ull, hpB = 0ull; unsigned short gA[4] = {0, 0, 0, 0}, gB[4] = {0, 0, 0, 0}; \
        if (SECOND) { hpA = __hip_atomic_load(hxu + kA * 64 + lane, __ATOMIC_RELAXED, __HIP_MEMORY_SCOPE_AGENT); hpB = __hip_atomic_load(hxu + kB * 64 + lane, __ATOMIC_RELAXED, __HIP_MEMORY_SCOPE_AGENT); \
            _Pragma("unroll") for (int r = 0; r < 4; ++r) { gA[r] = *(const bf16*)((const char*)ggr + obase + (unsigned)(tA + r) * 2048u); gB[r] = *(const bf16*)((const char*)ggr + obase + (unsigned)(tB + r) * 2048u); } } \
        float outA[4]; \
        { f32x4 ar, ai, ax; rnn_gates1(ring, Wg, cq0, cq1, cq2, cq3, br, bi, cbv, fr, fq, kkc, jsel, tA, ar, ai, ax); \
          float hl[4], pl[4], P, H, Pc, Hc, Pw, Hw; rnn_tile(ar, ai, ax, spl2, dir, hl, pl, P, H); rnn_quads(P, H, fr, fq, dir, Pc, Hc, Pw, Hw); \
          const float Hs = Pc * carry + Hc; carry = Pw * carry + Hw; \
          _Pragma("unroll") for (int r = 0; r < 4; ++r) outA[r] = pl[r] * Hs + hl[r]; } \
        __builtin_amdgcn_sched_barrier(0); \
        { f32x4 ar, ai, ax; rnn_gates1(ring, Wg, cq0, cq1, cq2, cq3, br, bi, cbv, fr, fq, kkc, jsel, tB, ar, ai, ax); \
          float hl[4], pl[4], P, H, Pc, Hc, Pw, Hw; rnn_tile(ar, ai, ax, spl2, dir, hl, pl, P, H); rnn_quads(P, H, fr, fq, dir, Pc, Hc, Pw, Hw); \
          const float Hs = Pc * carry + Hc; carry = Pw * carry + Hw; \
          _Pragma("unroll") for (int r = 0; r < 4; ++r) { float ha = outA[r], hb = pl[r] * Hs + hl[r]; \
            if (SECOND) { ha = bf2f(gA[r]) * (bf2f((unsigned short)(hpA >> (16 * r))) + ha); hb = bf2f(gB[r]) * (bf2f((unsigned short)(hpB >> (16 * r))) + hb); } \
            oAB[r] = pk2(ha, hb); } } \
        otA = tA; otB = tB; } while (0)
    RNN_FILL(RNN_TILE(0)); RNN_FILL(RNN_TILE(1)); RNN_FILL(RNN_TILE(2));
    float carry = 0.f;
    unsigned oAB[4] = {0u, 0u, 0u, 0u}; int otA = 0, otB = 0;
#pragma unroll 1
    for (int s = 0; s < 128; ++s) RNN_STEP(false);
#pragma unroll 1
    for (int s = 128; s < 256; ++s) RNN_STEP(true);
    asm volatile("s_waitcnt vmcnt(0)" ::: "memory");
#pragma unroll
    for (int r = 0; r < 4; ++r) { *(bf16*)((char*)yout + obase + (unsigned)(otA + r) * 2048u) = (bf16)(oAB[r] & 0xffffu); *(bf16*)((char*)yout + obase + (unsigned)(otB + r) * 2048u) = (bf16)(oAB[r] >> 16); }
#undef RNN_STEP
#undef RNN_FILL
#undef RNN_TILE
}

__device__ __forceinline__ void attn_unit(const bf16* Q, const bf16* K, const bf16* V, int L, int q0, bf16* og, float* lse, size_t tok_base, int dil, int rr, int h,
                                          LAS unsigned char* lds, int tid) {
    const int wave = tid >> 6, lane = tid & 63, fr = lane & 15, fq = lane >> 4;
    LAS unsigned char* kv = lds;
    LAS unsigned char* pb = lds + 73728 + wave * 5376;
    const int k0 = q0 - 64;
#pragma unroll
    for (int i = 0; i < 8; ++i) { const int idx = tid + 512 * i, row = idx >> 4, ch = idx & 15, gk = k0 + row;
        v4u v = {0u, 0u, 0u, 0u}; if (gk >= 0 && gk < L) v = *(const v4u*)(K + (size_t)gk * 128 + ch * 8);
        *(LAS v4u*)(kv + row * 272 + ch * 16) = v; }
    bf16x8 qf[4];
#pragma unroll
    for (int kk = 0; kk < 4; ++kk) qf[kk] = *(const bf16x8*)(Q + (size_t)(q0 + 16 * wave + fr) * 128 + kk * 32 + 8 * fq);
    __syncthreads();
    f32x4 s[9];
#pragma unroll
    for (int kt = 0; kt < 9; ++kt) { s[kt] = (f32x4){0.f, 0.f, 0.f, 0.f};
#pragma unroll
        for (int kk = 0; kk < 4; ++kk) { const bf16x8 b = *(const LAS bf16x8*)(kv + ((wave + kt) * 16 + fr) * 272 + (kk * 32 + 8 * fq) * 2);
            s[kt] = __builtin_amdgcn_mfma_f32_16x16x32_bf16(qf[kk], b, s[kt], 0, 0, 0); } }
    const float scale = 0.08838834764831845f;
    float mx[4] = {-1e30f, -1e30f, -1e30f, -1e30f};
#pragma unroll
    for (int kt = 0; kt < 9; ++kt) { const int lk = (wave + kt) * 16 + fr, gk = k0 + lk;
#pragma unroll
        for (int r = 0; r < 4; ++r) { const int lq = 16 * wave + 4 * fq + r, rel = lk - 64 - lq;
            const bool valid = (rel >= -64) && (rel <= 64) && (gk >= 0) && (gk < L);
            const float sv = valid ? s[kt][r] * scale : -1e30f; s[kt][r] = sv; mx[r] = fmaxf(mx[r], sv); } }
#pragma unroll
    for (int r = 0; r < 4; ++r) {
#pragma unroll
        for (int o = 1; o < 16; o <<= 1) mx[r] = fmaxf(mx[r], __shfl_xor(mx[r], o)); }
    float sum[4] = {0.f, 0.f, 0.f, 0.f};
#pragma unroll
    for (int kt = 0; kt < 9; ++kt)
#pragma unroll
        for (int r = 0; r < 4; ++r) { const float pv = __expf(s[kt][r] - mx[r]); sum[r] += pv;
            *(LAS unsigned short*)(pb + (4 * fq + r) * 336 + (kt * 16 + fr) * 2) = (unsigned short)f2bf(pv); }
#pragma unroll
    for (int r = 0; r < 4; ++r) {
#pragma unroll
        for (int o = 1; o < 16; o <<= 1) sum[r] += __shfl_xor(sum[r], o); }
    *(LAS v2u*)(pb + (lane >> 2) * 336 + 288 + (lane & 3) * 8) = (v2u){0u, 0u};
    __syncthreads();
    if (tid < 384) { const int row = tid / 3, part = tid % 3; *(LAS v4u*)(kv + row * 560 + 512 + part * 16) = (v4u){0u, 0u, 0u, 0u}; }
#pragma unroll
    for (int i = 0; i < 8; ++i) { const int idx = tid + 512 * i, row = idx >> 4, ch = idx & 15, gk = k0 + row;
        v4u v = {0u, 0u, 0u, 0u}; if (gk >= 0 && gk < L) v = *(const v4u*)(V + (size_t)gk * 128 + ch * 8);
        LAS unsigned char* d = kv + (ch * 8) * 560 + row * 2;
        *(LAS unsigned short*)(d + 0 * 560) = (unsigned short)(v.x & 0xffffu); *(LAS unsigned short*)(d + 1 * 560) = (unsigned short)(v.x >> 16);
        *(LAS unsigned short*)(d + 2 * 560) = (unsigned short)(v.y & 0xffffu); *(LAS unsigned short*)(d + 3 * 560) = (unsigned short)(v.y >> 16);
        *(LAS unsigned short*)(d + 4 * 560) = (unsigned short)(v.z & 0xffffu); *(LAS unsigned short*)(d + 5 * 560) = (unsigned short)(v.z >> 16);
        *(LAS unsigned short*)(d + 6 * 560) = (unsigned short)(v.w & 0xffffu); *(LAS unsigned short*)(d + 7 * 560) = (unsigned short)(v.w >> 16); }
    __syncthreads();
    f32x4 o[8];
#pragma unroll
    for (int nt = 0; nt < 8; ++nt) o[nt] = (f32x4){0.f, 0.f, 0.f, 0.f};
#pragma unroll
    for (int kk = 0; kk < 5; ++kk) { const bf16x8 a = *(const LAS bf16x8*)(pb + fr * 336 + (kk * 32 + 8 * fq) * 2);
#pragma unroll
        for (int nt = 0; nt < 8; ++nt) { const bf16x8 b = *(const LAS bf16x8*)(kv + (nt * 16 + fr) * 560 + (wave * 16 + kk * 32 + 8 * fq) * 2);
            o[nt] = __builtin_amdgcn_mfma_f32_16x16x32_bf16(a, b, o[nt], 0, 0, 0); } }
#pragma unroll
    for (int r = 0; r < 4; ++r) { const float inv = 1.0f / sum[r]; const int j = q0 + 16 * wave + 4 * fq + r; const size_t t = tok_base + (size_t)j * dil + rr;
#pragma unroll
        for (int nt = 0; nt < 8; ++nt) og[t * 512 + h * 128 + nt * 16 + fr] = (bf16)f2bf(o[nt][r] * inv);
        if (fr == 0) lse[t * 4 + h] = mx[r] + __logf(sum[r]); }
    __syncthreads();
}

__device__ __forceinline__ unsigned block_sum_u32(unsigned v, LAS unsigned* red, int tid) {
#pragma unroll
    for (int o = 1; o < 64; o <<= 1) v += __shfl_xor(v, o);
    if ((tid & 63) == 0) red[tid >> 6] = v;
    __syncthreads();
    unsigned t = 0;
#pragma unroll
    for (int w = 0; w < 8; ++w) t += red[w];
    __syncthreads();
    return t;
}
__device__ __forceinline__ void topk_unit(const float* aff  , int* idx  , float* gatev  , int* slot  ,
                                          LAS unsigned char* lds, int tid) {
    LAS unsigned* red = (LAS unsigned*)lds;
    LAS unsigned* wtot = (LAS unsigned*)(lds + 64);
    unsigned v[16];
    { const v4u* src = (const v4u*)(aff + tid * 16);
#pragma unroll
      for (int i = 0; i < 4; ++i) { const v4u w = src[i]; v[4 * i] = w.x; v[4 * i + 1] = w.y; v[4 * i + 2] = w.z; v[4 * i + 3] = w.w; } }
    unsigned prefix = 0u;
    for (int bit = 30; bit >= 0; --bit) {
        const unsigned cand = prefix | (1u << bit); unsigned cnt = 0;
#pragma unroll
        for (int k = 0; k < 16; ++k) cnt += (v[k] >= cand) ? 1u : 0u;
        const unsigned tot = block_sum_u32(cnt, red, tid);
        if (tot >= (unsigned)CAP) prefix = cand;
    }
    const unsigned T = prefix;
    unsigned cgt = 0, ceq = 0;
#pragma unroll
    for (int k = 0; k < 16; ++k) { cgt += (v[k] > T) ? 1u : 0u; ceq += (v[k] == T) ? 1u : 0u; }
    const unsigned packed = cgt | (ceq << 16);
    const unsigned total = block_sum_u32(packed, red, tid);
    const unsigned n_gt = total & 0xffffu, need_eq = (unsigned)CAP - n_gt;
    const int lane = tid & 63, wave = tid >> 6;
    unsigned inc = packed;
#pragma unroll
    for (int o = 1; o < 64; o <<= 1) { const unsigned t = __shfl_up(inc, o); if (lane >= o) inc += t; }
    if (lane == 63) wtot[wave] = inc;
    __syncthreads();
    unsigned wpre = 0;
#pragma unroll
    for (int w = 0; w < 8; ++w) if (w < wave) wpre += wtot[w];
    const unsigned excl = wpre + inc - packed;
    unsigned gt_before = excl & 0xffffu, eq_before = excl >> 16;
#pragma unroll
    for (int k = 0; k < 16; ++k) {
        const int t = tid * 16 + k;
        const bool isgt = v[k] > T, iseq = v[k] == T;
        const bool sel = isgt || (iseq && eq_before < need_eq);
        const unsigned c = gt_before + (eq_before < need_eq ? eq_before : need_eq);
        if (sel) { idx[c] = t; gatev[c] = __builtin_bit_cast(float, v[k]); }
        slot[(size_t)t * 16] = sel ? (int)c : -1;
        gt_before += isgt ? 1u : 0u; eq_before += iseq ? 1u : 0u;
    }
    __syncthreads();
}

#ifndef PH_MASK
#define PH_MASK 0xFFFFF
#endif
#define PH_ON(c) (((PH_MASK) >> (c)) & 1)
#ifndef REP_MASK
#define REP_MASK 0
#endif
#define PH_REP(c) for (int rep_ = 0; rep_ < 1 + (((REP_MASK) >> (c)) & 1); ++rep_)
#define PHASE_TID() int tid = threadIdx.x; asm volatile("" : "+v"(tid)); const int lane = tid & 63, wave = __builtin_amdgcn_readfirstlane(tid >> 6); const int gw = blockIdx.x * 8 + wave, NGW = G * 8; (void)lane; (void)gw; (void)NGW
constexpr int N_PHASES = 18;
__global__ void __launch_bounds__(512, 2) mega(Params p) {
    extern __shared__ __attribute__((aligned(16))) unsigned char lds_raw[];
    LAS unsigned char* lds = (LAS unsigned char*)lds_raw;
    const int G = gridDim.x;
    volatile LAS unsigned* MISC = (volatile LAS unsigned*)(lds + MISC_OFF);
    if (threadIdx.x < 32) MISC[threadIdx.x] = 0u;
    __syncthreads();
    const int lo = p.ph_lo, hi = p.ph_hi;
    XcdBarrier bar = xcd_barrier_post((unsigned*)(KWS() + WS_CTL) + CW_BAR + p.li * XCD_BAR_WORDS, MISC + 8);
#define IN(k) (lo <= (k) && (k) < hi)
#define SEAM(k) do { if (IN(k) && IN((k) + 1)) xcd_barrier(bar); } while (0)

    if (PH_ON(0) && IN(0)) PH_REP(0) { PHASE_TID(); phase_prep(lds, tid); }
    SEAM(0);

    if (PH_ON(1) && IN(1)) PH_REP(1) {
        unsigned char* ws = KWS();
        pg8::Gemm g{(const bf16*)(ws + WS_XN), (const bf16*)(ws + WS_WIN), TALL, 6656, DM}; pg8::StaticOrder S; S.init(TALL, 6656, G, (int)blockIdx.x);
        EpiInProj E{KIN(I_B_IN), (bf16*)(ws + WS_XR), (bf16*)(ws + WS_GGR), (bf16*)(ws + WS_QKV), (bf16*)(ws + WS_SGA), (bf16*)(ws + WS_SGB), (const float*)(ws + WS_COS), (const float*)(ws + WS_SIN), 0};
        pg8::gemm_phase<EpiInProj, pg8::StaticOrder, true, true>(lds, g, S, E);
    }
    SEAM(1);

    if (PH_ON(2) && IN(2)) PH_REP(2) { PHASE_TID();
        unsigned char* ws = KWS();
        volatile LAS unsigned* flags = (volatile LAS unsigned*)(lds + RNN_FLAG_OFF);
        if (tid < 8) flags[tid] = 0u;
        __syncthreads();
        if (wave < 4) {
            const int vcu = (G % 8 == 0) ? (int)(blockIdx.x % 8) * (G / 8) + (int)blockIdx.x / 8 : (int)blockIdx.x;
            const int pr = wave >> 1, dir = wave & 1; unsigned epoch = 0;
            for (int unit = vcu * 2 + pr; unit < 512; unit += 2 * G) { ++epoch;
                rnn_wave(lds + wave * RNN_RING_BYTES, flags + pr * 2 + dir, flags + pr * 2 + (dir ^ 1), epoch, unit, dir,
                         (const bf16*)(ws + WS_XR), (const bf16*)(ws + WS_GGR), (rep_ == 0 && ((REP_MASK >> 2) & 1)) ? (bf16*)KOUT() + (size_t)TALL * DM : (bf16*)(ws + WS_GGR), (unsigned long long*)KOUT(), (const v4u*)(ws + WS_RGWF), (const float*)(ws + WS_RGBIAS), lane); }
        }
        __syncthreads();
    }
    SEAM(2);

    if (PH_ON(3) && IN(3)) PH_REP(3) { PHASE_TID();
        unsigned char* ws = KWS();
        const bf16* qkv = (const bf16*)(ws + WS_QKV); bf16* og = (bf16*)KOUT(); float* lse = (float*)(ws + WS_LSE);
        for (int unit = blockIdx.x; unit < 6144; unit += G) {
            const int g = unit >> 11, rem = unit & 2047, bl = rem >> 8, h = (rem >> 6) & 3, w = rem & 63;
            const int lg = 2 * g, dil = 1 << lg, L = SEQ >> lg, nblk = 64 >> lg, rr = w / nblk, blk = w % nblk;
            const size_t sub = ((size_t)((bl * 4 + h) * dil + rr) * L) * 128;
            const bf16* Qp = qkv + (size_t)(0 * 3 + g) * ((size_t)TALL * 512) + sub;
            const bf16* Kp = qkv + (size_t)(1 * 3 + g) * ((size_t)TALL * 512) + sub;
            const bf16* Vp = qkv + (size_t)(2 * 3 + g) * ((size_t)TALL * 512) + sub;
            attn_unit(Qp, Kp, Vp, L, blk * 128, og + (size_t)g * ((size_t)TALL * 512), lse + (size_t)g * ((size_t)TALL * 4), (size_t)bl * SEQ, dil, rr, h, lds, tid);
        }
    }
    SEAM(3);

    if (PH_ON(4) && IN(4)) PH_REP(4) { PHASE_TID();
        unsigned char* ws = KWS();
        const bf16* og = (const bf16*)KOUT(); const float* lse = (const float*)(ws + WS_LSE); bf16* yatt = (bf16*)KOUT() + (size_t)3 * TALL * 512;
        for (int t = gw; t < TALL; t += NGW) {
            const int h = lane >> 4, d0 = (lane & 15) * 8;
            const float l0 = lse[(size_t)t * 4 + h], l1 = lse[(size_t)TALL * 4 + (size_t)t * 4 + h], l2 = lse[(size_t)TALL * 8 + (size_t)t * 4 + h];
            const float m = fmaxf(l0, fmaxf(l1, l2)); const float e0 = __expf(l0 - m), e1 = __expf(l1 - m), e2 = __expf(l2 - m); const float inv = 1.0f / (e0 + e1 + e2);
            const float w0 = e0 * inv, w1 = e1 * inv, w2 = e2 * inv;
            const size_t o = (size_t)t * 512 + h * 128 + d0;
            const v4u a = *(const v4u*)(og + o), b = *(const v4u*)(og + (size_t)TALL * 512 + o), c = *(const v4u*)(og + (size_t)TALL * 1024 + o);
            v4u r;
            r.x = pk2(w0 * bflo(a.x) + w1 * bflo(b.x) + w2 * bflo(c.x), w0 * bfhi(a.x) + w1 * bfhi(b.x) + w2 * bfhi(c.x));
            r.y = pk2(w0 * bflo(a.y) + w1 * bflo(b.y) + w2 * bflo(c.y), w0 * bfhi(a.y) + w1 * bfhi(b.y) + w2 * bfhi(c.y));
            r.z = pk2(w0 * bflo(a.z) + w1 * bflo(b.z) + w2 * bflo(c.z), w0 * bfhi(a.z) + w1 * bfhi(b.z) + w2 * bfhi(c.z));
            r.w = pk2(w0 * bflo(a.w) + w1 * bflo(b.w) + w2 * bflo(c.w), w0 * bfhi(a.w) + w1 * bfhi(b.w) + w2 * bfhi(c.w));
            *(v4u*)(yatt + o) = r;
        }
    }
    SEAM(4);

    if (PH_ON(5) && IN(5)) PH_REP(5) {
        unsigned char* ws = KWS();
        pg8::Gemm g{(const bf16*)(ws + WS_XN), (const bf16*)(ws + WS_WIN) + (size_t)6656 * DM, TALL, 2048, DM}; pg8::StaticOrder S; S.init(TALL, 2048, G, (int)blockIdx.x);
        EpiInProj E{KIN(I_B_IN), (bf16*)(ws + WS_XR), (bf16*)(ws + WS_GGR), (bf16*)(ws + WS_QKV), (bf16*)(ws + WS_SGA), (bf16*)(ws + WS_SGB), (const float*)(ws + WS_COS), (const float*)(ws + WS_SIN), 26};
        pg8::gemm_phase<EpiInProj, pg8::StaticOrder, true, true>(lds, g, S, E);
    }
    SEAM(5);

    if (PH_ON(6) && IN(6)) PH_REP(6) {
        unsigned char* ws = KWS();
        pg8::Gemm g{(const bf16*)(ws + WS_GGR), (const bf16*)(ws + WS_PRNN), TALL, DM, DM}; pg8::StaticOrder S; S.init(TALL, DM, G, (int)blockIdx.x);
        EpiGate E{(const bf16*)(ws + WS_SGA), nullptr, (bf16*)(ws + WS_MERGED)};
        pg8::gemm_phase<EpiGate, pg8::StaticOrder, true, true>(lds, g, S, E);
    }
    SEAM(6);
    if (PH_ON(7) && IN(7)) {
        unsigned char* ws = KWS();
        pg8::Gemm g{(const bf16*)KOUT() + (size_t)3 * TALL * 512, (const bf16*)(ws + WS_PATT), TALL, DM, 512}; pg8::StaticOrder S; S.init(TALL, DM, G, (int)blockIdx.x);
        EpiGate E{(const bf16*)(ws + WS_SGB), (const bf16*)(ws + WS_MERGED), (bf16*)(ws + WS_MERGED)};
        pg8::gemm_phase<EpiGate, pg8::StaticOrder, true, true>(lds, g, S, E);
    }
    SEAM(7);
    if (PH_ON(8) && IN(8)) PH_REP(8) {
        unsigned char* ws = KWS();
        pg8::Gemm g{(const bf16*)(ws + WS_MERGED), (const bf16*)(ws + WS_WOUT), TALL, DM, DM}; pg8::StaticOrder S; S.init(TALL, DM, G, (int)blockIdx.x);
        EpiResid E{KIN(I_X), KOUT()};
        pg8::gemm_phase<EpiResid, pg8::StaticOrder, true, true>(lds, g, S, E);
    }
    SEAM(8);

    if (PH_ON(9) && IN(9)) PH_REP(9) { PHASE_TID();
        unsigned char* ws = KWS();
        LAS float* scr = (LAS float*)(lds + wave * 16384);
        constexpr int I_E = 16 * 1024;
        { const float* wg = KIN(I_W_GATE); const float* wu = KIN(I_W_UP); const float* wd = KIN(I_W_DOWN);
        for (int it = gw; it < 3 * I_E; it += NGW) {
            int r = it;
            if (r < 2 * I_E) { const int up = r >= I_E; r -= up * I_E; const int e = r >> 10, rr2 = r & 1023, kb = rr2 >> 6, nb = rr2 & 63, n0 = nb * 32;
                tr_item((up ? wu : wg) + (size_t)e * DM * DFF, DFF, kb * 64, n0, (bf16*)(ws + WS_WGU), (size_t)e * 4096 + (n0 >> 7) * 256 + (n0 & 127) + up * 128, 1024, scr, lane); continue; }
            r -= 2 * I_E;
            { const int e = r >> 10, rr2 = r & 1023, kb = rr2 >> 5, nb = rr2 & 31, n0 = nb * 32;
              tr_item(wd + (size_t)e * DFF * DM, DM, kb * 64, n0, (bf16*)(ws + WS_WD), (size_t)e * 1024 + n0, 2048, scr, lane); }
        } }
        __syncthreads();
        LAS float* wrT = (LAS float*)lds;
        { const float* wrt = KIN(I_W_ROUTER);
          for (int i = tid; i < DM * NEXP; i += 512) { const int d = i >> 4, e = i & 15; wrT[e * 1024 + d] = wrt[i]; } }
        __syncthreads();
        const float* x2 = KOUT(); const float* nffn = KIN(I_NORM_FFN); const float* brt = KIN(I_B_ROUTER);
        for (int m = gw; m < TALL; m += NGW) {
            f32x4 o[4]; rms_row(x2 + (size_t)m * DM, nffn, lane, o); store_row_bf16((bf16*)(ws + WS_H2) + (size_t)m * DM, lane, o);
            float mine = -3.0e38f;
#pragma unroll 2
            for (int e = 0; e < 16; ++e) { float s = 0.f;
#pragma unroll
                for (int j = 0; j < 4; ++j) { const f32x4 w = *(const LAS f32x4*)(wrT + e * 1024 + j * 256 + 4 * lane); s += (o[j].x * w.x + o[j].y * w.y) + (o[j].z * w.z + o[j].w * w.w); }
                const float tot = wave_sum(s) + brt[e]; mine = (lane == e) ? tot : mine; }
            float mx = mine;
#pragma unroll
            for (int of = 1; of < 16; of <<= 1) mx = fmaxf(mx, __shfl_xor(mx, of));
            const float ex = expf(mine - mx); float den = ex;
#pragma unroll
            for (int of = 1; of < 16; of <<= 1) den += __shfl_xor(den, of);
            const int b = m >> 13, s = m & (SEQ - 1);
            if (lane < 16) ((float*)(ws + WS_AFF))[((size_t)(b * 16 + lane)) * SEQ + s] = ex / den;
        }
        __syncthreads();
    }
    SEAM(9);

    if (PH_ON(10) && IN(10)) PH_REP(10) { PHASE_TID();
        unsigned char* ws = KWS();
        for (int unit = blockIdx.x; unit < BATCH * NEXP; unit += G) { const int b = unit >> 4, e = unit & 15;
            topk_unit((const float*)(ws + WS_AFF) + (size_t)unit * SEQ, (int*)(ws + WS_IDX) + unit * CAP, (float*)(ws + WS_GATEV) + unit * CAP, (int*)(ws + WS_SLOT) + (size_t)b * SEQ * 16 + e, lds, tid); }
    }
    SEAM(10);

    for (int half = 0; half < 2; ++half) {
        const int pb0 = 11 + 3 * half;
        if (PH_ON(11) && IN(pb0 + 0)) PH_REP(11) { PHASE_TID();
            unsigned char* ws = KWS();
            const int* idx = (const int*)(ws + WS_IDX) + half * 65536; bf16* xg = (bf16*)(ws + WS_XG);
            for (int r = gw; r < 65536; r += NGW) { const int b = half * 4 + (r >> 14), t = idx[r];
                const v4u* src = (const v4u*)((const bf16*)(ws + WS_H2) + ((size_t)b * SEQ + t) * DM); v4u* dst = (v4u*)(xg + (size_t)r * DM);
                dst[lane] = src[lane]; dst[lane + 64] = src[lane + 64]; }
        }
        SEAM(pb0 + 0);
        if (PH_ON(12) && IN(pb0 + 1)) PH_REP(12) {
            unsigned char* ws = KWS();
            pg8::Gemm g{(const bf16*)(ws + WS_XG), (const bf16*)(ws + WS_WGU), 65536, 65536, DM}; MoeOrder S{G, (int)blockIdx.x, 16, 4096};
            EpiSwiglu E{(bf16*)(ws + WS_HID)};
            pg8::gemm_phase<EpiSwiglu, MoeOrder, true, true>(lds, g, S, E);
        }
        SEAM(pb0 + 1);
        if (PH_ON(13) && IN(pb0 + 2)) PH_REP(13) {
            unsigned char* ws = KWS();
            pg8::Gemm g{(const bf16*)(ws + WS_HID), (const bf16*)(ws + WS_WD), 65536, 16384, DFF}; MoeOrder S{G, (int)blockIdx.x, 4, 1024};
            EpiDown E{(bf16*)(ws + WS_EO) + (size_t)half * 65536 * DM, (const float*)(ws + WS_GATEV) + half * 65536};
            pg8::gemm_phase<EpiDown, MoeOrder, true, true>(lds, g, S, E);
        }
        SEAM(pb0 + 2);
    }

    if (PH_ON(14) && IN(17)) { PHASE_TID();
        unsigned char* ws = KWS();
        const bf16* eo = (const bf16*)(ws + WS_EO); float* outp = KOUT(); const float* nfin = KIN(I_NORM_FINAL);
        for (int m = gw; m < TALL; m += NGW) {
            const int b = m >> 13;
            float* xrow = outp + (size_t)m * DM;
            f32x4 v[4];
#pragma unroll
            for (int j = 0; j < 4; ++j) v[j] = ((const f32x4*)xrow)[64 * j + lane];
            const int* sl = (const int*)(ws + WS_SLOT) + (size_t)m * 16;
            for (int e = 0; e < 16; ++e) { const int c = sl[e];
                if (c >= 0) { const unsigned long long* er = (const unsigned long long*)(eo + ((size_t)(b * 16 + e) * CAP + c) * DM) + lane;
#pragma unroll
                    for (int j = 0; j < 4; ++j) { const unsigned long long w = er[64 * j]; const unsigned w0 = (unsigned)w, w1 = (unsigned)(w >> 32);
                        v[j].x += bflo(w0); v[j].y += bfhi(w0); v[j].z += bflo(w1); v[j].w += bfhi(w1); } } }
            float s = 0.f;
#pragma unroll
            for (int j = 0; j < 4; ++j) s += (v[j].x * v[j].x + v[j].y * v[j].y) + (v[j].z * v[j].z + v[j].w * v[j].w);
            const float rstd = 1.0f / sqrtf(wave_sum(s) * (1.0f / DM) + RMS_EPS);
#pragma unroll
            for (int j = 0; j < 4; ++j) { const f32x4 g = ((const f32x4*)nfin)[64 * j + lane]; ((f32x4*)xrow)[64 * j + lane] = v[j] * rstd * g; }
        }
    }
#undef IN
#undef SEAM
}

#ifndef MK_SPLIT
#define MK_SPLIT 0
#endif
extern "C" void kernel_launch(void* const* d_in, const int* in_sizes, int n_in, void* d_out, int out_size, void* d_ws, size_t ws_size, hipStream_t stream) {
    static int grid = 0;
    if (grid == 0) {
        if (n_in != 19 || out_size != TALL * DM || ws_size < WS_END) { fprintf(stderr, "kernel_launch: unexpected shapes (n_in %d out %d ws %zu)\n", n_in, out_size, ws_size); grid = -1; return; }
        int dev = 0, cus = 0, per_cu = 0;
        if (hipGetDevice(&dev) != hipSuccess || hipDeviceGetAttribute(&cus, hipDeviceAttributeMultiprocessorCount, dev) != hipSuccess) { grid = -1; return; }
        if (hipFuncSetAttribute((const void*)mega, hipFuncAttributeMaxDynamicSharedMemorySize, LDS_BYTES) != hipSuccess) { fprintf(stderr, "kernel_launch: hipFuncSetAttribute failed\n"); grid = -1; return; }
        if (hipOccupancyMaxActiveBlocksPerMultiprocessor(&per_cu, (const void*)mega, 512, LDS_BYTES) != hipSuccess || per_cu < 1) { fprintf(stderr, "kernel_launch: occupancy query says %d\n", per_cu); }
        (void)hipGetLastError();
        grid = cus;
    }
    if (grid < 0) return;
    (void)hipMemsetAsync((char*)d_ws + WS_CTL, 0, CTL_ZERO_BYTES, stream);
    Params p{};
    for (int i = 0; i < 19; ++i) p.in[i] = (const float*)d_in[i];
    p.out = (float*)d_out; p.ws = (unsigned char*)d_ws;
#if MK_SPLIT
    for (int k = 0; k < N_PHASES; ++k) { p.ph_lo = k; p.ph_hi = k + 1; p.li = 0; hipLaunchKernelGGL(mega, dim3(grid), dim3(512), LDS_BYTES, stream, p); }
#else
    p.ph_lo = 0; p.ph_hi = N_PHASES; p.li = 0;
    hipLaunchKernelGGL(mega, dim3(grid), dim3(512), LDS_BYTES, stream, p);
#endif
}
```

```cpp
#include <hip/hip_runtime.h>
#include <cstdio>
#include <cstdint>

#define GAS __attribute__((address_space(1)))
#define LAS __attribute__((address_space(3)))

namespace pg8 {
#define PG8_LAS __attribute__((address_space(3)))
typedef unsigned short bf16_t;
typedef short bf16x8 __attribute__((ext_vector_type(8)));
typedef float f32x4 __attribute__((ext_vector_type(4)));
typedef unsigned u32x4 __attribute__((ext_vector_type(4)));
constexpr int BM = 256, BK = 64, HALF = 128, HTB = HALF * BK * 2  , STAGE_BYTES = 8 * HTB, NXCD = 8, WGM = 8;

__host__ __device__ __forceinline__ int lds_byte(int r, int c) { const int st = (r >> 4) * 2 + (c >> 5), rr = r & 15, cc = c & 31, ob = rr * 64 + cc * 2; return st * 1024 + (ob ^ (((ob >> 9) & 1) << 5)); }
__host__ __device__ __forceinline__ void stage_rc(int b, int& R, int& C) { const int st = b / 1024, sb = b % 1024, swz = sb ^ (((sb >> 9) & 1) << 5); R = (st >> 1) * 16 + swz / 64; C = (st & 1) * 32 + (swz % 64) / 2; }
__host__ __device__ __forceinline__ int perm32(int rho) { const int n = rho >> 4, i = rho & 15; return 8 * (i >> 2) + 4 * n + (i & 3); }

struct Unit { int pm, pn; };
struct Gemm { const bf16_t* A; const bf16_t* Bt; int M, N, K; const int* gidx; int grow0; };

struct StaticOrder {
    int nM, nN, nwg, G, c;
    __host__ __device__ void init(int M, int N, int G_, int c_) { nM = M / BM; nN = N / BM; nwg = nM * nN; G = G_; c = c_; }
    __host__ __device__ bool next(int i, Unit& u) const {
        const long L = (long)i * G + c; if (L >= nwg) return false;
        int wgid = (int)L; { const int q = nwg / NXCD, r = nwg % NXCD, xcd = wgid % NXCD, off = wgid / NXCD; wgid = (xcd < r ? xcd * (q + 1) : r * (q + 1) + (xcd - r) * q) + off; }
        const int nig = WGM * nN, gid = wgid / nig, fm = gid * WGM, gsz = (nM - fm) < WGM ? (nM - fm) : WGM;
        u.pm = fm + ((wgid % nig) % gsz); u.pn = (wgid % nig) / gsz; return true;
    }
    __device__ __forceinline__ void a_ready(const Unit&) const {}
    __device__ __forceinline__ void done(const Unit&) const {}
};

__device__ __forceinline__ unsigned cvt_pk_bf16(float lo, float hi) { unsigned r; asm volatile("v_cvt_pk_bf16_f32 %0, %1, %2" : "=v"(r) : "v"(lo), "v"(hi)); return r; }
typedef float f32x2 __attribute__((ext_vector_type(2)));
template <class Epi, class Sched, bool ALIGN_EPI = false, bool SP2 = false, bool GATHER = false>
__device__ __forceinline__ void gemm_phase(PG8_LAS unsigned char* lds, const Gemm g, const Sched& S, const Epi& E) {
    int tid_ = threadIdx.x; asm volatile("" : "+v"(tid_));
    const int tid = tid_, wid = __builtin_amdgcn_readfirstlane(tid >> 6), lane = tid & 63, wr = wid >> 2, wc = wid & 3, fr = lane & 15, fq = lane >> 4;
    const int K = g.K, nt = K / BK;
    unsigned voffA[2], voffB[2];
#pragma unroll
    for (int i = 0; i < 2; ++i) { int R, C; stage_rc(tid * 16 + i * 8192, R, C); const int Rb = Epi::PERM ? ((R & ~31) + perm32(R & 31)) : R;
        voffA[i] = (unsigned)(R * K + C) * 2u; voffB[i] = (unsigned)(Rb * K + C) * 2u; }
    static_assert(!GATHER || SP2, "GATHER is written for the SP2 loop");
    const size_t kstep = (size_t)(BK * 2);
    const size_t hstep = (size_t)HALF * K * 2;
    const size_t tstep = 2 * hstep;
    unsigned cvA[2][2], nvA[2][2];
    int gR[2], gC[2];
#pragma unroll
    for (int i = 0; i < 2; ++i) { stage_rc(tid * 16 + i * 8192, gR[i], gC[i]); }
#define PG8_GATHER_OFFS(dst, unit) do { _Pragma("unroll") for (int h_ = 0; h_ < 2; ++h_) _Pragma("unroll") for (int i_ = 0; i_ < 2; ++i_) { \
        const int src_ = g.grow0 + ((unit).pm >> 6) * 8192 + g.gidx[(unit).pm * 256 + h_ * 128 + gR[i_]]; dst[h_][i_] = ((unsigned)src_ * (unsigned)K + (unsigned)gC[i_]) * 2u; } } while (0)
    const unsigned ldsw = (unsigned)wid * 1024u;
    const int aoff = lds_byte(wr * 64 + fr, fq * 8), boff = lds_byte(wc * 32 + fr, fq * 8);
#define PG8_SA(b, h) (((b) * 2 + (h)) * HTB)
#define PG8_SB(b, h) ((4 + (b) * 2 + (h)) * HTB)
#define PG8_STAGE(bufoff, gbase, voff) do { _Pragma("unroll") for (int _i = 0; _i < 2; ++_i) \
        __builtin_amdgcn_global_load_lds((const unsigned*)((const char*)(gbase) + (voff)[_i]), (PG8_LAS unsigned*)(lds + (bufoff) + ldsw + _i * 8192), 16, 0, 0); } while (0)
#define PG8_LDA(dst, b, h) do { _Pragma("unroll") for (int m = 0; m < 4; ++m) _Pragma("unroll") for (int k = 0; k < 2; ++k) dst[m][k] = *(const PG8_LAS bf16x8*)(lds + PG8_SA(b, h) + aoff + m * 2048 + k * 1024); } while (0)
#define PG8_LDB(dst, b, h) do { _Pragma("unroll") for (int n = 0; n < 2; ++n) _Pragma("unroll") for (int k = 0; k < 2; ++k) dst[n][k] = *(const PG8_LAS bf16x8*)(lds + PG8_SB(b, h) + boff + n * 2048 + k * 1024); } while (0)
#define PG8_MMA(ai, bj, At, Bt) do { __builtin_amdgcn_s_setprio(1); _Pragma("unroll") for (int m = 0; m < 4; ++m) _Pragma("unroll") for (int n = 0; n < 2; ++n) _Pragma("unroll") for (int k = 0; k < 2; ++k) \
        acc[ai][bj][m][n] = __builtin_amdgcn_mfma_f32_16x16x32_bf16(Bt[n][k], At[m][k], acc[ai][bj][m][n], 0, 0, 0); __builtin_amdgcn_s_setprio(0); } while (0)
#define PG8_WAIT_V(n) asm volatile("s_waitcnt vmcnt(" #n ")" ::: "memory")
#define PG8_WAIT_L(n) asm volatile("s_waitcnt lgkmcnt(" #n ")" ::: "memory")
#define PG8_BAR __builtin_amdgcn_s_barrier()
#define PG8_SCHED __builtin_amdgcn_sched_barrier(0)
    Unit cur, nxt; int ui = 0;
    if (!S.next(0, cur)) return;
    f32x4 acc[2][2][4][2];
#pragma unroll
    for (int a = 0; a < 2; ++a)
#pragma unroll
        for (int b = 0; b < 2; ++b)
#pragma unroll
            for (int m = 0; m < 4; ++m)
#pragma unroll
                for (int n = 0; n < 2; ++n) acc[a][b][m][n] = (f32x4){0.f, 0.f, 0.f, 0.f};
    bf16x8 At[4][2], B0[2][2], B1[2][2];
    const char* cA = GATHER ? (const char*)g.A : (const char*)g.A + (size_t)cur.pm * tstep; const char* cB = (const char*)g.Bt + (size_t)cur.pn * tstep;
    if constexpr (GATHER) { PG8_GATHER_OFFS(cvA, cur); } else {
#pragma unroll
        for (int i = 0; i < 2; ++i) { cvA[0][i] = voffA[i]; cvA[1][i] = voffA[i] + (unsigned)hstep; } }
#pragma unroll
    for (int h = 0; h < 2; ++h)
#pragma unroll
        for (int i = 0; i < 2; ++i) nvA[h][i] = cvA[h][i];
    S.a_ready(cur);
    if constexpr (SP2) {
        PG8_STAGE(PG8_SB(0, 0), cB, voffB); PG8_STAGE(PG8_SB(0, 1), cB + hstep, voffB); PG8_STAGE(PG8_SA(0, 0), cA, cvA[0]); PG8_STAGE(PG8_SA(0, 1), cA, cvA[1]);
        if (wr == 1) PG8_BAR;
        PG8_WAIT_V(2); PG8_BAR;
        PG8_STAGE(PG8_SB(1, 0), cB + kstep, voffB); PG8_STAGE(PG8_SA(1, 0), cA + kstep, cvA[0]); PG8_STAGE(PG8_SB(1, 1), cB + hstep + kstep, voffB);
        PG8_WAIT_V(6); PG8_BAR;
    } else {
        PG8_STAGE(PG8_SB(0, 0), cB, voffB); PG8_STAGE(PG8_SA(0, 0), cA, voffA); PG8_STAGE(PG8_SB(0, 1), cB + hstep, voffB); PG8_STAGE(PG8_SA(0, 1), cA + hstep, voffA);
        if (wr == 1) PG8_BAR;
        PG8_WAIT_V(4); PG8_BAR;
        PG8_STAGE(PG8_SB(1, 0), cB + kstep, voffB); PG8_STAGE(PG8_SA(1, 0), cA + kstep, voffA); PG8_STAGE(PG8_SB(1, 1), cB + hstep + kstep, voffB);
        PG8_WAIT_V(6); PG8_BAR;
    }
    for (;;) {
        const bool has_next = S.next(ui + 1, nxt);
        const char* nA = GATHER ? cA : (has_next ? (const char*)g.A + (size_t)nxt.pm * tstep : cA); const char* nB = has_next ? (const char*)g.Bt + (size_t)nxt.pn * tstep : cB;
        if constexpr (GATHER) { if (has_next) PG8_GATHER_OFFS(nvA, nxt); }
        for (int t = 0; t < nt; t += 2) {
            const bool last = (t == nt - 2);
            const char* a1 = cA + (size_t)(t + 1) * kstep;
            const char* a2 = last ? nA : cA + (size_t)(t + 2) * kstep; const char* b2 = last ? nB : cB + (size_t)(t + 2) * kstep;
            const char* a3 = a2 + kstep; const char* b3 = b2 + kstep;
            if (last && has_next) S.a_ready(nxt);
            if constexpr (SP2) {
            PG8_LDB(B0, 0, 0); PG8_LDB(B1, 0, 1); PG8_SCHED; PG8_LDA(At, 0, 0); PG8_STAGE(PG8_SA(1, 1), a1, cvA[1]);
            PG8_WAIT_V(8); PG8_WAIT_L(0); PG8_BAR; PG8_MMA(0, 0, At, B0); PG8_MMA(0, 1, At, B1); PG8_BAR; PG8_SCHED;
            PG8_LDA(At, 0, 1); PG8_STAGE(PG8_SB(0, 0), b2, voffB); PG8_STAGE(PG8_SB(0, 1), b2 + hstep, voffB); PG8_STAGE(PG8_SA(0, 0), a2, (last ? nvA[0] : cvA[0]));
            PG8_WAIT_V(8); PG8_WAIT_L(0); PG8_BAR; PG8_MMA(1, 0, At, B0); PG8_MMA(1, 1, At, B1); PG8_BAR; PG8_SCHED;
            PG8_LDB(B0, 1, 0); PG8_LDB(B1, 1, 1); PG8_SCHED; PG8_LDA(At, 1, 0); PG8_STAGE(PG8_SA(0, 1), a2, (last ? nvA[1] : cvA[1]));
            PG8_WAIT_V(8); PG8_WAIT_L(0); PG8_BAR; PG8_MMA(0, 0, At, B0); PG8_MMA(0, 1, At, B1); PG8_BAR; PG8_SCHED;
            PG8_LDA(At, 1, 1); PG8_STAGE(PG8_SB(1, 0), b3, voffB); PG8_STAGE(PG8_SB(1, 1), b3 + hstep, voffB); PG8_STAGE(PG8_SA(1, 0), a3, (last ? nvA[0] : cvA[0]));
            PG8_WAIT_V(8); PG8_WAIT_L(0); PG8_BAR; PG8_MMA(1, 0, At, B0); PG8_MMA(1, 1, At, B1); PG8_BAR; PG8_SCHED;
            } else {
            PG8_LDB(B0, 0, 0); PG8_SCHED; PG8_LDA(At, 0, 0); PG8_STAGE(PG8_SA(1, 1), a1 + hstep, voffA);
            PG8_WAIT_L(8); PG8_BAR; PG8_WAIT_L(0); PG8_MMA(0, 0, At, B0); PG8_BAR; PG8_SCHED;
            PG8_LDB(B1, 0, 1); PG8_STAGE(PG8_SB(0, 0), b2, voffB);
            PG8_BAR; PG8_WAIT_L(0); PG8_MMA(0, 1, At, B1); PG8_BAR;
            PG8_LDA(At, 0, 1); PG8_STAGE(PG8_SA(0, 0), a2, voffA);
            PG8_BAR; PG8_WAIT_L(0); PG8_MMA(1, 0, At, B0); PG8_BAR; PG8_SCHED;
            PG8_STAGE(PG8_SB(0, 1), b2 + hstep, voffB);
            PG8_WAIT_V(6); PG8_BAR; PG8_MMA(1, 1, At, B1); PG8_BAR;
            PG8_LDB(B0, 1, 0); PG8_SCHED; PG8_LDA(At, 1, 0); PG8_STAGE(PG8_SA(0, 1), a2 + hstep, voffA);
            PG8_WAIT_L(8); PG8_BAR; PG8_WAIT_L(0); PG8_MMA(0, 0, At, B0); PG8_BAR; PG8_SCHED;
            PG8_LDB(B1, 1, 1); PG8_STAGE(PG8_SB(1, 0), b3, voffB);
            PG8_BAR; PG8_WAIT_L(0); PG8_MMA(0, 1, At, B1); PG8_BAR;
            PG8_LDA(At, 1, 1); PG8_STAGE(PG8_SA(1, 0), a3, voffA);
            PG8_BAR; PG8_WAIT_L(0); PG8_MMA(1, 0, At, B0); PG8_BAR; PG8_SCHED;
            PG8_STAGE(PG8_SB(1, 1), b3 + hstep, voffB);
            PG8_WAIT_V(6); PG8_BAR; PG8_MMA(1, 1, At, B1); PG8_BAR;
            }
        }
        if constexpr (ALIGN_EPI) { if (wr == 0) PG8_BAR; }
        if constexpr (!Epi::AFTER_DRAIN) { E(acc, cur, wr, wc, fr, fq); S.done(cur); }
        if (!has_next) break;
#pragma unroll
        for (int a = 0; a < 2; ++a)
#pragma unroll
            for (int b = 0; b < 2; ++b)
#pragma unroll
                for (int m = 0; m < 4; ++m)
#pragma unroll
                    for (int n = 0; n < 2; ++n) acc[a][b][m][n] = (f32x4){0.f, 0.f, 0.f, 0.f};
        cur = nxt; cA = nA; cB = nB; ++ui;
#pragma unroll
        for (int h = 0; h < 2; ++h)
#pragma unroll
            for (int i = 0; i < 2; ++i) cvA[h][i] = nvA[h][i];
        if constexpr (ALIGN_EPI) { if (wr == 1) PG8_BAR; }
    }
    PG8_WAIT_V(0);
    if constexpr (!ALIGN_EPI) { if (wr == 0) PG8_BAR; }
    PG8_BAR;
    if constexpr (Epi::AFTER_DRAIN) { E.fused(acc, cur, wr, wc, fr, fq, lds, wid, lane); S.done(cur); }
#undef PG8_SA
#undef PG8_SB
#undef PG8_STAGE
#undef PG8_LDA
#undef PG8_LDB
#undef PG8_MMA
#undef PG8_WAIT_V
#undef PG8_WAIT_L
#undef PG8_BAR
#undef PG8_SCHED
#undef PG8_GATHER_OFFS
}
}

constexpr int DM = 1024, BATCH = 8, SEQ = 8192, TALL = BATCH * SEQ;
constexpr int HBATCH = 4, TH = HBATCH * SEQ;
constexpr int D_IN = 8704, NEXP = 16, CAP = 1024, DFF = 2048;
constexpr float RMS_EPS = 1e-6f;

typedef unsigned short bf16;
typedef unsigned v4u __attribute__((ext_vector_type(4)));
typedef unsigned v2u __attribute__((ext_vector_type(2)));
typedef float f32x4 __attribute__((ext_vector_type(4)));
typedef short bf16x8 __attribute__((ext_vector_type(8)));

constexpr size_t MiB = 1u << 20;
constexpr size_t WS_CTL = 0, CTL_ZERO_BYTES = 64 * 1024;
constexpr size_t WS_COS = 1 * MiB, WS_SIN = WS_COS + 512 * 1024;
constexpr size_t WS_WIN = 2 * MiB, WS_PRNN = 19 * MiB, WS_PATT = 21 * MiB, WS_WOUT = 22 * MiB;
constexpr size_t WS_AFF = 24 * MiB, WS_IDX = 28 * MiB, WS_GATEV = WS_IDX + 512 * 1024, WS_LSE = 29 * MiB, WS_SLOT = 32 * MiB;
constexpr size_t WS_RGWF = 36 * MiB, WS_RGBIAS = 40 * MiB;
constexpr size_t WS_XN = 44 * MiB;
constexpr size_t WS_XR = 172 * MiB, WS_GGR = 300 * MiB, WS_QKV = 428 * MiB;
constexpr size_t WS_MERGED = WS_XR;
constexpr size_t WS_SGA = WS_QKV, WS_SGB = WS_QKV + 128 * MiB;
constexpr size_t WS_H2 = WS_XN, WS_XG = 172 * MiB, WS_HID = 300 * MiB, WS_EO = 556 * MiB, WS_WGU = 812 * MiB, WS_WD = 940 * MiB, WS_END = 1004 * MiB;
constexpr int CW_BAR = 1024;

constexpr int LDS_BYTES = 155648, MISC_OFF = LDS_BYTES - 256;

__device__ __forceinline__ unsigned f2bf(float f) { unsigned u = __builtin_bit_cast(unsigned, f); return (u + 0x7fffu + ((u >> 16) & 1u)) >> 16; }
__device__ __forceinline__ unsigned pk2(float lo, float hi) { unsigned r; asm volatile("v_cvt_pk_bf16_f32 %0, %1, %2" : "=v"(r) : "v"(lo), "v"(hi)); return r; }
__device__ __forceinline__ float bflo(unsigned w) { return __builtin_bit_cast(float, w << 16); }
__device__ __forceinline__ float bfhi(unsigned w) { return __builtin_bit_cast(float, w & 0xffff0000u); }
__device__ __forceinline__ float bf2f(unsigned short b) { return __builtin_bit_cast(float, (unsigned)b << 16); }
__device__ __forceinline__ float wave_sum(float v) {
#pragma unroll
    for (int o = 1; o < 64; o <<= 1) v += __shfl_xor(v, o);
    return v;
}
__device__ __forceinline__ float sigmoidf_(float v) { return __builtin_amdgcn_rcpf(1.0f + __builtin_amdgcn_exp2f(-1.4426950408889634f * v)); }
__device__ __forceinline__ float gelu_tanh(float v) { const float u = 0.7978845608028654f * (v + 0.044715f * v * v * v); return v * __builtin_amdgcn_rcpf(1.0f + __builtin_amdgcn_exp2f(-2.8853900817779268f * u)); }
#define LDS_WAIT() asm volatile("s_waitcnt lgkmcnt(0)" ::: "memory")

#define XB_TMO      128
#define XB_XCNT(j)  (256  + 64 * (j))
#define XB_XSUB(j)  (1280 + 64 * (j))
#define XB_XGEN(j)  (2304 + 64 * (j))
#define XB_TOP      3328
#define XB_TOPGEN   3392
#define XCD_BAR_WORDS 3456
#define XB_SPIN_CAP (1u << 22)

__device__ __forceinline__ unsigned xb_ld(unsigned* p)              { return __hip_atomic_load(p, __ATOMIC_RELAXED, __HIP_MEMORY_SCOPE_AGENT); }
__device__ __forceinline__ unsigned xb_add(unsigned* p, unsigned v) { return __hip_atomic_fetch_add(p, v, __ATOMIC_RELAXED, __HIP_MEMORY_SCOPE_AGENT); }
__device__ __forceinline__ unsigned xb_xcc_id() { return (unsigned)__builtin_amdgcn_s_getreg((3 << 11) | 20) & 0xFu; }
#define XB_SPIN(cond, bar) do { unsigned _sp = 0; while (cond) { __builtin_amdgcn_s_sleep(1); \
    if ((++_sp & 255u) == 0u) { if (xb_ld(&(bar)[XB_TMO])) break; if (_sp > XB_SPIN_CAP) { atomicAdd(&(bar)[XB_TMO], 1u); break; } } } } while (0)

struct XcdBarrier { unsigned* bar; unsigned x; volatile LAS unsigned* st; };

__device__ __forceinline__ XcdBarrier xcd_barrier_post(unsigned* bar, volatile LAS unsigned* st) {
    XcdBarrier b; b.bar = bar; b.x = xb_xcc_id(); b.st = st;
    if (threadIdx.x == 0) (void)xb_add(&bar[XB_XCNT(b.x)], 1u);
    return b;
}
__device__ __forceinline__ void xcd_barrier_complete(unsigned* bar, unsigned x, unsigned& nloc, unsigned& nx) {
    const unsigned G = gridDim.x * gridDim.y * gridDim.z;
    unsigned sum, cnt, mine, sp = 0u;
    for (;;) {
        sum = 0u; cnt = 0u; mine = 0u;
#pragma unroll
        for (unsigned j = 0; j < 16; ++j) { const unsigned c = xb_ld(&bar[XB_XCNT(j)]); sum += c; cnt += (c > 0u) ? 1u : 0u; mine = (j == x) ? c : mine; }
        if (sum == G) break;
        __builtin_amdgcn_s_sleep(1);
        if ((++sp & 255u) == 0u) { if (xb_ld(&bar[XB_TMO])) break; if (sp > XB_SPIN_CAP) { atomicAdd(&bar[XB_TMO], 1u); break; } }
    }
    nloc = mine > 0u ? mine : 1u; nx = cnt > 0u ? cnt : 1u;
}
__device__ __forceinline__ void xcd_barrier(const XcdBarrier& b) {
    asm volatile("s_waitcnt vmcnt(0)" ::: "memory");
    __syncthreads();
    if (threadIdx.x == 0) {
        unsigned* bar = b.bar;
        __builtin_amdgcn_s_waitcnt(0);
        unsigned nloc = b.st[0], nx = b.st[1];
        if (nloc == 0u) { xcd_barrier_complete(bar, b.x, nloc, nx); b.st[0] = nloc; b.st[1] = nx; }
        const unsigned old = xb_add(&bar[XB_XSUB(b.x)], 1u);
        const unsigned gen = old / nloc;
        if (old + 1u == (gen + 1u) * nloc) {
            __builtin_amdgcn_fence(__ATOMIC_RELEASE, "agent");
            asm volatile("s_waitcnt vmcnt(0)" ::: "memory");
            const unsigned og = xb_add(&bar[XB_TOP], 1u);
            const unsigned tg = og / nx;
            if (og + 1u == (tg + 1u) * nx) xb_add(&bar[XB_TOPGEN], 1u);
            else XB_SPIN(xb_ld(&bar[XB_TOPGEN]) == tg, bar);
            __builtin_amdgcn_fence(__ATOMIC_ACQUIRE, "agent");
            xb_add(&bar[XB_XGEN(b.x)], 1u);
            asm volatile("s_waitcnt vmcnt(0)" ::: "memory");
        } else {
            XB_SPIN(xb_ld(&bar[XB_XGEN(b.x)]) == gen, bar);
            __builtin_amdgcn_fence(__ATOMIC_ACQUIRE, "agent");
            asm volatile("s_waitcnt vmcnt(0)" ::: "memory");
        }
    }
    __syncthreads();
}

struct Params {
    const float* in[19];
    float* out;
    unsigned char* ws;
    int ph_lo, ph_hi;
    int li, pad;
};
enum { I_X = 0, I_NORM_MIX, I_W_IN, I_B_IN, I_CONV_W, I_CONV_B, I_RG_W, I_RG_B, I_RG_LAM, I_P_RNN, I_P_ATTN, I_W_OUT, I_NORM_FFN, I_W_ROUTER, I_B_ROUTER, I_W_GATE, I_W_UP, I_W_DOWN, I_NORM_FINAL };

__device__ __forceinline__ unsigned long long karg_u64(int byte_off) {
    const auto ka = __builtin_amdgcn_kernarg_segment_ptr();
    unsigned long long v;
    asm volatile("s_load_dwordx2 %0, %1, %2\n\ts_waitcnt lgkmcnt(0)" : "=s"(v) : "s"(ka), "i"(byte_off) : "memory");
    return v;
}
#define KIN(i) ((const float*)(const GAS float*)karg_u64(8 * (i)))
#define KOUT() ((float*)(GAS float*)karg_u64(152))
#define KWS() ((unsigned char*)(GAS unsigned char*)karg_u64(160))
static_assert(sizeof(Params) == 184, "Params layout");

__device__ __forceinline__ float xlane32(float v, bool lower_half) {
    const unsigned u = __builtin_bit_cast(unsigned, v);
    const auto r = __builtin_amdgcn_permlane32_swap(u, u, false, false);
    return __builtin_bit_cast(float, lower_half ? (unsigned)r[1] : (unsigned)r[0]);
}
struct EpiInProj {
    static constexpr bool PERM = true, AFTER_DRAIN = false;
    const float* bias; bf16* xr; bf16* ggr; bf16* qkv; bf16* sga; bf16* sgb; const float* cosT; const float* sinT; int pn_off;
    __device__ __forceinline__ void operator()(const f32x4 (&acc)[2][2][4][2], const pg8::Unit& u, int wr, int wc, int fr, int fq) const {
        const int pn = u.pn + pn_off;
        const int row0 = u.pm * 256 + wr * 64 + fr, ccol = wc * 32 + 8 * fq, bcol0 = pn * 256 + ccol;
        f32x4 bv[2][2];
#pragma unroll
        for (int bj = 0; bj < 2; ++bj)
#pragma unroll
            for (int n = 0; n < 2; ++n) bv[bj][n] = *(const f32x4*)(bias + bcol0 + bj * 128 + 4 * n);
        __builtin_amdgcn_s_waitcnt(0x0F70);
        if (pn < 8 || pn >= 26) {
            bf16* O; int colt; int act;
            if (pn < 4) { O = xr; colt = pn * 256; act = 0; } else if (pn < 8) { O = ggr; colt = (pn - 4) * 256; act = 1; }
            else if (pn < 30) { O = sga; colt = (pn - 26) * 256; act = 2; } else { O = sgb; colt = (pn - 30) * 256; act = 2; }
#pragma unroll
            for (int ai = 0; ai < 2; ++ai)
#pragma unroll
                for (int m = 0; m < 4; ++m) { bf16* rowp = O + (size_t)(row0 + ai * 128 + m * 16) * 1024 + colt + ccol;
#pragma unroll
                    for (int bj = 0; bj < 2; ++bj) { f32x4 v0 = acc[ai][bj][m][0] + bv[bj][0], v1 = acc[ai][bj][m][1] + bv[bj][1];
                        if (act == 1) {
#pragma unroll
                            for (int e = 0; e < 4; ++e) { v0[e] = gelu_tanh(v0[e]); v1[e] = gelu_tanh(v1[e]); } }
                        if (act == 2) {
#pragma unroll
                            for (int e = 0; e < 4; ++e) { v0[e] = sigmoidf_(v0[e]); v1[e] = sigmoidf_(v1[e]); } }
                        v4u w; w.x = pk2(v0[0], v0[1]); w.y = pk2(v0[2], v0[3]); w.z = pk2(v1[0], v1[1]); w.w = pk2(v1[2], v1[3]);
                        *(v4u*)(rowp + bj * 128) = w; } }
        } else {
            const int q = pn - 8, sec = q / 6, g = (q % 6) >> 1, tig = q & 1;
            const int lg = 2 * g, dil = 1 << lg, L = SEQ >> lg;
            bf16* base = qkv + (size_t)(sec * 3 + g) * ((size_t)TALL * 512);
            const bool rot = (sec < 2) && (wc == 0);
            const float sgn = (fq < 2) ? -1.0f : 1.0f;
#pragma unroll
            for (int ai = 0; ai < 2; ++ai)
#pragma unroll
                for (int m = 0; m < 4; ++m) {
                    const int row = row0 + ai * 128 + m * 16, b = row >> 13, s = row & (SEQ - 1), rr = s & (dil - 1), j = s >> lg;
                    f32x4 cs0 = {1.f, 1.f, 1.f, 1.f}, cs1 = cs0, sn0 = {0.f, 0.f, 0.f, 0.f}, sn1 = sn0;
                    if (rot) { const float* cp = cosT + s * 16 + 8 * (fq & 1); const float* sp = sinT + s * 16 + 8 * (fq & 1);
                        cs0 = *(const f32x4*)cp; cs1 = *(const f32x4*)(cp + 4); sn0 = *(const f32x4*)sp; sn1 = *(const f32x4*)(sp + 4); }
#pragma unroll
                    for (int bj = 0; bj < 2; ++bj) { const int h = 2 * tig + bj;
                        f32x4 v0 = acc[ai][bj][m][0] + bv[bj][0], v1 = acc[ai][bj][m][1] + bv[bj][1];
                        if (rot) {
#pragma unroll
                            for (int e = 0; e < 4; ++e) { const float p0 = xlane32(v0[e], fq < 2), p1 = xlane32(v1[e], fq < 2);
                                v0[e] = v0[e] * cs0[e] + sgn * p0 * sn0[e]; v1[e] = v1[e] * cs1[e] + sgn * p1 * sn1[e]; } }
                        bf16* dst = base + ((size_t)(((b * 4 + h) * dil + rr) * L + j)) * 128 + ccol;
                        v4u w; w.x = pk2(v0[0], v0[1]); w.y = pk2(v0[2], v0[3]); w.z = pk2(v1[0], v1[1]); w.w = pk2(v1[2], v1[3]);
                        *(v4u*)dst = w; } }
        }
        __builtin_amdgcn_s_waitcnt(0x0F70);
    }
};
struct EpiGate {
    static constexpr bool PERM = true, AFTER_DRAIN = false;
    const bf16* gate; const bf16* add; bf16* out;
    __device__ __forceinline__ void operator()(const f32x4 (&acc)[2][2][4][2], const pg8::Unit& u, int wr, int wc, int fr, int fq) const {
        const int row0 = u.pm * 256 + wr * 64 + fr, col0 = u.pn * 256 + wc * 32 + 8 * fq;
#pragma unroll
        for (int ai = 0; ai < 2; ++ai)
#pragma unroll
            for (int m = 0; m < 4; ++m) { const size_t off = (size_t)(row0 + ai * 128 + m * 16) * 1024 + col0;
#pragma unroll
                for (int bj = 0; bj < 2; ++bj) { const v4u gw = *(const v4u*)(gate + off + bj * 128);
                    v4u aw = {0u, 0u, 0u, 0u}; if (add) aw = *(const v4u*)(add + off + bj * 128);
                    const f32x4 v0 = acc[ai][bj][m][0], v1 = acc[ai][bj][m][1];
                    v4u w;
                    w.x = pk2(bflo(aw.x) + bflo(gw.x) * v0[0], bfhi(aw.x) + bfhi(gw.x) * v0[1]);
                    w.y = pk2(bflo(aw.y) + bflo(gw.y) * v0[2], bfhi(aw.y) + bfhi(gw.y) * v0[3]);
                    w.z = pk2(bflo(aw.z) + bflo(gw.z) * v1[0], bfhi(aw.z) + bfhi(gw.z) * v1[1]);
                    w.w = pk2(bflo(aw.w) + bflo(gw.w) * v1[2], bfhi(aw.w) + bfhi(gw.w) * v1[3]);
                    *(v4u*)(out + off + bj * 128) = w; } }
    }
};
struct EpiResid {
    static constexpr bool PERM = false, AFTER_DRAIN = false;
    const float* res; float* out;
    __device__ __forceinline__ void operator()(const f32x4 (&acc)[2][2][4][2], const pg8::Unit& u, int wr, int wc, int fr, int fq) const {
        const int row0 = u.pm * 256 + wr * 64 + fr, col0 = u.pn * 256 + wc * 32 + 4 * fq;
#pragma unroll
        for (int ai = 0; ai < 2; ++ai)
#pragma unroll
            for (int m = 0; m < 4; ++m) { const size_t off = (size_t)(row0 + ai * 128 + m * 16) * 1024 + col0;
#pragma unroll
                for (int bj = 0; bj < 2; ++bj)
#pragma unroll
                    for (int n = 0; n < 2; ++n) { const f32x4 r = *(const f32x4*)(res + off + bj * 128 + n * 16); *(f32x4*)(out + off + bj * 128 + n * 16) = r + acc[ai][bj][m][n]; } }
    }
};
struct MoeOrder {
    int G, c, nJ, nunits;
    __device__ __forceinline__ bool next(int i, pg8::Unit& u) const {
        const int L = i * G + c; if (L >= nunits) return false;
        const int per_e = 16 * nJ, e = L / per_e, rem = L % per_e, panel = rem / nJ, j = rem % nJ;
        u.pm = ((panel >> 2) * 16 + e) * 4 + (panel & 3); u.pn = e * nJ + j; return true;
    }
    __device__ __forceinline__ void a_ready(const pg8::Unit&) const {}
    __device__ __forceinline__ void done(const pg8::Unit&) const {}
};
struct EpiSwiglu {
    static constexpr bool PERM = true, AFTER_DRAIN = false;
    bf16* hid;
    __device__ __forceinline__ void operator()(const f32x4 (&acc)[2][2][4][2], const pg8::Unit& u, int wr, int wc, int fr, int fq) const {
        const int row0 = u.pm * 256 + wr * 64 + fr, col0 = (u.pn & 15) * 128 + wc * 32 + 8 * fq;
#pragma unroll
        for (int ai = 0; ai < 2; ++ai)
#pragma unroll
            for (int m = 0; m < 4; ++m) { bf16* dst = hid + (size_t)(row0 + ai * 128 + m * 16) * DFF + col0;
                float o[8];
#pragma unroll
                for (int n = 0; n < 2; ++n)
#pragma unroll
                    for (int e = 0; e < 4; ++e) { const float gt = acc[ai][0][m][n][e], up = acc[ai][1][m][n][e]; o[4 * n + e] = gt * sigmoidf_(gt) * up; }
                v4u w; w.x = pk2(o[0], o[1]); w.y = pk2(o[2], o[3]); w.z = pk2(o[4], o[5]); w.w = pk2(o[6], o[7]);
                *(v4u*)dst = w; }
    }
};
struct EpiDown {
    static constexpr bool PERM = true, AFTER_DRAIN = false;
    bf16* eo; const float* gatev;
    __device__ __forceinline__ void operator()(const f32x4 (&acc)[2][2][4][2], const pg8::Unit& u, int wr, int wc, int fr, int fq) const {
        const int row0 = u.pm * 256 + wr * 64 + fr, col0 = (u.pn & 3) * 256 + wc * 32 + 8 * fq;
#pragma unroll
        for (int ai = 0; ai < 2; ++ai)
#pragma unroll
            for (int m = 0; m < 4; ++m) { const int row = row0 + ai * 128 + m * 16; const float gt = gatev[row]; bf16* dst = eo + (size_t)row * 1024 + col0;
#pragma unroll
                for (int bj = 0; bj < 2; ++bj) { const f32x4 v0 = acc[ai][bj][m][0] * gt, v1 = acc[ai][bj][m][1] * gt;
                    v4u w; w.x = pk2(v0[0], v0[1]); w.y = pk2(v0[2], v0[3]); w.z = pk2(v1[0], v1[1]); w.w = pk2(v1[2], v1[3]);
                    *(v4u*)(dst + bj * 128) = w; } }
    }
};

__device__ __forceinline__ void tr_item(const float* W, int ldw, int k0, int n0, bf16* dst, size_t drow0, int ldd, LAS float* scr, int lane) {
#pragma unroll 8
    for (int i = 0; i < 32; ++i) { const int kk = 2 * i + (lane >> 5); scr[kk * 33 + (lane & 31)] = W[(size_t)(k0 + kk) * ldw + n0 + (lane & 31)]; }
    LDS_WAIT(); asm volatile("" ::: "memory");
    const int c = lane & 7;
#pragma unroll
    for (int j = 0; j < 4; ++j) { const int n = (lane >> 3) + 8 * j; const LAS float* s = scr + (8 * c) * 33 + n;
        v4u o; o.x = pk2(s[0 * 33], s[1 * 33]); o.y = pk2(s[2 * 33], s[3 * 33]); o.z = pk2(s[4 * 33], s[5 * 33]); o.w = pk2(s[6 * 33], s[7 * 33]);
        *(v4u*)(dst + (drow0 + n) * (size_t)ldd + k0 + 8 * c) = o; }
    LDS_WAIT(); asm volatile("" ::: "memory");
}
__device__ __forceinline__ void rms_row(const float* xrow, const float* gain, int lane, f32x4 (&o)[4]) {
    const f32x4* xr = (const f32x4*)xrow + lane; float s = 0.f;
#pragma unroll
    for (int j = 0; j < 4; ++j) { o[j] = xr[64 * j]; s += (o[j].x * o[j].x + o[j].y * o[j].y) + (o[j].z * o[j].z + o[j].w * o[j].w); }
    const float rstd = 1.0f / sqrtf(wave_sum(s) * (1.0f / DM) + RMS_EPS);
#pragma unroll
    for (int j = 0; j < 4; ++j) { const f32x4 g = ((const f32x4*)gain)[64 * j + lane]; o[j] = o[j] * rstd * g; }
}
__device__ __forceinline__ void store_row_bf16(bf16* orow, int lane, const f32x4 (&o)[4]) {
    unsigned long long* o8 = (unsigned long long*)orow + lane;
#pragma unroll
    for (int j = 0; j < 4; ++j) o8[64 * j] = (unsigned long long)pk2(o[j].x, o[j].y) | ((unsigned long long)pk2(o[j].z, o[j].w) << 32);
}

__device__ const float ROPE_INV[16] = {1.0f, 0.44036659598350525f, 0.1939227432012558f, 0.08539710193872452f, 0.03760603070259094f, 0.01656043902039528f, 0.007292664609849453f, 0.0032114458736032248f,
    0.0014142135623842478f, 0.000622772378847003f, 0.00027424818836152554f, 0.00012076973507646471f, 5.318296098266728e-05f, 2.34199997066753e-05f, 1.0313386155758053e-05f, 4.541670477919979e-06f};

__device__ __forceinline__ void phase_prep(LAS unsigned char* lds, int tid) {
    const int wave = tid >> 6, lane = tid & 63, G = gridDim.x;
    LAS float* scr = (LAS float*)(lds + wave * 16384);
    const int gw = blockIdx.x * 8 + wave, NGW = G * 8;
    unsigned char* ws = KWS();
    const float* w_in = KIN(I_W_IN); const float* p_rnn = KIN(I_P_RNN); const float* p_attn = KIN(I_P_ATTN); const float* w_out = KIN(I_W_OUT);
    constexpr int I_WIN = 16 * 272, I_PR = 16 * 32, I_PA = 8 * 32, I_WO = 16 * 32, NIT = I_WIN + I_PR + I_PA + I_WO;
    for (int it = gw; it < NIT; it += NGW) {
        int r = it;
        if (r < I_WIN) { const int kb = r / 272, nb = r % 272; tr_item(w_in, D_IN, kb * 64, nb * 32, (bf16*)(ws + WS_WIN), nb * 32, 1024, scr, lane); continue; } r -= I_WIN;
        if (r < I_PR) { const int kb = r / 32, nb = r % 32; tr_item(p_rnn, 1024, kb * 64, nb * 32, (bf16*)(ws + WS_PRNN), nb * 32, 1024, scr, lane); continue; } r -= I_PR;
        if (r < I_PA) { const int kb = r / 32, nb = r % 32; tr_item(p_attn, 1024, kb * 64, nb * 32, (bf16*)(ws + WS_PATT), nb * 32, 512, scr, lane); continue; } r -= I_PA;
        { const int kb = r / 32, nb = r % 32; tr_item(w_out, 1024, kb * 64, nb * 32, (bf16*)(ws + WS_WOUT), nb * 32, 1024, scr, lane); }
    }
    for (int i = blockIdx.x * 512 + tid; i < SEQ * 16; i += G * 512) {
        const int pos = i >> 4, k = i & 15;
        const float ang = (float)pos * ROPE_INV[k];
        const double a = (double)ang;
        const double kq = __builtin_rint(a * 0.63661977236758134308);
        double y = __builtin_fma(-kq, 1.57079632679489655800e+00, a); y = __builtin_fma(-kq, 6.12323399573676603587e-17, y);
        const int q = ((int)kq) & 3;
        const double y2 = y * y;
        const double sp = y * (1.0 + y2 * (-1.0 / 6 + y2 * (1.0 / 120 + y2 * (-1.0 / 5040 + y2 * (1.0 / 362880 + y2 * (-1.0 / 39916800 + y2 * (1.0 / 6227020800.0)))))));
        const double cp = 1.0 + y2 * (-0.5 + y2 * (1.0 / 24 + y2 * (-1.0 / 720 + y2 * (1.0 / 40320 + y2 * (-1.0 / 3628800 + y2 * (1.0 / 479001600.0 + y2 * (-1.0 / 87178291200.0)))))));
        double sv, cv;
        if (q == 0) { sv = sp; cv = cp; } else if (q == 1) { sv = cp; cv = -sp; } else if (q == 2) { sv = -sp; cv = -cp; } else { sv = -cp; cv = sp; }
        ((float*)(ws + WS_COS))[i] = (float)cv; ((float*)(ws + WS_SIN))[i] = (float)sv;
    }
    { const float* rgw = KIN(I_RG_W); const float* cvw = KIN(I_CONV_W);
      for (int f = blockIdx.x * 512 + tid; f < 2 * 8 * 8 * 32 * 64; f += G * 512) {
        const int ln = f & 63, frag = f >> 6, kk = frag & 3, tap = (frag >> 2) & 3, g = (frag >> 4) & 1, u = frag >> 5, cg = u & 7, n = (u >> 3) & 7, dir = u >> 6, fr = ln & 15, fq = ln >> 4;
        const float* wp = rgw + ((size_t)(((dir * 2 + g) * 8 + n) * 128 + kk * 32 + 8 * fq)) * 128 + cg * 16 + fr;
        const float* cp = cvw + tap * 1024 + n * 128 + kk * 32 + 8 * fq;
        v4u w; w.x = pk2(wp[0] * cp[0], wp[128] * cp[1]); w.y = pk2(wp[256] * cp[2], wp[384] * cp[3]); w.z = pk2(wp[512] * cp[4], wp[640] * cp[5]); w.w = pk2(wp[768] * cp[6], wp[896] * cp[7]);
        ((v4u*)(ws + WS_RGWF))[f] = w; }
      const float* rgb = KIN(I_RG_B); const float* cvb = KIN(I_CONV_B);
      for (int i = blockIdx.x * 512 + tid; i < 4096; i += G * 512) { const int dg = i >> 10, cc = i & 1023, n = cc >> 7, j = cc & 127; float s = rgb[i];
        for (int k = 0; k < 128; ++k) s += cvb[n * 128 + k] * rgw[((size_t)((dg * 8 + n) * 128 + k)) * 128 + j];
        ((float*)(ws + WS_RGBIAS))[i] = s; } }
    const float* xin = KIN(I_X); const float* nmix = KIN(I_NORM_MIX);
    for (int m = gw; m < TALL; m += NGW) { f32x4 o[4]; rms_row(xin + (size_t)m * DM, nmix, lane, o); store_row_bf16((bf16*)(ws + WS_XN) + (size_t)m * DM, lane, o); }
}

constexpr int RNN_RING_BYTES = 128 * 256;
constexpr int RNN_QD = 2, RNN_Q_OFF = 4 * RNN_RING_BYTES, RNN_Q_BYTES = RNN_QD * 2048;
constexpr int RNN_CTL_OFF = RNN_Q_OFF + 4 * RNN_Q_BYTES;
__device__ __forceinline__ int rnn_cell(int row, int j) { return ((row >> 4) & 7) * 4096 + ((j * 16 + (row & 15)) << 4); }
#define RNN_TILE(i) (dir ? 511 - (i) : (i))
__device__ __forceinline__ void rnn_spin_ge(volatile LAS unsigned* w, unsigned want) {
    unsigned spins = 0;
    while ((unsigned)__builtin_amdgcn_readfirstlane((int)*w) < want) { __builtin_amdgcn_s_sleep(1); if (++spins > (1u << 22)) break; }
    asm volatile("" ::: "memory");
}
__device__ __forceinline__ void rnn_producer(LAS unsigned char* ring, LAS unsigned char* queue, volatile LAS unsigned* head, volatile LAS unsigned* tail,
                                             int unit, int dir, const bf16* xr, const v4u* rgwf, const float* rgbias, int lane) {
    const int b = unit >> 6, n = (unit >> 3) & 7, cg = unit & 7, fr = lane & 15, fq = lane >> 4, c = n * 128 + cg * 16 + fr;
    bf16x8 Wr[4][4];
    { const v4u* wp = rgwf + ((size_t)((dir * 8 + n) * 8 + cg) * 32) * 64 + lane;
#pragma unroll
      for (int tap = 0; tap < 4; ++tap)
#pragma unroll
        for (int kk = 0; kk < 4; ++kk) Wr[tap][kk] = __builtin_bit_cast(bf16x8, wp[((0 * 4 + tap) * 4 + kk) * 64]); }
    const float* conv_w = KIN(I_CONV_W); const float* conv_b = KIN(I_CONV_B); const float* rgl = KIN(I_RG_LAM);
    const bool mine = fq == ((cg & 1) * 2 + (fr >> 3));
    unsigned cq0, cq1, cq2, cq3;
    { const unsigned w0 = f2bf(conv_w[c]), w1 = f2bf(conv_w[1024 + c]), w2 = f2bf(conv_w[2048 + c]), w3 = f2bf(conv_w[3072 + c]); const int sh = (fr & 1) * 16;
      cq0 = mine ? (w0 << sh) : 0u; cq1 = mine ? (w1 << sh) : 0u; cq2 = mine ? (w2 << sh) : 0u; cq3 = mine ? (w3 << sh) : 0u; }
    float br = rgbias[(dir * 2 + 0) * 1024 + c], cbv = conv_b[c];
    const float spl2 = 8.0f * log1pf(expf(-rgl[dir * 1024 + c])) * 1.4426950408889634f;
    const int kkc = cg >> 1, jsel = (fr & 7) >> 1;
    const bf16* xb = xr + (size_t)b * SEQ * 1024 + n * 128;
    for (int i = lane; i < RNN_RING_BYTES / 16; i += 64) *(LAS v4u*)(ring + i * 16) = (v4u){0u, 0u, 0u, 0u};
    const unsigned lofs = (unsigned)(lane & 15) * 2048u + (unsigned)(lane >> 4) * 16u;
#define RNN_FILL(kt) do { const int kt_ = (kt); LAS unsigned char* dst_ = ring + (kt_ & 7) * 4096; \
        if (kt_ >= 0 && kt_ < 512) { _Pragma("unroll") for (int i = 0; i < 4; ++i) \
            __builtin_amdgcn_global_load_lds((const unsigned*)((const char*)(xb + (size_t)kt_ * 16384) + (lofs + (unsigned)i * 64u)), (LAS unsigned*)(dst_ + i * 1024), 16, 0, 0); } \
        else { _Pragma("unroll") for (int i = 0; i < 4; ++i) *(LAS v4u*)(dst_ + i * 1024 + lane * 16) = (v4u){0u, 0u, 0u, 0u}; } } while (0)
    RNN_FILL(RNN_TILE(0)); RNN_FILL(RNN_TILE(1));
#pragma unroll 1
    for (int i = 0; i < 512; ++i) {
        const int t0 = 16 * RNN_TILE(i);
        asm volatile("s_waitcnt vmcnt(0)" ::: "memory");
        if (i >= 4) rnn_spin_ge(tail, (unsigned)(i - 3));
        RNN_FILL(RNN_TILE(i + 2));
        float brl = br, cbl = cbv; asm volatile("" : "+v"(brl), "+v"(cbl));
        f32x4 ar = {brl, brl, brl, brl}, ax = {cbl, cbl, cbl, cbl};
#pragma unroll
        for (int tap = 0; tap < 4; ++tap) {
            unsigned cwt = tap == 0 ? cq0 : tap == 1 ? cq1 : tap == 2 ? cq2 : cq3; asm volatile("" : "+v"(cwt));
            v4u dv; dv.x = jsel == 0 ? cwt : 0u; dv.y = jsel == 1 ? cwt : 0u; dv.z = jsel == 2 ? cwt : 0u; dv.w = jsel == 3 ? cwt : 0u; const bf16x8 Dt = __builtin_bit_cast(bf16x8, dv);
            const LAS unsigned char* pa = ring + rnn_cell(t0 + fr + tap - 2, fq);
            { const bf16x8 ac = *(const LAS bf16x8*)(pa + kkc * 1024); ax = __builtin_amdgcn_mfma_f32_16x16x32_bf16(ac, Dt, ax, 0, 0, 0); }
#pragma unroll
            for (int kk = 0; kk < 4; ++kk) { const bf16x8 a = *(const LAS bf16x8*)(pa + kk * 1024); ar = __builtin_amdgcn_mfma_f32_16x16x32_bf16(a, Wr[tap][kk], ar, 0, 0, 0); }
        }
        f32x4 av, tv;
#pragma unroll
        for (int r = 0; r < 4; ++r) {
            const float rg = __builtin_amdgcn_rcpf(1.0f + __builtin_amdgcn_exp2f(-1.4426950408889634f * ar[r]));
            const float a = __builtin_amdgcn_exp2f(-spl2 * rg);
            av[r] = a; tv[r] = ax[r] * __builtin_amdgcn_sqrtf(fmaxf(1.0f - a * a, 0.f)); }
        if (i >= RNN_QD) rnn_spin_ge(tail, (unsigned)(i - RNN_QD + 1));
        LAS unsigned char* qe = queue + (i % RNN_QD) * 2048 + lane * 32;
        *(LAS f32x4*)qe = av; *(LAS f32x4*)(qe + 16) = tv;
        asm volatile("s_waitcnt lgkmcnt(0)" ::: "memory");
        if (lane == 0) *head = (unsigned)(i + 1);
    }
#undef RNN_FILL
}
__device__ __forceinline__ void rnn_quads(float P, float H, int fr, int fq, int dir, float& Pc, float& Hc, float& Pw, float& Hw) {
    float Pq[4], Hq[4];
#pragma unroll
    for (int qq = 0; qq < 4; ++qq) { Pq[qq] = __shfl(P, fr + 16 * qq); Hq[qq] = __shfl(H, fr + 16 * qq); }
    Pc = 1.f; Hc = 0.f; Pw = 1.f; Hw = 0.f;
    if (dir == 0) {
#pragma unroll
        for (int qq = 0; qq < 4; ++qq) { if (qq < fq) { Hc = Pq[qq] * Hc + Hq[qq]; Pc *= Pq[qq]; } Hw = Pq[qq] * Hw + Hq[qq]; Pw *= Pq[qq]; }
    } else {
#pragma unroll
        for (int qq = 3; qq >= 0; --qq) { if (qq > fq) { Hc = Pq[qq] * Hc + Hq[qq]; Pc *= Pq[qq]; } Hw = Pq[qq] * Hw + Hq[qq]; Pw *= Pq[qq]; }
    }
}
__device__ __forceinline__ void rnn_consumer(const LAS unsigned char* ring, const LAS unsigned char* queue, volatile LAS unsigned* head, volatile LAS unsigned* tail,
                                             volatile LAS unsigned* myflag, volatile LAS unsigned* otherflag, unsigned epoch,
                                             int unit, int dir, const bf16* ggr, bf16* yout, unsigned long long* hx, const v4u* rgwf, const float* rgbias, int lane) {
    const int b = unit >> 6, n = (unit >> 3) & 7, cg = unit & 7, fr = lane & 15, fq = lane >> 4, c = n * 128 + cg * 16 + fr;
    bf16x8 Wi[4][4];
    { const v4u* wp = rgwf + ((size_t)((dir * 8 + n) * 8 + cg) * 32) * 64 + lane;
#pragma unroll
      for (int tap = 0; tap < 4; ++tap)
#pragma unroll
        for (int kk = 0; kk < 4; ++kk) Wi[tap][kk] = __builtin_bit_cast(bf16x8, wp[((1 * 4 + tap) * 4 + kk) * 64]); }
    float bi = rgbias[(dir * 2 + 1) * 1024 + c];
    const unsigned obase = (unsigned)(((size_t)b * SEQ + 4 * fq) * 1024 + c) * 2u;
    unsigned long long* hxu = hx + (size_t)unit * 512 * 64;
    float carry = 0.f;
    unsigned o01 = 0u, o23 = 0u; int ot = 0;
#define RNN_CSTEP(SECOND) do { \
        const int k = RNN_TILE(i), t0 = 16 * k; \
        if (i > 0) { if (SECOND && i > 256) { *(bf16*)((char*)yout + obase + (unsigned)(ot + 0) * 2048u) = (bf16)(o01 & 0xffffu); *(bf16*)((char*)yout + obase + (unsigned)(ot + 1) * 2048u) = (bf16)(o01 >> 16); \
                                               *(bf16*)((char*)yout + obase + (unsigned)(ot + 2) * 2048u) = (bf16)(o23 & 0xffffu); *(bf16*)((char*)yout + obase + (unsigned)(ot + 3) * 2048u) = (bf16)(o23 >> 16); } \
                     else hxu[(ot >> 4) * 64 + lane] = (unsigned long long)o01 | ((unsigned long long)o23 << 32); } \
        if (SECOND && i == 256) {                                                \
            asm volatile("s_waitcnt vmcnt(0)" ::: "memory"); \
            if (lane == 0) *myflag = epoch; \
            rnn_spin_ge(otherflag, epoch); } \
        unsigned long long hp = 0ull; unsigned short gv[4] = {0, 0, 0, 0}; \
        if (SECOND) { hp = __hip_atomic_load(hxu + k * 64 + lane, __ATOMIC_RELAXED, __HIP_MEMORY_SCOPE_AGENT); \
            _Pragma("unroll") for (int r = 0; r < 4; ++r) gv[r] = *(const bf16*)((const char*)ggr + obase + (unsigned)(t0 + r) * 2048u); } \
        rnn_spin_ge(head, (unsigned)(i + 1));                                    \
        float bil = bi; asm volatile("" : "+v"(bil)); \
        f32x4 ai = {bil, bil, bil, bil}; \
        _Pragma("unroll") for (int tap = 0; tap < 4; ++tap) { const LAS unsigned char* pa = ring + rnn_cell(t0 + fr + tap - 2, fq); \
            _Pragma("unroll") for (int kk = 0; kk < 4; ++kk) { const bf16x8 a = *(const LAS bf16x8*)(pa + kk * 1024); ai = __builtin_amdgcn_mfma_f32_16x16x32_bf16(a, Wi[tap][kk], ai, 0, 0, 0); } } \
        const LAS unsigned char* qe = queue + (i % RNN_QD) * 2048 + lane * 32; \
        const f32x4 av = *(const LAS f32x4*)qe, tv = *(const LAS f32x4*)(qe + 16); \
        asm volatile("s_waitcnt lgkmcnt(0)" ::: "memory"); \
        if (lane == 0) *tail = (unsigned)(i + 1); \
        float uv[4]; \
        _Pragma("unroll") for (int r = 0; r < 4; ++r) uv[r] = tv[r] * __builtin_amdgcn_rcpf(1.0f + __builtin_amdgcn_exp2f(-1.4426950408889634f * ai[r])); \
        float hl[4], pl[4]; float H = 0.f, P = 1.f; \
        if (dir == 0) { _Pragma("unroll") for (int r = 0; r < 4; ++r) { H = av[r] * H + uv[r]; P *= av[r]; hl[r] = H; pl[r] = P; } } \
        else          { _Pragma("unroll") for (int r = 3; r >= 0; --r) { H = av[r] * H + uv[r]; P *= av[r]; hl[r] = H; pl[r] = P; } } \
        float Pc, Hc, Pw, Hw; rnn_quads(P, H, fr, fq, dir, Pc, Hc, Pw, Hw); \
        const float Hs = Pc * carry + Hc; carry = Pw * carry + Hw; \
        float hh[4]; \
        _Pragma("unroll") for (int r = 0; r < 4; ++r) { hh[r] = pl[r] * Hs + hl[r]; if (SECOND) hh[r] = bf2f(gv[r]) * (bf2f((unsigned short)(hp >> (16 * r))) + hh[r]); } \
        o01 = pk2(hh[0], hh[1]); o23 = pk2(hh[2], hh[3]); ot = t0; } while (0)
#pragma unroll 1
    for (int i = 0; i < 256; ++i) RNN_CSTEP(false);
#pragma unroll 1
    for (int i = 256; i < 512; ++i) RNN_CSTEP(true);
    *(bf16*)((char*)yout + obase + (unsigned)(ot + 0) * 2048u) = (bf16)(o01 & 0xffffu); *(bf16*)((char*)yout + obase + (unsigned)(ot + 1) * 2048u) = (bf16)(o01 >> 16);
    *(bf16*)((char*)yout + obase + (unsigned)(ot + 2) * 2048u) = (bf16)(o23 & 0xffffu); *(bf16*)((char*)yout + obase + (unsigned)(ot + 3) * 2048u) = (bf16)(o23 >> 16);
#undef RNN_CSTEP
}
#undef RNN_TILE

typedef short v4i16_t __attribute__((ext_vector_type(4)));
__device__ __forceinline__ unsigned attn_off_a(unsigned row, unsigned ch) { return 2048u * (row >> 3) + 512u * (ch >> 2) + 64u * (row & 7) + 16u * ((ch & 3) ^ ((row >> 2) & 3)); }
constexpr int ATT_K_BYTES = 256 * 272, ATT_V_OFF = ATT_K_BYTES, ATT_V_BYTES = 272 * 256;
__device__ __forceinline__ void phase_attn(const bf16* qkv, bf16* og, float* lse, LAS unsigned char* lds, int tid, int G) {
    const int wave = __builtin_amdgcn_readfirstlane(tid >> 6), lane = tid & 63, fr = lane & 15, fq = lane >> 4;
    LAS unsigned char* kimg = lds;
    LAS unsigned char* vimg = lds + ATT_V_OFF;
    LAS unsigned char* pb = lds + wave * 5376;
    for (int i = tid; i < 16 * 256 / 16; i += 512) *(LAS v4u*)(vimg + 256 * 256 + i * 16) = (v4u){0u, 0u, 0u, 0u};
    v4u kp[8], vp[8]; bf16x8 qf[4]; v4u ost[4]; bf16* odst = nullptr;
#define ATT_DECODE(u_) const int g_ = (u_) >> 11, rem_ = (u_) & 2047, bl_ = rem_ >> 8, h_ = (rem_ >> 6) & 3, w_ = rem_ & 63, lg_ = 2 * g_, dil_ = 1 << lg_, L_ = SEQ >> lg_, nblk_ = 64 >> lg_, rr_ = w_ / nblk_, q0_ = (w_ % nblk_) * 128; \
        const size_t sub_ = ((size_t)((bl_ * 4 + h_) * dil_ + rr_) * L_) * 128
#define ATT_LOAD(u_) do { ATT_DECODE(u_); const bf16* Kp_ = qkv + (size_t)(1 * 3 + g_) * ((size_t)TALL * 512) + sub_; \
        const bf16* Vp_ = qkv + (size_t)(2 * 3 + g_) * ((size_t)TALL * 512) + sub_; \
        _Pragma("unroll") for (int i = 0; i < 8; ++i) { const int idx = tid + 512 * i, row = idx >> 4, ch = idx & 15, gk = q0_ - 64 + row; kp[i] = (v4u){0u, 0u, 0u, 0u}; vp[i] = kp[i]; \
            if (gk >= 0 && gk < L_) { kp[i] = *(const v4u*)(Kp_ + (size_t)gk * 128 + ch * 8); vp[i] = *(const v4u*)(Vp_ + (size_t)gk * 128 + ch * 8); } } \
        } while (0)
#define ATT_LOADQ(u_) do { ATT_DECODE(u_); const bf16* Qp_ = qkv + (size_t)(0 * 3 + g_) * ((size_t)TALL * 512) + sub_; \
        _Pragma("unroll") for (int kk = 0; kk < 4; ++kk) qf[kk] = *(const bf16x8*)(Qp_ + (size_t)(q0_ + 16 * wave + fr) * 128 + kk * 32 + 8 * fq); } while (0)
    int unit = blockIdx.x;
    if (unit < 6144) { ATT_LOAD(unit); ATT_LOADQ(unit); }
    for (; unit < 6144; unit += G) {
        ATT_DECODE(unit);
        const int k0 = q0_ - 64;
#pragma unroll
        for (int i = 0; i < 8; ++i) { const int idx = tid + 512 * i, row = idx >> 4, ch = idx & 15;
            *(LAS v4u*)(kimg + row * 272 + ch * 16) = kp[i]; *(LAS v4u*)(vimg + attn_off_a(row, ch)) = vp[i]; }
        if (odst) {
#pragma unroll
            for (int i = 0; i < 4; ++i) *(v4u*)(odst + 32 * i) = ost[i]; }
        __syncthreads();
        if (unit + G < 6144) ATT_LOAD(unit + G);
        f32x4 s[9];
#pragma unroll
        for (int kt = 0; kt < 9; ++kt) { s[kt] = (f32x4){0.f, 0.f, 0.f, 0.f};
#pragma unroll
            for (int kk = 0; kk < 4; ++kk) { const bf16x8 b = *(const LAS bf16x8*)(kimg + ((wave + kt) * 16 + fr) * 272 + (kk * 32 + 8 * fq) * 2);
                s[kt] = __builtin_amdgcn_mfma_f32_16x16x32_bf16(qf[kk], b, s[kt], 0, 0, 0); } }
        if (unit + G < 6144) ATT_LOADQ(unit + G);
        const float scale2 = 0.08838834764831845f * 1.4426950408889634f;
        float mx[4] = {-1e30f, -1e30f, -1e30f, -1e30f};
#pragma unroll
        for (int kt = 0; kt < 9; ++kt) { const int lk = (wave + kt) * 16 + fr, gk = k0 + lk;
#pragma unroll
            for (int r = 0; r < 4; ++r) { const int lq = 16 * wave + 4 * fq + r, rel = lk - 64 - lq;
                const bool valid = (rel >= -64) && (rel <= 64) && (gk >= 0) && (gk < L_);
                const float sv = valid ? s[kt][r] * scale2 : -1e30f; s[kt][r] = sv; mx[r] = fmaxf(mx[r], sv); } }
#pragma unroll
        for (int r = 0; r < 4; ++r) {
#pragma unroll
            for (int o = 1; o < 16; o <<= 1) mx[r] = fmaxf(mx[r], __shfl_xor(mx[r], o)); }
        float sum[4] = {0.f, 0.f, 0.f, 0.f};
#pragma unroll
        for (int kt = 0; kt < 9; ++kt)
#pragma unroll
            for (int r = 0; r < 4; ++r) { const float pv = __builtin_amdgcn_exp2f(s[kt][r] - mx[r]); sum[r] += pv; s[kt][r] = pv; }
#pragma unroll
        for (int r = 0; r < 4; ++r) {
#pragma unroll
            for (int o = 1; o < 16; o <<= 1) sum[r] += __shfl_xor(sum[r], o); }
        if (fr == 0) {
#pragma unroll
            for (int r = 0; r < 4; ++r) { const size_t t = (size_t)bl_ * SEQ + (size_t)(q0_ + 16 * wave + 4 * fq + r) * dil_ + rr_; (lse + (size_t)g_ * ((size_t)TALL * 4))[t * 4 + h_] = (mx[r] + __builtin_amdgcn_logf(sum[r])) * 0.6931471805599453f; } }
        __syncthreads();
#pragma unroll
        for (int kt = 0; kt < 9; ++kt)
#pragma unroll
            for (int r = 0; r < 4; ++r) *(LAS unsigned short*)(pb + (4 * fq + r) * 336 + (kt * 16 + fr) * 2) = (unsigned short)f2bf(s[kt][r]);
        *(LAS v2u*)(pb + (lane >> 2) * 336 + 288 + (lane & 3) * 8) = (v2u){0u, 0u};
        f32x4 o[8];
#pragma unroll
        for (int nt = 0; nt < 8; ++nt) o[nt] = (f32x4){0.f, 0.f, 0.f, 0.f};
        { const unsigned tq = (unsigned)fr >> 2, tp = (unsigned)fr & 3;
          const unsigned bcom = 2048u * (2u * (unsigned)wave + (unsigned)fq) + 64u * tq + 8u * (tp & 1);
          const LAS unsigned char* vb00 = vimg + bcom + 16u * (((tp >> 1)) ^ ((2u * fq) & 3u));
          const LAS unsigned char* vb01 = vimg + bcom + 256u + 16u * (((tp >> 1)) ^ ((2u * fq + 1u) & 3u));
          const LAS unsigned char* vb10 = vimg + bcom + 16u * ((2u + (tp >> 1)) ^ ((2u * fq) & 3u));
          const LAS unsigned char* vb11 = vimg + bcom + 256u + 16u * ((2u + (tp >> 1)) ^ ((2u * fq + 1u) & 3u));
#pragma unroll
          for (int kk = 0; kk < 5; ++kk) { const bf16x8 a = *(const LAS bf16x8*)(pb + fr * 336 + (kk * 32 + 8 * fq) * 2);
#pragma unroll
            for (int nt = 0; nt < 8; ++nt) {
                const LAS unsigned char* p0 = ((nt & 1) ? vb10 : vb00) + kk * 8192 + (nt >> 1) * 512; const LAS unsigned char* p1 = ((nt & 1) ? vb11 : vb01) + kk * 8192 + (nt >> 1) * 512;
                const v4i16_t b0 = __builtin_amdgcn_ds_read_tr16_b64_v4i16((LAS v4i16_t*)p0);
                const v4i16_t b1 = __builtin_amdgcn_ds_read_tr16_b64_v4i16((LAS v4i16_t*)p1);
                bf16x8 b; b[0] = b0[0]; b[1] = b0[1]; b[2] = b0[2]; b[3] = b0[3]; b[4] = b1[0]; b[5] = b1[1]; b[6] = b1[2]; b[7] = b1[3];
                o[nt] = __builtin_amdgcn_mfma_f32_16x16x32_bf16(a, b, o[nt], 0, 0, 0); } } }
#pragma unroll
        for (int r = 0; r < 4; ++r) { const float inv = 1.0f / sum[r];
#pragma unroll
            for (int nt = 0; nt < 8; ++nt) *(LAS unsigned short*)(pb + (4 * fq + r) * 272 + (nt * 16 + fr) * 2) = (unsigned short)f2bf(o[nt][r] * inv);
 }
        { const int row = lane >> 2; const size_t t = (size_t)bl_ * SEQ + (size_t)(q0_ + 16 * wave + row) * dil_ + rr_; odst = og + (size_t)g_ * ((size_t)TALL * 512) + t * 512 + h_ * 128 + (lane & 3) * 8;
#pragma unroll
          for (int i = 0; i < 4; ++i) ost[i] = *(const LAS v4u*)(pb + row * 272 + (4 * i + (lane & 3)) * 16); }
        __syncthreads();
    }
    if (odst) {
#pragma unroll
        for (int i = 0; i < 4; ++i) *(v4u*)(odst + 32 * i) = ost[i]; }
#undef ATT_LOAD
#undef ATT_DECODE
}

__device__ __forceinline__ unsigned block_sum_u32(unsigned v, LAS unsigned* red, int tid) {
#pragma unroll
    for (int o = 1; o < 64; o <<= 1) v += __shfl_xor(v, o);
    if ((tid & 63) == 0) red[tid >> 6] = v;
    __syncthreads();
    unsigned t = 0;
#pragma unroll
    for (int w = 0; w < 8; ++w) t += red[w];
    __syncthreads();
    return t;
}
__device__ __forceinline__ void topk_unit(const float* aff  , int* idx  , float* gatev  , int* slot  ,
                                          LAS unsigned char* lds, int tid) {
    LAS unsigned* red = (LAS unsigned*)lds;
    LAS unsigned* wtot = (LAS unsigned*)(lds + 64);
    unsigned v[16];
    { const v4u* src = (const v4u*)(aff + tid * 16);
#pragma unroll
      for (int i = 0; i < 4; ++i) { const v4u w = src[i]; v[4 * i] = w.x; v[4 * i + 1] = w.y; v[4 * i + 2] = w.z; v[4 * i + 3] = w.w; } }
    unsigned prefix = 0u;
    for (int bit = 30; bit >= 0; --bit) {
        const unsigned cand = prefix | (1u << bit); unsigned cnt = 0;
#pragma unroll
        for (int k = 0; k < 16; ++k) cnt += (v[k] >= cand) ? 1u : 0u;
        const unsigned tot = block_sum_u32(cnt, red, tid);
        if (tot >= (unsigned)CAP) prefix = cand;
    }
    const unsigned T = prefix;
    unsigned cgt = 0, ceq = 0;
#pragma unroll
    for (int k = 0; k < 16; ++k) { cgt += (v[k] > T) ? 1u : 0u; ceq += (v[k] == T) ? 1u : 0u; }
    const unsigned packed = cgt | (ceq << 16);
    const unsigned total = block_sum_u32(packed, red, tid);
    const unsigned n_gt = total & 0xffffu, need_eq = (unsigned)CAP - n_gt;
    const int lane = tid & 63, wave = tid >> 6;
    unsigned inc = packed;
#pragma unroll
    for (int o = 1; o < 64; o <<= 1) { const unsigned t = __shfl_up(inc, o); if (lane >= o) inc += t; }
    if (lane == 63) wtot[wave] = inc;
    __syncthreads();
    unsigned wpre = 0;
#pragma unroll
    for (int w = 0; w < 8; ++w) if (w < wave) wpre += wtot[w];
    const unsigned excl = wpre + inc - packed;
    unsigned gt_before = excl & 0xffffu, eq_before = excl >> 16;
#pragma unroll
    for (int k = 0; k < 16; ++k) {
        const int t = tid * 16 + k;
        const bool isgt = v[k] > T, iseq = v[k] == T;
        const bool sel = isgt || (iseq && eq_before < need_eq);
        const unsigned c = gt_before + (eq_before < need_eq ? eq_before : need_eq);
        if (sel) { idx[c] = t; gatev[c] = __builtin_bit_cast(float, v[k]); }
        slot[(size_t)t * 16] = sel ? (int)c : -1;
        gt_before += isgt ? 1u : 0u; eq_before += iseq ? 1u : 0u;
    }
    __syncthreads();
}

#ifndef PH_MASK
#define PH_MASK 0xFFFFF
#endif
#define PH_ON(c) (((PH_MASK) >> (c)) & 1)
#ifndef REP_MASK
#define REP_MASK 0
#endif
#define PH_REP(c) for (int rep_ = 0; rep_ < 1 + (((REP_MASK) >> (c)) & 1); ++rep_)
#define PHASE_TID() int tid = threadIdx.x; asm volatile("" : "+v"(tid)); const int lane = tid & 63, wave = __builtin_amdgcn_readfirstlane(tid >> 6); const int gw = blockIdx.x * 8 + wave, NGW = G * 8; (void)lane; (void)gw; (void)NGW
constexpr int N_PHASES = 16;
__global__ void __launch_bounds__(512, 2) mega(Params p) {
    extern __shared__ __attribute__((aligned(16))) unsigned char lds_raw[];
    LAS unsigned char* lds = (LAS unsigned char*)lds_raw;
    const int G = gridDim.x;
    volatile LAS unsigned* MISC = (volatile LAS unsigned*)(lds + MISC_OFF);
    if (threadIdx.x < 32) MISC[threadIdx.x] = 0u;
    __syncthreads();
    const int lo = p.ph_lo, hi = p.ph_hi;
    XcdBarrier bar = xcd_barrier_post((unsigned*)(KWS() + WS_CTL) + CW_BAR + p.li * XCD_BAR_WORDS, MISC + 8);
#define IN(k) (lo <= (k) && (k) < hi)
#define SEAM(k) do { if (IN(k) && IN((k) + 1)) xcd_barrier(bar); } while (0)

    if (PH_ON(0) && IN(0)) PH_REP(0) { PHASE_TID(); phase_prep(lds, tid); }
    SEAM(0);

    if (PH_ON(1) && IN(1)) PH_REP(1) {
        unsigned char* ws = KWS();
        pg8::Gemm g{(const bf16*)(ws + WS_XN), (const bf16*)(ws + WS_WIN), TALL, 6656, DM}; pg8::StaticOrder S; S.init(TALL, 6656, G, (int)blockIdx.x);
        EpiInProj E{KIN(I_B_IN), (bf16*)(ws + WS_XR), (bf16*)(ws + WS_GGR), (bf16*)(ws + WS_QKV), (bf16*)(ws + WS_SGA), (bf16*)(ws + WS_SGB), (const float*)(ws + WS_COS), (const float*)(ws + WS_SIN), 0};
        pg8::gemm_phase<EpiInProj, pg8::StaticOrder, true, true>(lds, g, S, E);
    }
    SEAM(1);

    if (PH_ON(2) && IN(2)) PH_REP(2) { PHASE_TID();
        unsigned char* ws = KWS();
        volatile LAS unsigned* ctl = (volatile LAS unsigned*)(lds + RNN_CTL_OFF);
        if (tid < 16) ctl[tid * 16] = 0u;
        __syncthreads();
        {
            const int vcu = (G % 8 == 0) ? (int)(blockIdx.x % 8) * (G / 8) + (int)blockIdx.x / 8 : (int)blockIdx.x;
            const int ud = wave >> 1, pr = wave >> 2, dir = (wave >> 1) & 1, role = wave & 1;
            LAS unsigned char* ring = lds + ud * RNN_RING_BYTES; LAS unsigned char* queue = lds + RNN_Q_OFF + ud * RNN_Q_BYTES;
            volatile LAS unsigned* head = ctl + (ud * 2 + 0) * 16; volatile LAS unsigned* tail = ctl + (ud * 2 + 1) * 16;
            volatile LAS unsigned* myflag = ctl + (8 + pr * 2 + dir) * 16; volatile LAS unsigned* otherflag = ctl + (8 + pr * 2 + (dir ^ 1)) * 16;
            const int unit = vcu * 2 + pr;
            if (unit < 512) {
                if (role == 0) rnn_producer(ring, queue, head, tail, unit, dir, (const bf16*)(ws + WS_XR), (const v4u*)(ws + WS_RGWF), (const float*)(ws + WS_RGBIAS), lane);
                else rnn_consumer(ring, queue, head, tail, myflag, otherflag, 1u, unit, dir, (const bf16*)(ws + WS_GGR),
                                  (rep_ == 0 && ((REP_MASK >> 2) & 1)) ? (bf16*)KOUT() + (size_t)TALL * DM : (bf16*)(ws + WS_GGR), (unsigned long long*)KOUT(), (const v4u*)(ws + WS_RGWF), (const float*)(ws + WS_RGBIAS), lane);
            }
        }
        __syncthreads();
    }
    SEAM(2);

    if (PH_ON(3) && IN(3)) PH_REP(3) { PHASE_TID();
        unsigned char* ws = KWS();
        phase_attn((const bf16*)(ws + WS_QKV), (bf16*)KOUT(), (float*)(ws + WS_LSE), lds, tid, G);
    }
    SEAM(3);

    if (PH_ON(4) && IN(4)) PH_REP(4) { PHASE_TID();
        unsigned char* ws = KWS();
        const bf16* og = (const bf16*)KOUT(); const float* lse = (const float*)(ws + WS_LSE); bf16* yatt = (bf16*)KOUT() + (size_t)3 * TALL * 512;
        for (int t = gw; t < TALL; t += NGW) {
            const int h = lane >> 4, d0 = (lane & 15) * 8;
            const float l0 = lse[(size_t)t * 4 + h], l1 = lse[(size_t)TALL * 4 + (size_t)t * 4 + h], l2 = lse[(size_t)TALL * 8 + (size_t)t * 4 + h];
            const float m = fmaxf(l0, fmaxf(l1, l2)); const float e0 = __expf(l0 - m), e1 = __expf(l1 - m), e2 = __expf(l2 - m); const float inv = 1.0f / (e0 + e1 + e2);
            const float w0 = e0 * inv, w1 = e1 * inv, w2 = e2 * inv;
            const size_t o = (size_t)t * 512 + h * 128 + d0;
            const v4u a = *(const v4u*)(og + o), b = *(const v4u*)(og + (size_t)TALL * 512 + o), c = *(const v4u*)(og + (size_t)TALL * 1024 + o);
            v4u r;
            r.x = pk2(w0 * bflo(a.x) + w1 * bflo(b.x) + w2 * bflo(c.x), w0 * bfhi(a.x) + w1 * bfhi(b.x) + w2 * bfhi(c.x));
            r.y = pk2(w0 * bflo(a.y) + w1 * bflo(b.y) + w2 * bflo(c.y), w0 * bfhi(a.y) + w1 * bfhi(b.y) + w2 * bfhi(c.y));
            r.z = pk2(w0 * bflo(a.z) + w1 * bflo(b.z) + w2 * bflo(c.z), w0 * bfhi(a.z) + w1 * bfhi(b.z) + w2 * bfhi(c.z));
            r.w = pk2(w0 * bflo(a.w) + w1 * bflo(b.w) + w2 * bflo(c.w), w0 * bfhi(a.w) + w1 * bfhi(b.w) + w2 * bfhi(c.w));
            *(v4u*)(yatt + o) = r;
        }
    }
    SEAM(4);

    if (PH_ON(5) && IN(5)) PH_REP(5) {
        unsigned char* ws = KWS();
        pg8::Gemm g{(const bf16*)(ws + WS_XN), (const bf16*)(ws + WS_WIN) + (size_t)6656 * DM, TALL, 2048, DM}; pg8::StaticOrder S; S.init(TALL, 2048, G, (int)blockIdx.x);
        EpiInProj E{KIN(I_B_IN), (bf16*)(ws + WS_XR), (bf16*)(ws + WS_GGR), (bf16*)(ws + WS_QKV), (bf16*)(ws + WS_SGA), (bf16*)(ws + WS_SGB), (const float*)(ws + WS_COS), (const float*)(ws + WS_SIN), 26};
        pg8::gemm_phase<EpiInProj, pg8::StaticOrder, true, true>(lds, g, S, E);
    }
    SEAM(5);

    if (PH_ON(6) && IN(6)) PH_REP(6) {
        unsigned char* ws = KWS();
        pg8::Gemm g{(const bf16*)(ws + WS_GGR), (const bf16*)(ws + WS_PRNN), TALL, DM, DM}; pg8::StaticOrder S; S.init(TALL, DM, G, (int)blockIdx.x);
        EpiGate E{(const bf16*)(ws + WS_SGA), nullptr, (bf16*)(ws + WS_MERGED)};
        pg8::gemm_phase<EpiGate, pg8::StaticOrder, true, true>(lds, g, S, E);
    }
    SEAM(6);
    if (PH_ON(7) && IN(7)) {
        unsigned char* ws = KWS();
        pg8::Gemm g{(const bf16*)KOUT() + (size_t)3 * TALL * 512, (const bf16*)(ws + WS_PATT), TALL, DM, 512}; pg8::StaticOrder S; S.init(TALL, DM, G, (int)blockIdx.x);
        EpiGate E{(const bf16*)(ws + WS_SGB), (const bf16*)(ws + WS_MERGED), (bf16*)(ws + WS_MERGED)};
        pg8::gemm_phase<EpiGate, pg8::StaticOrder, true, true>(lds, g, S, E);
    }
    SEAM(7);
    if (PH_ON(8) && IN(8)) PH_REP(8) {
        unsigned char* ws = KWS();
        pg8::Gemm g{(const bf16*)(ws + WS_MERGED), (const bf16*)(ws + WS_WOUT), TALL, DM, DM}; pg8::StaticOrder S; S.init(TALL, DM, G, (int)blockIdx.x);
        EpiResid E{KIN(I_X), KOUT()};
        pg8::gemm_phase<EpiResid, pg8::StaticOrder, true, true>(lds, g, S, E);
    }
    SEAM(8);

    if (PH_ON(9) && IN(9)) PH_REP(9) { PHASE_TID();
        unsigned char* ws = KWS();
        LAS float* scr = (LAS float*)(lds + wave * 16384);
        constexpr int I_E = 16 * 1024;
        { const float* wg = KIN(I_W_GATE); const float* wu = KIN(I_W_UP); const float* wd = KIN(I_W_DOWN);
        for (int it = gw; it < 3 * I_E; it += NGW) {
            int r = it;
            if (r < 2 * I_E) { const int up = r >= I_E; r -= up * I_E; const int e = r >> 10, rr2 = r & 1023, kb = rr2 >> 6, nb = rr2 & 63, n0 = nb * 32;
                tr_item((up ? wu : wg) + (size_t)e * DM * DFF, DFF, kb * 64, n0, (bf16*)(ws + WS_WGU), (size_t)e * 4096 + (n0 >> 7) * 256 + (n0 & 127) + up * 128, 1024, scr, lane); continue; }
            r -= 2 * I_E;
            { const int e = r >> 10, rr2 = r & 1023, kb = rr2 >> 5, nb = rr2 & 31, n0 = nb * 32;
              tr_item(wd + (size_t)e * DFF * DM, DM, kb * 64, n0, (bf16*)(ws + WS_WD), (size_t)e * 1024 + n0, 2048, scr, lane); }
        } }
        __syncthreads();
        LAS float* wrT = (LAS float*)lds;
        { const float* wrt = KIN(I_W_ROUTER);
          for (int i = tid; i < DM * NEXP; i += 512) { const int d = i >> 4, e = i & 15; wrT[e * 1024 + d] = wrt[i]; } }
        __syncthreads();
        const float* x2 = KOUT(); const float* nffn = KIN(I_NORM_FFN); const float* brt = KIN(I_B_ROUTER);
        for (int m = gw; m < TALL; m += NGW) {
            f32x4 o[4]; rms_row(x2 + (size_t)m * DM, nffn, lane, o); store_row_bf16((bf16*)(ws + WS_H2) + (size_t)m * DM, lane, o);
            float mine = -3.0e38f;
#pragma unroll 2
            for (int e = 0; e < 16; ++e) { float s = 0.f;
#pragma unroll
                for (int j = 0; j < 4; ++j) { const f32x4 w = *(const LAS f32x4*)(wrT + e * 1024 + j * 256 + 4 * lane); s += (o[j].x * w.x + o[j].y * w.y) + (o[j].z * w.z + o[j].w * w.w); }
                const float tot = wave_sum(s) + brt[e]; mine = (lane == e) ? tot : mine; }
            float mx = mine;
#pragma unroll
            for (int of = 1; of < 16; of <<= 1) mx = fmaxf(mx, __shfl_xor(mx, of));
            const float ex = expf(mine - mx); float den = ex;
#pragma unroll
            for (int of = 1; of < 16; of <<= 1) den += __shfl_xor(den, of);
            const int b = m >> 13, s = m & (SEQ - 1);
            if (lane < 16) ((float*)(ws + WS_AFF))[((size_t)(b * 16 + lane)) * SEQ + s] = ex / den;
        }
        __syncthreads();
    }
    SEAM(9);

    if (PH_ON(10) && IN(10)) PH_REP(10) { PHASE_TID();
        unsigned char* ws = KWS();
        for (int unit = blockIdx.x; unit < BATCH * NEXP; unit += G) { const int b = unit >> 4, e = unit & 15;
            topk_unit((const float*)(ws + WS_AFF) + (size_t)unit * SEQ, (int*)(ws + WS_IDX) + unit * CAP, (float*)(ws + WS_GATEV) + unit * CAP, (int*)(ws + WS_SLOT) + (size_t)b * SEQ * 16 + e, lds, tid); }
    }
    SEAM(10);

    for (int half = 0; half < 2; ++half) {
        const int pb0 = 11 + 2 * half;
        if (PH_ON(12) && IN(pb0 + 0)) PH_REP(12) {
            unsigned char* ws = KWS();
            pg8::Gemm g{(const bf16*)(ws + WS_H2), (const bf16*)(ws + WS_WGU), 65536, 65536, DM, (const int*)(ws + WS_IDX) + half * 65536, half * 4 * SEQ}; MoeOrder S{G, (int)blockIdx.x, 16, 4096};
            EpiSwiglu E{(bf16*)(ws + WS_HID)};
            pg8::gemm_phase<EpiSwiglu, MoeOrder, true, true, true>(lds, g, S, E);
        }
        SEAM(pb0 + 0);
        if (PH_ON(13) && IN(pb0 + 1)) PH_REP(13) {
            unsigned char* ws = KWS();
            pg8::Gemm g{(const bf16*)(ws + WS_HID), (const bf16*)(ws + WS_WD), 65536, 16384, DFF}; MoeOrder S{G, (int)blockIdx.x, 4, 1024};
            EpiDown E{(bf16*)(ws + WS_EO) + (size_t)half * 65536 * DM, (const float*)(ws + WS_GATEV) + half * 65536};
            pg8::gemm_phase<EpiDown, MoeOrder, true, true>(lds, g, S, E);
        }
        SEAM(pb0 + 1);
    }

    if (PH_ON(14) && IN(15)) { PHASE_TID();
        unsigned char* ws = KWS();
        const bf16* eo = (const bf16*)(ws + WS_EO); float* outp = KOUT(); const float* nfin = KIN(I_NORM_FINAL);
        for (int m = gw; m < TALL; m += NGW) {
            const int b = m >> 13;
            float* xrow = outp + (size_t)m * DM;
            f32x4 v[4];
#pragma unroll
            for (int j = 0; j < 4; ++j) v[j] = ((const f32x4*)xrow)[64 * j + lane];
            const int* sl = (const int*)(ws + WS_SLOT) + (size_t)m * 16;
            for (int e = 0; e < 16; ++e) { const int c = sl[e];
                if (c >= 0) { const unsigned long long* er = (const unsigned long long*)(eo + ((size_t)(b * 16 + e) * CAP + c) * DM) + lane;
#pragma unroll
                    for (int j = 0; j < 4; ++j) { const unsigned long long w = er[64 * j]; const unsigned w0 = (unsigned)w, w1 = (unsigned)(w >> 32);
                        v[j].x += bflo(w0); v[j].y += bfhi(w0); v[j].z += bflo(w1); v[j].w += bfhi(w1); } } }
            float s = 0.f;
#pragma unroll
            for (int j = 0; j < 4; ++j) s += (v[j].x * v[j].x + v[j].y * v[j].y) + (v[j].z * v[j].z + v[j].w * v[j].w);
            const float rstd = 1.0f / sqrtf(wave_sum(s) * (1.0f / DM) + RMS_EPS);
#pragma unroll
            for (int j = 0; j < 4; ++j) { const f32x4 g = ((const f32x4*)nfin)[64 * j + lane]; ((f32x4*)xrow)[64 * j + lane] = v[j] * rstd * g; }
        }
    }
#undef IN
#undef SEAM
}

#ifndef MK_SPLIT
#define MK_SPLIT 0
#endif
extern "C" void kernel_launch(void* const* d_in, const int* in_sizes, int n_in, void* d_out, int out_size, void* d_ws, size_t ws_size, hipStream_t stream) {
    static int grid = 0;
    if (grid == 0) {
        if (n_in != 19 || out_size != TALL * DM || ws_size < WS_END) { fprintf(stderr, "kernel_launch: unexpected shapes (n_in %d out %d ws %zu)\n", n_in, out_size, ws_size); grid = -1; return; }
        int dev = 0, cus = 0, per_cu = 0;
        if (hipGetDevice(&dev) != hipSuccess || hipDeviceGetAttribute(&cus, hipDeviceAttributeMultiprocessorCount, dev) != hipSuccess) { grid = -1; return; }
        if (hipFuncSetAttribute((const void*)mega, hipFuncAttributeMaxDynamicSharedMemorySize, LDS_BYTES) != hipSuccess) { fprintf(stderr, "kernel_launch: hipFuncSetAttribute failed\n"); grid = -1; return; }
        if (hipOccupancyMaxActiveBlocksPerMultiprocessor(&per_cu, (const void*)mega, 512, LDS_BYTES) != hipSuccess || per_cu < 1) { fprintf(stderr, "kernel_launch: occupancy query says %d\n", per_cu); }
        (void)hipGetLastError();
        grid = cus;
    }
    if (grid < 0) return;
    (void)hipMemsetAsync((char*)d_ws + WS_CTL, 0, CTL_ZERO_BYTES, stream);
    Params p{};
    for (int i = 0; i < 19; ++i) p.in[i] = (const float*)d_in[i];
    p.out = (float*)d_out; p.ws = (unsigned char*)d_ws;
#if MK_SPLIT
    for (int k = 0; k < N_PHASES; ++k) { p.ph_lo = k; p.ph_hi = k + 1; p.li = 0; hipLaunchKernelGGL(mega, dim3(grid), dim3(512), LDS_BYTES, stream, p); }
#else
    p.ph_lo = 0; p.ph_hi = N_PHASES; p.li = 0;
    hipLaunchKernelGGL(mega, dim3(grid), dim3(512), LDS_BYTES, stream, p);
#endif
}
```

```cpp
#include <hip/hip_runtime.h>
#include <cstdio>
#include <cstdint>

#define GAS __attribute__((address_space(1)))
#define LAS __attribute__((address_space(3)))

namespace pg8 {
#define PG8_LAS __attribute__((address_space(3)))
typedef unsigned short bf16_t;
typedef short bf16x8 __attribute__((ext_vector_type(8)));
typedef float f32x4 __attribute__((ext_vector_type(4)));
typedef unsigned u32x4 __attribute__((ext_vector_type(4)));
constexpr int BM = 256, BK = 64, HALF = 128, HTB = HALF * BK * 2  , STAGE_BYTES = 8 * HTB, NXCD = 8, WGM = 8;

__host__ __device__ __forceinline__ int lds_byte(int r, int c) { const int st = (r >> 4) * 2 + (c >> 5), rr = r & 15, cc = c & 31, ob = rr * 64 + cc * 2; return st * 1024 + (ob ^ (((ob >> 9) & 1) << 5)); }
__host__ __device__ __forceinline__ void stage_rc(int b, int& R, int& C) { const int st = b / 1024, sb = b % 1024, swz = sb ^ (((sb >> 9) & 1) << 5); R = (st >> 1) * 16 + swz / 64; C = (st & 1) * 32 + (swz % 64) / 2; }
__host__ __device__ __forceinline__ int perm32(int rho) { const int n = rho >> 4, i = rho & 15; return 8 * (i >> 2) + 4 * n + (i & 3); }

struct Unit { int pm, pn; };
struct Gemm { const bf16_t* A; const bf16_t* Bt; int M, N, K; const int* gidx; int grow0; };

struct StaticOrder {
    int nM, nN, nwg, G, c;
    __host__ __device__ void init(int M, int N, int G_, int c_) { nM = M / BM; nN = N / BM; nwg = nM * nN; G = G_; c = c_; }
    __host__ __device__ bool next(int i, Unit& u) const {
        const long L = (long)i * G + c; if (L >= nwg) return false;
        int wgid = (int)L; { const int q = nwg / NXCD, r = nwg % NXCD, xcd = wgid % NXCD, off = wgid / NXCD; wgid = (xcd < r ? xcd * (q + 1) : r * (q + 1) + (xcd - r) * q) + off; }
        const int nig = WGM * nN, gid = wgid / nig, fm = gid * WGM, gsz = (nM - fm) < WGM ? (nM - fm) : WGM;
        u.pm = fm + ((wgid % nig) % gsz); u.pn = (wgid % nig) / gsz; return true;
    }
    __device__ __forceinline__ void a_ready(const Unit&) const {}
    __device__ __forceinline__ void done(const Unit&) const {}
};

__device__ __forceinline__ unsigned cvt_pk_bf16(float lo, float hi) { unsigned r; asm volatile("v_cvt_pk_bf16_f32 %0, %1, %2" : "=v"(r) : "v"(lo), "v"(hi)); return r; }
typedef float f32x2 __attribute__((ext_vector_type(2)));
template <class Epi, class Sched, bool ALIGN_EPI = false, bool SP2 = false, bool GATHER = false>
__device__ __forceinline__ void gemm_phase(PG8_LAS unsigned char* lds, const Gemm g, const Sched& S, const Epi& E) {
    int tid_ = threadIdx.x; asm volatile("" : "+v"(tid_));
    const int tid = tid_, wid = __builtin_amdgcn_readfirstlane(tid >> 6), lane = tid & 63, wr = wid >> 2, wc = wid & 3, fr = lane & 15, fq = lane >> 4;
    const int K = g.K, nt = K / BK;
    unsigned voffA[2], voffB[2];
#pragma unroll
    for (int i = 0; i < 2; ++i) { int R, C; stage_rc(tid * 16 + i * 8192, R, C); const int Rb = Epi::PERM ? ((R & ~31) + perm32(R & 31)) : R;
        voffA[i] = (unsigned)(R * K + C) * 2u; voffB[i] = (unsigned)(Rb * K + C) * 2u; }
    static_assert(!GATHER || SP2, "GATHER is written for the SP2 loop");
    const size_t kstep = (size_t)(BK * 2);
    const size_t hstep = (size_t)HALF * K * 2;
    const size_t tstep = 2 * hstep;
    unsigned cvA[2][2], nvA[2][2];
    int gR[2], gC[2];
#pragma unroll
    for (int i = 0; i < 2; ++i) { stage_rc(tid * 16 + i * 8192, gR[i], gC[i]); }
#define PG8_GATHER_OFFS(dst, unit) do { _Pragma("unroll") for (int h_ = 0; h_ < 2; ++h_) _Pragma("unroll") for (int i_ = 0; i_ < 2; ++i_) { \
        const int src_ = g.grow0 + ((unit).pm >> 6) * 8192 + g.gidx[(unit).pm * 256 + h_ * 128 + gR[i_]]; dst[h_][i_] = ((unsigned)src_ * (unsigned)K + (unsigned)gC[i_]) * 2u; } } while (0)
    const unsigned ldsw = (unsigned)wid * 1024u;
    const int aoff = lds_byte(wr * 64 + fr, fq * 8), boff = lds_byte(wc * 32 + fr, fq * 8);
#define PG8_SA(b, h) (((b) * 2 + (h)) * HTB)
#define PG8_SB(b, h) ((4 + (b) * 2 + (h)) * HTB)
#define PG8_STAGE(bufoff, gbase, voff) do { _Pragma("unroll") for (int _i = 0; _i < 2; ++_i) \
        __builtin_amdgcn_global_load_lds((const unsigned*)((const char*)(gbase) + (voff)[_i]), (PG8_LAS unsigned*)(lds + (bufoff) + ldsw + _i * 8192), 16, 0, 0); } while (0)
#define PG8_LDA(dst, b, h) do { _Pragma("unroll") for (int m = 0; m < 4; ++m) _Pragma("unroll") for (int k = 0; k < 2; ++k) dst[m][k] = *(const PG8_LAS bf16x8*)(lds + PG8_SA(b, h) + aoff + m * 2048 + k * 1024); } while (0)
#define PG8_LDB(dst, b, h) do { _Pragma("unroll") for (int n = 0; n < 2; ++n) _Pragma("unroll") for (int k = 0; k < 2; ++k) dst[n][k] = *(const PG8_LAS bf16x8*)(lds + PG8_SB(b, h) + boff + n * 2048 + k * 1024); } while (0)
#define PG8_MMA(ai, bj, At, Bt) do { __builtin_amdgcn_s_setprio(1); _Pragma("unroll") for (int m = 0; m < 4; ++m) _Pragma("unroll") for (int n = 0; n < 2; ++n) _Pragma("unroll") for (int k = 0; k < 2; ++k) \
        acc[ai][bj][m][n] = __builtin_amdgcn_mfma_f32_16x16x32_bf16(Bt[n][k], At[m][k], acc[ai][bj][m][n], 0, 0, 0); __builtin_amdgcn_s_setprio(0); } while (0)
#define PG8_WAIT_V(n) asm volatile("s_waitcnt vmcnt(" #n ")" ::: "memory")
#define PG8_WAIT_L(n) asm volatile("s_waitcnt lgkmcnt(" #n ")" ::: "memory")
#define PG8_BAR __builtin_amdgcn_s_barrier()
#define PG8_SCHED __builtin_amdgcn_sched_barrier(0)
    Unit cur, nxt; int ui = 0;
    if (!S.next(0, cur)) return;
    f32x4 acc[2][2][4][2];
#pragma unroll
    for (int a = 0; a < 2; ++a)
#pragma unroll
        for (int b = 0; b < 2; ++b)
#pragma unroll
            for (int m = 0; m < 4; ++m)
#pragma unroll
                for (int n = 0; n < 2; ++n) acc[a][b][m][n] = (f32x4){0.f, 0.f, 0.f, 0.f};
    bf16x8 At[4][2], B0[2][2], B1[2][2];
    const char* cA = GATHER ? (const char*)g.A : (const char*)g.A + (size_t)cur.pm * tstep; const char* cB = (const char*)g.Bt + (size_t)cur.pn * tstep;
    if constexpr (GATHER) { PG8_GATHER_OFFS(cvA, cur); } else {
#pragma unroll
        for (int i = 0; i < 2; ++i) { cvA[0][i] = voffA[i]; cvA[1][i] = voffA[i] + (unsigned)hstep; } }
#pragma unroll
    for (int h = 0; h < 2; ++h)
#pragma unroll
        for (int i = 0; i < 2; ++i) nvA[h][i] = cvA[h][i];
    S.a_ready(cur);
    if constexpr (SP2) {
        PG8_STAGE(PG8_SB(0, 0), cB, voffB); PG8_STAGE(PG8_SB(0, 1), cB + hstep, voffB); PG8_STAGE(PG8_SA(0, 0), cA, cvA[0]); PG8_STAGE(PG8_SA(0, 1), cA, cvA[1]);
        if (wr == 1) PG8_BAR;
        PG8_WAIT_V(2); PG8_BAR;
        PG8_STAGE(PG8_SB(1, 0), cB + kstep, voffB); PG8_STAGE(PG8_SA(1, 0), cA + kstep, cvA[0]); PG8_STAGE(PG8_SB(1, 1), cB + hstep + kstep, voffB);
        PG8_WAIT_V(6); PG8_BAR;
    } else {
        PG8_STAGE(PG8_SB(0, 0), cB, voffB); PG8_STAGE(PG8_SA(0, 0), cA, voffA); PG8_STAGE(PG8_SB(0, 1), cB + hstep, voffB); PG8_STAGE(PG8_SA(0, 1), cA + hstep, voffA);
        if (wr == 1) PG8_BAR;
        PG8_WAIT_V(4); PG8_BAR;
        PG8_STAGE(PG8_SB(1, 0), cB + kstep, voffB); PG8_STAGE(PG8_SA(1, 0), cA + kstep, voffA); PG8_STAGE(PG8_SB(1, 1), cB + hstep + kstep, voffB);
        PG8_WAIT_V(6); PG8_BAR;
    }
    for (;;) {
        const bool has_next = S.next(ui + 1, nxt);
        const char* nA = GATHER ? cA : (has_next ? (const char*)g.A + (size_t)nxt.pm * tstep : cA); const char* nB = has_next ? (const char*)g.Bt + (size_t)nxt.pn * tstep : cB;
        if constexpr (GATHER) { if (has_next) PG8_GATHER_OFFS(nvA, nxt); }
        for (int t = 0; t < nt; t += 2) {
            const bool last = (t == nt - 2);
            const char* a1 = cA + (size_t)(t + 1) * kstep;
            const char* a2 = last ? nA : cA + (size_t)(t + 2) * kstep; const char* b2 = last ? nB : cB + (size_t)(t + 2) * kstep;
            const char* a3 = a2 + kstep; const char* b3 = b2 + kstep;
            if (last && has_next) S.a_ready(nxt);
            if constexpr (SP2) {
            PG8_LDB(B0, 0, 0); PG8_LDB(B1, 0, 1); PG8_SCHED; PG8_LDA(At, 0, 0); PG8_STAGE(PG8_SA(1, 1), a1, cvA[1]);
            PG8_WAIT_V(8); PG8_WAIT_L(0); PG8_BAR; PG8_MMA(0, 0, At, B0); PG8_MMA(0, 1, At, B1); PG8_BAR; PG8_SCHED;
            PG8_LDA(At, 0, 1); PG8_STAGE(PG8_SB(0, 0), b2, voffB); PG8_STAGE(PG8_SB(0, 1), b2 + hstep, voffB); PG8_STAGE(PG8_SA(0, 0), a2, (last ? nvA[0] : cvA[0]));
            PG8_WAIT_V(8); PG8_WAIT_L(0); PG8_BAR; PG8_MMA(1, 0, At, B0); PG8_MMA(1, 1, At, B1); PG8_BAR; PG8_SCHED;
            PG8_LDB(B0, 1, 0); PG8_LDB(B1, 1, 1); PG8_SCHED; PG8_LDA(At, 1, 0); PG8_STAGE(PG8_SA(0, 1), a2, (last ? nvA[1] : cvA[1]));
            PG8_WAIT_V(8); PG8_WAIT_L(0); PG8_BAR; PG8_MMA(0, 0, At, B0); PG8_MMA(0, 1, At, B1); PG8_BAR; PG8_SCHED;
            PG8_LDA(At, 1, 1); PG8_STAGE(PG8_SB(1, 0), b3, voffB); PG8_STAGE(PG8_SB(1, 1), b3 + hstep, voffB); PG8_STAGE(PG8_SA(1, 0), a3, (last ? nvA[0] : cvA[0]));
            PG8_WAIT_V(8); PG8_WAIT_L(0); PG8_BAR; PG8_MMA(1, 0, At, B0); PG8_MMA(1, 1, At, B1); PG8_BAR; PG8_SCHED;
            } else {
            PG8_LDB(B0, 0, 0); PG8_SCHED; PG8_LDA(At, 0, 0); PG8_STAGE(PG8_SA(1, 1), a1 + hstep, voffA);
            PG8_WAIT_L(8); PG8_BAR; PG8_WAIT_L(0); PG8_MMA(0, 0, At, B0); PG8_BAR; PG8_SCHED;
            PG8_LDB(B1, 0, 1); PG8_STAGE(PG8_SB(0, 0), b2, voffB);
            PG8_BAR; PG8_WAIT_L(0); PG8_MMA(0, 1, At, B1); PG8_BAR;
            PG8_LDA(At, 0, 1); PG8_STAGE(PG8_SA(0, 0), a2, voffA);
            PG8_BAR; PG8_WAIT_L(0); PG8_MMA(1, 0, At, B0); PG8_BAR; PG8_SCHED;
            PG8_STAGE(PG8_SB(0, 1), b2 + hstep, voffB);
            PG8_WAIT_V(6); PG8_BAR; PG8_MMA(1, 1, At, B1); PG8_BAR;
            PG8_LDB(B0, 1, 0); PG8_SCHED; PG8_LDA(At, 1, 0); PG8_STAGE(PG8_SA(0, 1), a2 + hstep, voffA);
            PG8_WAIT_L(8); PG8_BAR; PG8_WAIT_L(0); PG8_MMA(0, 0, At, B0); PG8_BAR; PG8_SCHED;
            PG8_LDB(B1, 1, 1); PG8_STAGE(PG8_SB(1, 0), b3, voffB);
            PG8_BAR; PG8_WAIT_L(0); PG8_MMA(0, 1, At, B1); PG8_BAR;
            PG8_LDA(At, 1, 1); PG8_STAGE(PG8_SA(1, 0), a3, voffA);
            PG8_BAR; PG8_WAIT_L(0); PG8_MMA(1, 0, At, B0); PG8_BAR; PG8_SCHED;
            PG8_STAGE(PG8_SB(1, 1), b3 + hstep, voffB);
            PG8_WAIT_V(6); PG8_BAR; PG8_MMA(1, 1, At, B1); PG8_BAR;
            }
        }
        if constexpr (ALIGN_EPI) { if (wr == 0) PG8_BAR; }
        if constexpr (!Epi::AFTER_DRAIN) { E(acc, cur, wr, wc, fr, fq); S.done(cur); }
        if (!has_next) break;
#pragma unroll
        for (int a = 0; a < 2; ++a)
#pragma unroll
            for (int b = 0; b < 2; ++b)
#pragma unroll
                for (int m = 0; m < 4; ++m)
#pragma unroll
                    for (int n = 0; n < 2; ++n) acc[a][b][m][n] = (f32x4){0.f, 0.f, 0.f, 0.f};
        cur = nxt; cA = nA; cB = nB; ++ui;
#pragma unroll
        for (int h = 0; h < 2; ++h)
#pragma unroll
            for (int i = 0; i < 2; ++i) cvA[h][i] = nvA[h][i];
        if constexpr (ALIGN_EPI) { if (wr == 1) PG8_BAR; }
    }
    PG8_WAIT_V(0);
    if constexpr (!ALIGN_EPI) { if (wr == 0) PG8_BAR; }
    PG8_BAR;
    if constexpr (Epi::AFTER_DRAIN) { E.fused(acc, cur, wr, wc, fr, fq, lds, wid, lane); S.done(cur); }
#undef PG8_SA
#undef PG8_SB
#undef PG8_STAGE
#undef PG8_LDA
#undef PG8_LDB
#undef PG8_MMA
#undef PG8_WAIT_V
#undef PG8_WAIT_L
#undef PG8_BAR
#undef PG8_SCHED
#undef PG8_GATHER_OFFS
}
}

constexpr int DM = 1024, BATCH = 8, SEQ = 8192, TALL = BATCH * SEQ;
constexpr int HBATCH = 4, TH = HBATCH * SEQ;
constexpr int D_IN = 8704, NEXP = 16, CAP = 1024, DFF = 2048;
constexpr float RMS_EPS = 1e-6f;

typedef unsigned short bf16;
typedef unsigned v4u __attribute__((ext_vector_type(4)));
typedef unsigned v2u __attribute__((ext_vector_type(2)));
typedef float f32x4 __attribute__((ext_vector_type(4)));
typedef short bf16x8 __attribute__((ext_vector_type(8)));

constexpr size_t MiB = 1u << 20;
constexpr size_t WS_CTL = 0, CTL_ZERO_BYTES = 64 * 1024;
constexpr size_t WS_COS = 1 * MiB, WS_SIN = WS_COS + 512 * 1024;
constexpr size_t WS_WIN = 2 * MiB, WS_PRNN = 19 * MiB, WS_PATT = 21 * MiB, WS_WOUT = 22 * MiB;
constexpr size_t WS_AFF = 24 * MiB, WS_IDX = 28 * MiB, WS_GATEV = WS_IDX + 512 * 1024, WS_LSE = 29 * MiB, WS_SLOT = 32 * MiB;
constexpr size_t WS_RGWF = 36 * MiB, WS_RGBIAS = 40 * MiB;
constexpr size_t WS_XN = 44 * MiB;
constexpr size_t WS_XR = 172 * MiB, WS_GGR = 300 * MiB, WS_QKV = 428 * MiB;
constexpr size_t WS_MERGED = WS_XR;
constexpr size_t WS_SGA = WS_QKV, WS_SGB = WS_QKV + 128 * MiB;
constexpr size_t WS_H2 = WS_XN, WS_XG = 172 * MiB, WS_HID = 300 * MiB, WS_EO = 556 * MiB, WS_WGU = 812 * MiB, WS_WD = 940 * MiB, WS_END = 1004 * MiB;
constexpr int CW_BAR = 1024;

constexpr int LDS_BYTES = 163840, MISC_OFF = LDS_BYTES - 256;

__device__ __forceinline__ unsigned f2bf(float f) { unsigned u = __builtin_bit_cast(unsigned, f); return (u + 0x7fffu + ((u >> 16) & 1u)) >> 16; }
__device__ __forceinline__ unsigned pk2(float lo, float hi) { unsigned r; asm volatile("v_cvt_pk_bf16_f32 %0, %1, %2" : "=v"(r) : "v"(lo), "v"(hi)); return r; }
__device__ __forceinline__ float bflo(unsigned w) { return __builtin_bit_cast(float, w << 16); }
__device__ __forceinline__ float bfhi(unsigned w) { return __builtin_bit_cast(float, w & 0xffff0000u); }
__device__ __forceinline__ float bf2f(unsigned short b) { return __builtin_bit_cast(float, (unsigned)b << 16); }
__device__ __forceinline__ float wave_sum(float v) {
#pragma unroll
    for (int o = 1; o < 64; o <<= 1) v += __shfl_xor(v, o);
    return v;
}
__device__ __forceinline__ float sigmoidf_(float v) { return __builtin_amdgcn_rcpf(1.0f + __builtin_amdgcn_exp2f(-1.4426950408889634f * v)); }
__device__ __forceinline__ float gelu_tanh(float v) { const float u = 0.7978845608028654f * (v + 0.044715f * v * v * v); return v * __builtin_amdgcn_rcpf(1.0f + __builtin_amdgcn_exp2f(-2.8853900817779268f * u)); }
#define LDS_WAIT() asm volatile("s_waitcnt lgkmcnt(0)" ::: "memory")

#define XB_TMO      128
#define XB_XCNT(j)  (256  + 64 * (j))
#define XB_XSUB(j)  (1280 + 64 * (j))
#define XB_XGEN(j)  (2304 + 64 * (j))
#define XB_TOP      3328
#define XB_TOPGEN   3392
#define XCD_BAR_WORDS 3456
#define XB_SPIN_CAP (1u << 22)

__device__ __forceinline__ unsigned xb_ld(unsigned* p)              { return __hip_atomic_load(p, __ATOMIC_RELAXED, __HIP_MEMORY_SCOPE_AGENT); }
__device__ __forceinline__ unsigned xb_add(unsigned* p, unsigned v) { return __hip_atomic_fetch_add(p, v, __ATOMIC_RELAXED, __HIP_MEMORY_SCOPE_AGENT); }
__device__ __forceinline__ unsigned xb_xcc_id() { return (unsigned)__builtin_amdgcn_s_getreg((3 << 11) | 20) & 0xFu; }
#define XB_SPIN(cond, bar) do { unsigned _sp = 0; while (cond) { __builtin_amdgcn_s_sleep(1); \
    if ((++_sp & 255u) == 0u) { if (xb_ld(&(bar)[XB_TMO])) break; if (_sp > XB_SPIN_CAP) { atomicAdd(&(bar)[XB_TMO], 1u); break; } } } } while (0)

struct XcdBarrier { unsigned* bar; unsigned x; volatile LAS unsigned* st; };

__device__ __forceinline__ XcdBarrier xcd_barrier_post(unsigned* bar, volatile LAS unsigned* st) {
    XcdBarrier b; b.bar = bar; b.x = xb_xcc_id(); b.st = st;
    if (threadIdx.x == 0) (void)xb_add(&bar[XB_XCNT(b.x)], 1u);
    return b;
}
__device__ __forceinline__ void xcd_barrier_complete(unsigned* bar, unsigned x, unsigned& nloc, unsigned& nx) {
    const unsigned G = gridDim.x * gridDim.y * gridDim.z;
    unsigned sum, cnt, mine, sp = 0u;
    for (;;) {
        sum = 0u; cnt = 0u; mine = 0u;
#pragma unroll
        for (unsigned j = 0; j < 16; ++j) { const unsigned c = xb_ld(&bar[XB_XCNT(j)]); sum += c; cnt += (c > 0u) ? 1u : 0u; mine = (j == x) ? c : mine; }
        if (sum == G) break;
        __builtin_amdgcn_s_sleep(1);
        if ((++sp & 255u) == 0u) { if (xb_ld(&bar[XB_TMO])) break; if (sp > XB_SPIN_CAP) { atomicAdd(&bar[XB_TMO], 1u); break; } }
    }
    nloc = mine > 0u ? mine : 1u; nx = cnt > 0u ? cnt : 1u;
}
__device__ __forceinline__ void xcd_barrier(const XcdBarrier& b) {
    asm volatile("s_waitcnt vmcnt(0)" ::: "memory");
    __syncthreads();
    if (threadIdx.x == 0) {
        unsigned* bar = b.bar;
        __builtin_amdgcn_s_waitcnt(0);
        unsigned nloc = b.st[0], nx = b.st[1];
        if (nloc == 0u) { xcd_barrier_complete(bar, b.x, nloc, nx); b.st[0] = nloc; b.st[1] = nx; }
        const unsigned old = xb_add(&bar[XB_XSUB(b.x)], 1u);
        const unsigned gen = old / nloc;
        if (old + 1u == (gen + 1u) * nloc) {
            __builtin_amdgcn_fence(__ATOMIC_RELEASE, "agent");
            asm volatile("s_waitcnt vmcnt(0)" ::: "memory");
            const unsigned og = xb_add(&bar[XB_TOP], 1u);
            const unsigned tg = og / nx;
            if (og + 1u == (tg + 1u) * nx) xb_add(&bar[XB_TOPGEN], 1u);
            else XB_SPIN(xb_ld(&bar[XB_TOPGEN]) == tg, bar);
            __builtin_amdgcn_fence(__ATOMIC_ACQUIRE, "agent");
            xb_add(&bar[XB_XGEN(b.x)], 1u);
            asm volatile("s_waitcnt vmcnt(0)" ::: "memory");
        } else {
            XB_SPIN(xb_ld(&bar[XB_XGEN(b.x)]) == gen, bar);
            __builtin_amdgcn_fence(__ATOMIC_ACQUIRE, "agent");
            asm volatile("s_waitcnt vmcnt(0)" ::: "memory");
        }
    }
    __syncthreads();
}

struct Params {
    const float* in[19];
    float* out;
    unsigned char* ws;
    int ph_lo, ph_hi;
    int li, pad;
};
enum { I_X = 0, I_NORM_MIX, I_W_IN, I_B_IN, I_CONV_W, I_CONV_B, I_RG_W, I_RG_B, I_RG_LAM, I_P_RNN, I_P_ATTN, I_W_OUT, I_NORM_FFN, I_W_ROUTER, I_B_ROUTER, I_W_GATE, I_W_UP, I_W_DOWN, I_NORM_FINAL };

__device__ __forceinline__ unsigned long long karg_u64(int byte_off) {
    const auto ka = __builtin_amdgcn_kernarg_segment_ptr();
    unsigned long long v;
    asm volatile("s_load_dwordx2 %0, %1, %2\n\ts_waitcnt lgkmcnt(0)" : "=s"(v) : "s"(ka), "i"(byte_off) : "memory");
    return v;
}
#define KIN(i) ((const float*)(const GAS float*)karg_u64(8 * (i)))
#define KOUT() ((float*)(GAS float*)karg_u64(152))
#define KWS() ((unsigned char*)(GAS unsigned char*)karg_u64(160))
static_assert(sizeof(Params) == 184, "Params layout");

__device__ __forceinline__ float xlane32(float v, bool lower_half) {
    const unsigned u = __builtin_bit_cast(unsigned, v);
    const auto r = __builtin_amdgcn_permlane32_swap(u, u, false, false);
    return __builtin_bit_cast(float, lower_half ? (unsigned)r[1] : (unsigned)r[0]);
}
struct EpiInProj {
    static constexpr bool PERM = true, AFTER_DRAIN = false;
    const float* bias; bf16* xr; bf16* ggr; bf16* qkv; bf16* sga; bf16* sgb; const float* cosT; const float* sinT; int pn_off;
    __device__ __forceinline__ void operator()(const f32x4 (&acc)[2][2][4][2], const pg8::Unit& u, int wr, int wc, int fr, int fq) const {
        const int pn = u.pn + pn_off;
        const int row0 = u.pm * 256 + wr * 64 + fr, ccol = wc * 32 + 8 * fq, bcol0 = pn * 256 + ccol;
        f32x4 bv[2][2];
#pragma unroll
        for (int bj = 0; bj < 2; ++bj)
#pragma unroll
            for (int n = 0; n < 2; ++n) bv[bj][n] = *(const f32x4*)(bias + bcol0 + bj * 128 + 4 * n);
        __builtin_amdgcn_s_waitcnt(0x0F70);
        if (pn < 8 || pn >= 26) {
            bf16* O; int colt; int act;
            if (pn < 4) { O = xr; colt = pn * 256; act = 0; } else if (pn < 8) { O = ggr; colt = (pn - 4) * 256; act = 1; }
            else if (pn < 30) { O = sga; colt = (pn - 26) * 256; act = 2; } else { O = sgb; colt = (pn - 30) * 256; act = 2; }
#pragma unroll
            for (int ai = 0; ai < 2; ++ai)
#pragma unroll
                for (int m = 0; m < 4; ++m) { bf16* rowp = O + (size_t)(row0 + ai * 128 + m * 16) * 1024 + colt + ccol;
#pragma unroll
                    for (int bj = 0; bj < 2; ++bj) { f32x4 v0 = acc[ai][bj][m][0] + bv[bj][0], v1 = acc[ai][bj][m][1] + bv[bj][1];
                        if (act == 1) {
#pragma unroll
                            for (int e = 0; e < 4; ++e) { v0[e] = gelu_tanh(v0[e]); v1[e] = gelu_tanh(v1[e]); } }
                        if (act == 2) {
#pragma unroll
                            for (int e = 0; e < 4; ++e) { v0[e] = sigmoidf_(v0[e]); v1[e] = sigmoidf_(v1[e]); } }
                        v4u w; w.x = pk2(v0[0], v0[1]); w.y = pk2(v0[2], v0[3]); w.z = pk2(v1[0], v1[1]); w.w = pk2(v1[2], v1[3]);
                        *(v4u*)(rowp + bj * 128) = w; } }
        } else {
            const int q = pn - 8, sec = q / 6, g = (q % 6) >> 1, tig = q & 1;
            const int lg = 2 * g, dil = 1 << lg, L = SEQ >> lg;
            bf16* base = qkv + (size_t)(sec * 3 + g) * ((size_t)TALL * 512);
            const bool rot = (sec < 2) && (wc == 0);
            const float sgn = (fq < 2) ? -1.0f : 1.0f;
#pragma unroll
            for (int ai = 0; ai < 2; ++ai)
#pragma unroll
                for (int m = 0; m < 4; ++m) {
                    const int row = row0 + ai * 128 + m * 16, b = row >> 13, s = row & (SEQ - 1), rr = s & (dil - 1), j = s >> lg;
                    f32x4 cs0 = {1.f, 1.f, 1.f, 1.f}, cs1 = cs0, sn0 = {0.f, 0.f, 0.f, 0.f}, sn1 = sn0;
                    if (rot) { const float* cp = cosT + s * 16 + 8 * (fq & 1); const float* sp = sinT + s * 16 + 8 * (fq & 1);
                        cs0 = *(const f32x4*)cp; cs1 = *(const f32x4*)(cp + 4); sn0 = *(const f32x4*)sp; sn1 = *(const f32x4*)(sp + 4); }
#pragma unroll
                    for (int bj = 0; bj < 2; ++bj) { const int h = 2 * tig + bj;
                        f32x4 v0 = acc[ai][bj][m][0] + bv[bj][0], v1 = acc[ai][bj][m][1] + bv[bj][1];
                        if (rot) {
#pragma unroll
                            for (int e = 0; e < 4; ++e) { const float p0 = xlane32(v0[e], fq < 2), p1 = xlane32(v1[e], fq < 2);
                                v0[e] = v0[e] * cs0[e] + sgn * p0 * sn0[e]; v1[e] = v1[e] * cs1[e] + sgn * p1 * sn1[e]; } }
                        bf16* dst = base + ((size_t)(((b * 4 + h) * dil + rr) * L + j)) * 128 + ccol;
                        v4u w; w.x = pk2(v0[0], v0[1]); w.y = pk2(v0[2], v0[3]); w.z = pk2(v1[0], v1[1]); w.w = pk2(v1[2], v1[3]);
                        *(v4u*)dst = w; } }
        }
        __builtin_amdgcn_s_waitcnt(0x0F70);
    }
};
struct EpiGate {
    static constexpr bool PERM = true, AFTER_DRAIN = false;
    const bf16* gate; const bf16* add; bf16* out;
    __device__ __forceinline__ void operator()(const f32x4 (&acc)[2][2][4][2], const pg8::Unit& u, int wr, int wc, int fr, int fq) const {
        const int row0 = u.pm * 256 + wr * 64 + fr, col0 = u.pn * 256 + wc * 32 + 8 * fq;
#pragma unroll
        for (int ai = 0; ai < 2; ++ai)
#pragma unroll
            for (int m = 0; m < 4; ++m) { const size_t off = (size_t)(row0 + ai * 128 + m * 16) * 1024 + col0;
#pragma unroll
                for (int bj = 0; bj < 2; ++bj) { const v4u gw = *(const v4u*)(gate + off + bj * 128);
                    v4u aw = {0u, 0u, 0u, 0u}; if (add) aw = *(const v4u*)(add + off + bj * 128);
                    const f32x4 v0 = acc[ai][bj][m][0], v1 = acc[ai][bj][m][1];
                    v4u w;
                    w.x = pk2(bflo(aw.x) + bflo(gw.x) * v0[0], bfhi(aw.x) + bfhi(gw.x) * v0[1]);
                    w.y = pk2(bflo(aw.y) + bflo(gw.y) * v0[2], bfhi(aw.y) + bfhi(gw.y) * v0[3]);
                    w.z = pk2(bflo(aw.z) + bflo(gw.z) * v1[0], bfhi(aw.z) + bfhi(gw.z) * v1[1]);
                    w.w = pk2(bflo(aw.w) + bflo(gw.w) * v1[2], bfhi(aw.w) + bfhi(gw.w) * v1[3]);
                    *(v4u*)(out + off + bj * 128) = w; } }
    }
};
struct EpiResid {
    static constexpr bool PERM = false, AFTER_DRAIN = false;
    const float* res; float* out;
    __device__ __forceinline__ void operator()(const f32x4 (&acc)[2][2][4][2], const pg8::Unit& u, int wr, int wc, int fr, int fq) const {
        const int row0 = u.pm * 256 + wr * 64 + fr, col0 = u.pn * 256 + wc * 32 + 4 * fq;
#pragma unroll
        for (int ai = 0; ai < 2; ++ai)
#pragma unroll
            for (int m = 0; m < 4; ++m) { const size_t off = (size_t)(row0 + ai * 128 + m * 16) * 1024 + col0;
#pragma unroll
                for (int bj = 0; bj < 2; ++bj)
#pragma unroll
                    for (int n = 0; n < 2; ++n) { const f32x4 r = *(const f32x4*)(res + off + bj * 128 + n * 16); *(f32x4*)(out + off + bj * 128 + n * 16) = r + acc[ai][bj][m][n]; } }
    }
};
struct MoeOrder {
    int G, c, nJ, nunits;
    __device__ __forceinline__ bool next(int i, pg8::Unit& u) const {
        const int L = i * G + c; if (L >= nunits) return false;
        const int per_e = 16 * nJ, e = L / per_e, rem = L % per_e, panel = rem / nJ, j = rem % nJ;
        u.pm = ((panel >> 2) * 16 + e) * 4 + (panel & 3); u.pn = e * nJ + j; return true;
    }
    __device__ __forceinline__ void a_ready(const pg8::Unit&) const {}
    __device__ __forceinline__ void done(const pg8::Unit&) const {}
};
struct EpiSwiglu {
    static constexpr bool PERM = true, AFTER_DRAIN = false;
    bf16* hid;
    __device__ __forceinline__ void operator()(const f32x4 (&acc)[2][2][4][2], const pg8::Unit& u, int wr, int wc, int fr, int fq) const {
        const int row0 = u.pm * 256 + wr * 64 + fr, col0 = (u.pn & 15) * 128 + wc * 32 + 8 * fq;
#pragma unroll
        for (int ai = 0; ai < 2; ++ai)
#pragma unroll
            for (int m = 0; m < 4; ++m) { bf16* dst = hid + (size_t)(row0 + ai * 128 + m * 16) * DFF + col0;
                float o[8];
#pragma unroll
                for (int n = 0; n < 2; ++n)
#pragma unroll
                    for (int e = 0; e < 4; ++e) { const float gt = acc[ai][0][m][n][e], up = acc[ai][1][m][n][e]; o[4 * n + e] = gt * sigmoidf_(gt) * up; }
                v4u w; w.x = pk2(o[0], o[1]); w.y = pk2(o[2], o[3]); w.z = pk2(o[4], o[5]); w.w = pk2(o[6], o[7]);
                *(v4u*)dst = w; }
    }
};
struct EpiDown {
    static constexpr bool PERM = true, AFTER_DRAIN = false;
    bf16* eo; const float* gatev;
    __device__ __forceinline__ void operator()(const f32x4 (&acc)[2][2][4][2], const pg8::Unit& u, int wr, int wc, int fr, int fq) const {
        const int row0 = u.pm * 256 + wr * 64 + fr, col0 = (u.pn & 3) * 256 + wc * 32 + 8 * fq;
#pragma unroll
        for (int ai = 0; ai < 2; ++ai)
#pragma unroll
            for (int m = 0; m < 4; ++m) { const int row = row0 + ai * 128 + m * 16; const float gt = gatev[row]; bf16* dst = eo + (size_t)row * 1024 + col0;
#pragma unroll
                for (int bj = 0; bj < 2; ++bj) { const f32x4 v0 = acc[ai][bj][m][0] * gt, v1 = acc[ai][bj][m][1] * gt;
                    v4u w; w.x = pk2(v0[0], v0[1]); w.y = pk2(v0[2], v0[3]); w.z = pk2(v1[0], v1[1]); w.w = pk2(v1[2], v1[3]);
                    *(v4u*)(dst + bj * 128) = w; } }
    }
};

__device__ __forceinline__ void tr_item(const float* W, int ldw, int k0, int n0, bf16* dst, size_t drow0, int ldd, LAS float* scr, int lane) {
#pragma unroll 8
    for (int i = 0; i < 32; ++i) { const int kk = 2 * i + (lane >> 5); scr[kk * 33 + (lane & 31)] = W[(size_t)(k0 + kk) * ldw + n0 + (lane & 31)]; }
    LDS_WAIT(); asm volatile("" ::: "memory");
    const int c = lane & 7;
#pragma unroll
    for (int j = 0; j < 4; ++j) { const int n = (lane >> 3) + 8 * j; const LAS float* s = scr + (8 * c) * 33 + n;
        v4u o; o.x = pk2(s[0 * 33], s[1 * 33]); o.y = pk2(s[2 * 33], s[3 * 33]); o.z = pk2(s[4 * 33], s[5 * 33]); o.w = pk2(s[6 * 33], s[7 * 33]);
        *(v4u*)(dst + (drow0 + n) * (size_t)ldd + k0 + 8 * c) = o; }
    LDS_WAIT(); asm volatile("" ::: "memory");
}
__device__ __forceinline__ void rms_row(const float* xrow, const float* gain, int lane, f32x4 (&o)[4]) {
    const f32x4* xr = (const f32x4*)xrow + lane; float s = 0.f;
#pragma unroll
    for (int j = 0; j < 4; ++j) { o[j] = xr[64 * j]; s += (o[j].x * o[j].x + o[j].y * o[j].y) + (o[j].z * o[j].z + o[j].w * o[j].w); }
    const float rstd = 1.0f / sqrtf(wave_sum(s) * (1.0f / DM) + RMS_EPS);
#pragma unroll
    for (int j = 0; j < 4; ++j) { const f32x4 g = ((const f32x4*)gain)[64 * j + lane]; o[j] = o[j] * rstd * g; }
}
__device__ __forceinline__ void store_row_bf16(bf16* orow, int lane, const f32x4 (&o)[4]) {
    unsigned long long* o8 = (unsigned long long*)orow + lane;
#pragma unroll
    for (int j = 0; j < 4; ++j) o8[64 * j] = (unsigned long long)pk2(o[j].x, o[j].y) | ((unsigned long long)pk2(o[j].z, o[j].w) << 32);
}

__device__ const float ROPE_INV[16] = {1.0f, 0.44036659598350525f, 0.1939227432012558f, 0.08539710193872452f, 0.03760603070259094f, 0.01656043902039528f, 0.007292664609849453f, 0.0032114458736032248f,
    0.0014142135623842478f, 0.000622772378847003f, 0.00027424818836152554f, 0.00012076973507646471f, 5.318296098266728e-05f, 2.34199997066753e-05f, 1.0313386155758053e-05f, 4.541670477919979e-06f};

__device__ __forceinline__ void phase_prep(LAS unsigned char* lds, int tid) {
    const int wave = tid >> 6, lane = tid & 63, G = gridDim.x;
    LAS float* scr = (LAS float*)(lds + wave * 16384);
    const int gw = blockIdx.x * 8 + wave, NGW = G * 8;
    unsigned char* ws = KWS();
    const float* w_in = KIN(I_W_IN); const float* p_rnn = KIN(I_P_RNN); const float* p_attn = KIN(I_P_ATTN); const float* w_out = KIN(I_W_OUT);
    constexpr int I_WIN = 16 * 272, I_PR = 16 * 32, I_PA = 8 * 32, I_WO = 16 * 32, NIT = I_WIN + I_PR + I_PA + I_WO;
    for (int it = gw; it < NIT; it += NGW) {
        int r = it;
        if (r < I_WIN) { const int kb = r / 272, nb = r % 272; tr_item(w_in, D_IN, kb * 64, nb * 32, (bf16*)(ws + WS_WIN), nb * 32, 1024, scr, lane); continue; } r -= I_WIN;
        if (r < I_PR) { const int kb = r / 32, nb = r % 32; tr_item(p_rnn, 1024, kb * 64, nb * 32, (bf16*)(ws + WS_PRNN), nb * 32, 1024, scr, lane); continue; } r -= I_PR;
        if (r < I_PA) { const int kb = r / 32, nb = r % 32; tr_item(p_attn, 1024, kb * 64, nb * 32, (bf16*)(ws + WS_PATT), nb * 32, 512, scr, lane); continue; } r -= I_PA;
        { const int kb = r / 32, nb = r % 32; tr_item(w_out, 1024, kb * 64, nb * 32, (bf16*)(ws + WS_WOUT), nb * 32, 1024, scr, lane); }
    }
    for (int i = blockIdx.x * 512 + tid; i < SEQ * 16; i += G * 512) {
        const int pos = i >> 4, k = i & 15;
        const float ang = (float)pos * ROPE_INV[k];
        const double a = (double)ang;
        const double kq = __builtin_rint(a * 0.63661977236758134308);
        double y = __builtin_fma(-kq, 1.57079632679489655800e+00, a); y = __builtin_fma(-kq, 6.12323399573676603587e-17, y);
        const int q = ((int)kq) & 3;
        const double y2 = y * y;
        const double sp = y * (1.0 + y2 * (-1.0 / 6 + y2 * (1.0 / 120 + y2 * (-1.0 / 5040 + y2 * (1.0 / 362880 + y2 * (-1.0 / 39916800 + y2 * (1.0 / 6227020800.0)))))));
        const double cp = 1.0 + y2 * (-0.5 + y2 * (1.0 / 24 + y2 * (-1.0 / 720 + y2 * (1.0 / 40320 + y2 * (-1.0 / 3628800 + y2 * (1.0 / 479001600.0 + y2 * (-1.0 / 87178291200.0)))))));
        double sv, cv;
        if (q == 0) { sv = sp; cv = cp; } else if (q == 1) { sv = cp; cv = -sp; } else if (q == 2) { sv = -sp; cv = -cp; } else { sv = -cp; cv = sp; }
        ((float*)(ws + WS_COS))[i] = (float)cv; ((float*)(ws + WS_SIN))[i] = (float)sv;
    }
    { const float* rgw = KIN(I_RG_W); const float* cvw = KIN(I_CONV_W);
      for (int f = blockIdx.x * 512 + tid; f < 2 * 8 * 8 * 32 * 64; f += G * 512) {
        const int ln = f & 63, frag = f >> 6, kk = frag & 3, tap = (frag >> 2) & 3, g = (frag >> 4) & 1, u = frag >> 5, cg = u & 7, n = (u >> 3) & 7, dir = u >> 6, fr = ln & 15, fq = ln >> 4;
        const float* wp = rgw + ((size_t)(((dir * 2 + g) * 8 + n) * 128 + kk * 32 + 8 * fq)) * 128 + cg * 16 + fr;
        const float* cp = cvw + tap * 1024 + n * 128 + kk * 32 + 8 * fq;
        v4u w; w.x = pk2(wp[0] * cp[0], wp[128] * cp[1]); w.y = pk2(wp[256] * cp[2], wp[384] * cp[3]); w.z = pk2(wp[512] * cp[4], wp[640] * cp[5]); w.w = pk2(wp[768] * cp[6], wp[896] * cp[7]);
        ((v4u*)(ws + WS_RGWF))[f] = w; }
      const float* rgb = KIN(I_RG_B); const float* cvb = KIN(I_CONV_B);
      for (int i = blockIdx.x * 512 + tid; i < 4096; i += G * 512) { const int dg = i >> 10, cc = i & 1023, n = cc >> 7, j = cc & 127; float s = rgb[i];
        for (int k = 0; k < 128; ++k) s += cvb[n * 128 + k] * rgw[((size_t)((dg * 8 + n) * 128 + k)) * 128 + j];
        ((float*)(ws + WS_RGBIAS))[i] = s; } }
    const float* xin = KIN(I_X); const float* nmix = KIN(I_NORM_MIX);
    for (int m = gw; m < TALL; m += NGW) { f32x4 o[4]; rms_row(xin + (size_t)m * DM, nmix, lane, o); store_row_bf16((bf16*)(ws + WS_XN) + (size_t)m * DM, lane, o); }
}

constexpr int RNN_RING_BYTES = 128 * 256;
constexpr int RNN_QD = 2, RNN_QE = 3072, RNN_Q_OFF = 4 * RNN_RING_BYTES, RNN_Q_BYTES = RNN_QD * RNN_QE;
constexpr int RNN_CTL_OFF = RNN_Q_OFF + 4 * RNN_Q_BYTES;
__device__ __forceinline__ int rnn_cell(int row, int j) { return ((row >> 4) & 7) * 4096 + ((j * 16 + (row & 15)) << 4); }
#define RNN_TILE(i) (dir ? 511 - (i) : (i))
__device__ __forceinline__ void rnn_spin_ge(volatile LAS unsigned* w, unsigned want) {
    unsigned spins = 0;
    while ((unsigned)__builtin_amdgcn_readfirstlane((int)*w) < want) { if (++spins > (1u << 24)) break; }
    asm volatile("" ::: "memory");
}
__device__ __forceinline__ void rnn_producer(LAS unsigned char* ring, LAS unsigned char* queue, volatile LAS unsigned* head, volatile LAS unsigned* tail,
                                             int unit, int dir, const bf16* xr, const v4u* rgwf, const float* rgbias, int lane) {
    const int b = unit >> 6, n = (unit >> 3) & 7, cg = unit & 7, fr = lane & 15, fq = lane >> 4, c = n * 128 + cg * 16 + fr;
    bf16x8 Wg[2][4][4];
    { const v4u* wp = rgwf + ((size_t)((dir * 8 + n) * 8 + cg) * 32) * 64 + lane;
#pragma unroll
      for (int g = 0; g < 2; ++g)
#pragma unroll
        for (int tap = 0; tap < 4; ++tap)
#pragma unroll
          for (int kk = 0; kk < 4; ++kk) Wg[g][tap][kk] = __builtin_bit_cast(bf16x8, wp[((g * 4 + tap) * 4 + kk) * 64]); }
    const float* conv_w = KIN(I_CONV_W); const float* conv_b = KIN(I_CONV_B);
    const bool mine = fq == ((cg & 1) * 2 + (fr >> 3));
    unsigned cq0, cq1, cq2, cq3;
    { const unsigned w0 = f2bf(conv_w[c]), w1 = f2bf(conv_w[1024 + c]), w2 = f2bf(conv_w[2048 + c]), w3 = f2bf(conv_w[3072 + c]); const int sh = (fr & 1) * 16;
      cq0 = mine ? (w0 << sh) : 0u; cq1 = mine ? (w1 << sh) : 0u; cq2 = mine ? (w2 << sh) : 0u; cq3 = mine ? (w3 << sh) : 0u; }
    float br = rgbias[(dir * 2 + 0) * 1024 + c], bi = rgbias[(dir * 2 + 1) * 1024 + c], cbv = conv_b[c];
    const int kkc = cg >> 1, jsel = (fr & 7) >> 1;
    const bf16* xb = xr + (size_t)b * SEQ * 1024 + n * 128;
    for (int i = lane; i < RNN_RING_BYTES / 16; i += 64) *(LAS v4u*)(ring + i * 16) = (v4u){0u, 0u, 0u, 0u};
    const unsigned lofs = (unsigned)(lane & 15) * 2048u + (unsigned)(lane >> 4) * 16u;
#define RNN_FILL(kt) do { const int kt_ = (kt); LAS unsigned char* dst_ = ring + (kt_ & 7) * 4096; \
        if (kt_ >= 0 && kt_ < 512) { _Pragma("unroll") for (int i = 0; i < 4; ++i) \
            __builtin_amdgcn_global_load_lds((const unsigned*)((const char*)(xb + (size_t)kt_ * 16384) + (lofs + (unsigned)i * 64u)), (LAS unsigned*)(dst_ + i * 1024), 16, 0, 0); } \
        else { _Pragma("unroll") for (int i = 0; i < 4; ++i) *(LAS v4u*)(dst_ + i * 1024 + lane * 16) = (v4u){0u, 0u, 0u, 0u}; } } while (0)
    RNN_FILL(RNN_TILE(0)); RNN_FILL(RNN_TILE(1)); RNN_FILL(RNN_TILE(2));
#pragma unroll 1
    for (int s = 0; s < 256; ++s) {
        const int tA = 16 * RNN_TILE(2 * s), tB = 16 * RNN_TILE(2 * s + 1);
        asm volatile("s_waitcnt vmcnt(0)" ::: "memory");
        RNN_FILL(RNN_TILE(2 * s + 3)); RNN_FILL(RNN_TILE(2 * s + 4));
        float brl = br, bil = bi, cbl = cbv; asm volatile("" : "+v"(brl), "+v"(bil), "+v"(cbl));
        f32x4 arA = {brl, brl, brl, brl}, aiA = {bil, bil, bil, bil}, axA = {cbl, cbl, cbl, cbl}, arB = arA, aiB = aiA, axB = axA;
#pragma unroll
        for (int tap = 0; tap < 4; ++tap) {
            unsigned cwt = tap == 0 ? cq0 : tap == 1 ? cq1 : tap == 2 ? cq2 : cq3; asm volatile("" : "+v"(cwt));
            v4u dv; dv.x = jsel == 0 ? cwt : 0u; dv.y = jsel == 1 ? cwt : 0u; dv.z = jsel == 2 ? cwt : 0u; dv.w = jsel == 3 ? cwt : 0u; const bf16x8 Dt = __builtin_bit_cast(bf16x8, dv);
            const LAS unsigned char* pa = ring + rnn_cell(tA + fr + tap - 2, fq); const LAS unsigned char* pb = ring + rnn_cell(tB + fr + tap - 2, fq);
            { const bf16x8 ac = *(const LAS bf16x8*)(pa + kkc * 1024), bc = *(const LAS bf16x8*)(pb + kkc * 1024);
              axA = __builtin_amdgcn_mfma_f32_16x16x32_bf16(ac, Dt, axA, 0, 0, 0); axB = __builtin_amdgcn_mfma_f32_16x16x32_bf16(bc, Dt, axB, 0, 0, 0); }
#pragma unroll
            for (int kk = 0; kk < 4; ++kk) { const bf16x8 a = *(const LAS bf16x8*)(pa + kk * 1024), bb = *(const LAS bf16x8*)(pb + kk * 1024);
                arA = __builtin_amdgcn_mfma_f32_16x16x32_bf16(a, Wg[0][tap][kk], arA, 0, 0, 0); aiA = __builtin_amdgcn_mfma_f32_16x16x32_bf16(a, Wg[1][tap][kk], aiA, 0, 0, 0);
                arB = __builtin_amdgcn_mfma_f32_16x16x32_bf16(bb, Wg[0][tap][kk], arB, 0, 0, 0); aiB = __builtin_amdgcn_mfma_f32_16x16x32_bf16(bb, Wg[1][tap][kk], aiB, 0, 0, 0); }
            __builtin_amdgcn_sched_barrier(0);
        }
        if (s >= RNN_QD) rnn_spin_ge(tail, (unsigned)(s - RNN_QD + 1));
        LAS unsigned char* qe = queue + (s % RNN_QD) * RNN_QE + lane * 48;
        *(LAS v4u*)qe = (v4u){pk2(arA[0], arA[1]), pk2(arA[2], arA[3]), pk2(aiA[0], aiA[1]), pk2(aiA[2], aiA[3])};
        *(LAS v4u*)(qe + 16) = (v4u){pk2(axA[0], axA[1]), pk2(axA[2], axA[3]), pk2(arB[0], arB[1]), pk2(arB[2], arB[3])};
        *(LAS v4u*)(qe + 32) = (v4u){pk2(aiB[0], aiB[1]), pk2(aiB[2], aiB[3]), pk2(axB[0], axB[1]), pk2(axB[2], axB[3])};
        asm volatile("s_waitcnt lgkmcnt(0)" ::: "memory");
        if (lane == 0) *head = (unsigned)(s + 1);
    }
#undef RNN_FILL
}
__device__ __forceinline__ void rnn_quads(float P, float H, int fr, int fq, int dir, float& Pc, float& Hc, float& Pw, float& Hw) {
    float Pq[4], Hq[4];
#pragma unroll
    for (int qq = 0; qq < 4; ++qq) { Pq[qq] = __shfl(P, fr + 16 * qq); Hq[qq] = __shfl(H, fr + 16 * qq); }
    Pc = 1.f; Hc = 0.f; Pw = 1.f; Hw = 0.f;
    if (dir == 0) {
#pragma unroll
        for (int qq = 0; qq < 4; ++qq) { if (qq < fq) { Hc = Pq[qq] * Hc + Hq[qq]; Pc *= Pq[qq]; } Hw = Pq[qq] * Hw + Hq[qq]; Pw *= Pq[qq]; }
    } else {
#pragma unroll
        for (int qq = 3; qq >= 0; --qq) { if (qq > fq) { Hc = Pq[qq] * Hc + Hq[qq]; Pc *= Pq[qq]; } Hw = Pq[qq] * Hw + Hq[qq]; Pw *= Pq[qq]; }
    }
}
__device__ __forceinline__ void rnn_local(unsigned r01, unsigned r23, unsigned i01, unsigned i23, unsigned x01, unsigned x23, float spl2, int dir, float (&hl)[4], float (&pl)[4], float& P, float& H) {
    const float ar[4] = {bflo(r01), bfhi(r01), bflo(r23), bfhi(r23)}, ai[4] = {bflo(i01), bfhi(i01), bflo(i23), bfhi(i23)}, ax[4] = {bflo(x01), bfhi(x01), bflo(x23), bfhi(x23)};
    float av[4], uv[4];
#pragma unroll
    for (int r = 0; r < 4; ++r) {
        const float rg = __builtin_amdgcn_rcpf(1.0f + __builtin_amdgcn_exp2f(-1.4426950408889634f * ar[r]));
        const float ig = __builtin_amdgcn_rcpf(1.0f + __builtin_amdgcn_exp2f(-1.4426950408889634f * ai[r]));
        const float a = __builtin_amdgcn_exp2f(-spl2 * rg);
        av[r] = a; uv[r] = ax[r] * ig * __builtin_amdgcn_sqrtf(fmaxf(1.0f - a * a, 0.f)); }
    H = 0.f; P = 1.f;
    if (dir == 0) {
#pragma unroll
        for (int r = 0; r < 4; ++r) { H = av[r] * H + uv[r]; P *= av[r]; hl[r] = H; pl[r] = P; }
    } else {
#pragma unroll
        for (int r = 3; r >= 0; --r) { H = av[r] * H + uv[r]; P *= av[r]; hl[r] = H; pl[r] = P; }
    }
}
__device__ __forceinline__ void rnn_consumer(const LAS unsigned char* queue, volatile LAS unsigned* head, volatile LAS unsigned* tail,
                                             volatile LAS unsigned* myflag, volatile LAS unsigned* otherflag, unsigned epoch,
                                             int unit, int dir, const bf16* ggr, bf16* yout, unsigned long long* hx, int lane) {
    const int b = unit >> 6, n = (unit >> 3) & 7, cg = unit & 7, fr = lane & 15, fq = lane >> 4, c = n * 128 + cg * 16 + fr;
    const float* rgl = KIN(I_RG_LAM);
    const float spl2 = 8.0f * log1pf(expf(-rgl[dir * 1024 + c])) * 1.4426950408889634f;
    const unsigned obase = (unsigned)(((size_t)b * SEQ + 4 * fq) * 1024 + c) * 2u;
    unsigned long long* hxu = hx + (size_t)unit * 512 * 64;
    float carry = 0.f;
    unsigned oA01 = 0u, oA23 = 0u, oB01 = 0u, oB23 = 0u; int otA = 0, otB = 0;
#define RNN_YST(o01, o23, t_) do { *(bf16*)((char*)yout + obase + (unsigned)((t_) + 0) * 2048u) = (bf16)((o01) & 0xffffu); *(bf16*)((char*)yout + obase + (unsigned)((t_) + 1) * 2048u) = (bf16)((o01) >> 16); \
        *(bf16*)((char*)yout + obase + (unsigned)((t_) + 2) * 2048u) = (bf16)((o23) & 0xffffu); *(bf16*)((char*)yout + obase + (unsigned)((t_) + 3) * 2048u) = (bf16)((o23) >> 16); } while (0)
#define RNN_CSTEP(SECOND) do { \
        const int kA = RNN_TILE(2 * s), kB = RNN_TILE(2 * s + 1), tA = 16 * kA, tB = 16 * kB; \
        if (s > 0) { if (SECOND && s > 128) { RNN_YST(oA01, oA23, otA); RNN_YST(oB01, oB23, otB); } \
                     else { hxu[(otA >> 4) * 64 + lane] = (unsigned long long)oA01 | ((unsigned long long)oA23 << 32); hxu[(otB >> 4) * 64 + lane] = (unsigned long long)oB01 | ((unsigned long long)oB23 << 32); } } \
        if (SECOND && s == 128) {                                                \
            asm volatile("s_waitcnt vmcnt(0)" ::: "memory"); \
            if (lane == 0) *myflag = epoch; \
            rnn_spin_ge(otherflag, epoch); } \
        unsigned long long hpA = 0ull, hpB = 0ull; unsigned short gA[4] = {0, 0, 0, 0}, gB[4] = {0, 0, 0, 0}; \
        if (SECOND) { hpA = __hip_atomic_load(hxu + kA * 64 + lane, __ATOMIC_RELAXED, __HIP_MEMORY_SCOPE_AGENT); hpB = __hip_atomic_load(hxu + kB * 64 + lane, __ATOMIC_RELAXED, __HIP_MEMORY_SCOPE_AGENT); \
            _Pragma("unroll") for (int r = 0; r < 4; ++r) { gA[r] = *(const bf16*)((const char*)ggr + obase + (unsigned)(tA + r) * 2048u); gB[r] = *(const bf16*)((const char*)ggr + obase + (unsigned)(tB + r) * 2048u); } } \
        rnn_spin_ge(head, (unsigned)(s + 1)); \
        const LAS unsigned char* qe = queue + (s % RNN_QD) * RNN_QE + lane * 48; \
        const v4u q0 = *(const LAS v4u*)qe, q1 = *(const LAS v4u*)(qe + 16), q2 = *(const LAS v4u*)(qe + 32); \
        asm volatile("s_waitcnt lgkmcnt(0)" ::: "memory"); \
        if (lane == 0) *tail = (unsigned)(s + 1); \
        float hlA[4], plA[4], hlB[4], plB[4], PA, HA, PB, HB; \
        rnn_local(q0.x, q0.y, q0.z, q0.w, q1.x, q1.y, spl2, dir, hlA, plA, PA, HA); \
        rnn_local(q1.z, q1.w, q2.x, q2.y, q2.z, q2.w, spl2, dir, hlB, plB, PB, HB); \
        float PcA, HcA, PwA, HwA, PcB, HcB, PwB, HwB; \
        rnn_quads(PA, HA, fr, fq, dir, PcA, HcA, PwA, HwA); rnn_quads(PB, HB, fr, fq, dir, PcB, HcB, PwB, HwB); \
        const float HsA = PcA * carry + HcA; carry = PwA * carry + HwA; \
        const float HsB = PcB * carry + HcB; carry = PwB * carry + HwB; \
        float hA[4], hB[4]; \
        _Pragma("unroll") for (int r = 0; r < 4; ++r) { hA[r] = plA[r] * HsA + hlA[r]; hB[r] = plB[r] * HsB + hlB[r]; \
            if (SECOND) { hA[r] = bf2f(gA[r]) * (bf2f((unsigned short)(hpA >> (16 * r))) + hA[r]); hB[r] = bf2f(gB[r]) * (bf2f((unsigned short)(hpB >> (16 * r))) + hB[r]); } } \
        oA01 = pk2(hA[0], hA[1]); oA23 = pk2(hA[2], hA[3]); oB01 = pk2(hB[0], hB[1]); oB23 = pk2(hB[2], hB[3]); otA = tA; otB = tB; } while (0)
#pragma unroll 1
    for (int s = 0; s < 128; ++s) RNN_CSTEP(false);
#pragma unroll 1
    for (int s = 128; s < 256; ++s) RNN_CSTEP(true);
    RNN_YST(oA01, oA23, otA); RNN_YST(oB01, oB23, otB);
#undef RNN_CSTEP
#undef RNN_YST
}
#undef RNN_TILE

typedef short v4i16_t __attribute__((ext_vector_type(4)));
__device__ __forceinline__ unsigned attn_off_a(unsigned row, unsigned ch) { return 2048u * (row >> 3) + 512u * (ch >> 2) + 64u * (row & 7) + 16u * ((ch & 3) ^ ((row >> 2) & 3)); }
constexpr int ATT_K_BYTES = 256 * 272, ATT_V_OFF = ATT_K_BYTES, ATT_V_BYTES = 272 * 256;
__device__ __forceinline__ void phase_attn(const bf16* qkv, bf16* og, float* lse, LAS unsigned char* lds, int tid, int G) {
    const int wave = __builtin_amdgcn_readfirstlane(tid >> 6), lane = tid & 63, fr = lane & 15, fq = lane >> 4;
    LAS unsigned char* kimg = lds;
    LAS unsigned char* vimg = lds + ATT_V_OFF;
    LAS unsigned char* pb = lds + wave * 5376;
    for (int i = tid; i < 16 * 256 / 16; i += 512) *(LAS v4u*)(vimg + 256 * 256 + i * 16) = (v4u){0u, 0u, 0u, 0u};
    v4u kp[8], vp[8]; bf16x8 qf[4]; v4u ost[4]; bf16* odst = nullptr;
#define ATT_DECODE(u_) const int g_ = (u_) >> 11, rem_ = (u_) & 2047, bl_ = rem_ >> 8, h_ = (rem_ >> 6) & 3, w_ = rem_ & 63, lg_ = 2 * g_, dil_ = 1 << lg_, L_ = SEQ >> lg_, nblk_ = 64 >> lg_, rr_ = w_ / nblk_, q0_ = (w_ % nblk_) * 128; \
        const size_t sub_ = ((size_t)((bl_ * 4 + h_) * dil_ + rr_) * L_) * 128
#define ATT_LOAD(u_) do { ATT_DECODE(u_); const bf16* Kp_ = qkv + (size_t)(1 * 3 + g_) * ((size_t)TALL * 512) + sub_; \
        const bf16* Vp_ = qkv + (size_t)(2 * 3 + g_) * ((size_t)TALL * 512) + sub_; \
        _Pragma("unroll") for (int i = 0; i < 8; ++i) { const int idx = tid + 512 * i, row = idx >> 4, ch = idx & 15, gk = q0_ - 64 + row; kp[i] = (v4u){0u, 0u, 0u, 0u}; vp[i] = kp[i]; \
            if (gk >= 0 && gk < L_) { kp[i] = *(const v4u*)(Kp_ + (size_t)gk * 128 + ch * 8); vp[i] = *(const v4u*)(Vp_ + (size_t)gk * 128 + ch * 8); } } \
        } while (0)
#define ATT_LOADQ(u_) do { ATT_DECODE(u_); const bf16* Qp_ = qkv + (size_t)(0 * 3 + g_) * ((size_t)TALL * 512) + sub_; \
        _Pragma("unroll") for (int kk = 0; kk < 4; ++kk) qf[kk] = *(const bf16x8*)(Qp_ + (size_t)(q0_ + 16 * wave + fr) * 128 + kk * 32 + 8 * fq); } while (0)
    int unit = blockIdx.x;
    if (unit < 6144) { ATT_LOAD(unit); ATT_LOADQ(unit); }
    for (; unit < 6144; unit += G) {
        ATT_DECODE(unit);
        const int k0 = q0_ - 64;
#pragma unroll
        for (int i = 0; i < 8; ++i) { const int idx = tid + 512 * i, row = idx >> 4, ch = idx & 15;
            *(LAS v4u*)(kimg + row * 272 + ch * 16) = kp[i]; *(LAS v4u*)(vimg + attn_off_a(row, ch)) = vp[i]; }
        if (odst) {
#pragma unroll
            for (int i = 0; i < 4; ++i) *(v4u*)(odst + 32 * i) = ost[i]; }
        __syncthreads();
        if (unit + G < 6144) ATT_LOAD(unit + G);
        f32x4 s[9];
#pragma unroll
        for (int kt = 0; kt < 9; ++kt) { s[kt] = (f32x4){0.f, 0.f, 0.f, 0.f};
#pragma unroll
            for (int kk = 0; kk < 4; ++kk) { const bf16x8 b = *(const LAS bf16x8*)(kimg + ((wave + kt) * 16 + fr) * 272 + (kk * 32 + 8 * fq) * 2);
                s[kt] = __builtin_amdgcn_mfma_f32_16x16x32_bf16(qf[kk], b, s[kt], 0, 0, 0); } }
        if (unit + G < 6144) ATT_LOADQ(unit + G);
        const float scale2 = 0.08838834764831845f * 1.4426950408889634f;
        float mx[4] = {-1e30f, -1e30f, -1e30f, -1e30f};
#pragma unroll
        for (int kt = 0; kt < 9; ++kt) { const int lk = (wave + kt) * 16 + fr, gk = k0 + lk;
#pragma unroll
            for (int r = 0; r < 4; ++r) { const int lq = 16 * wave + 4 * fq + r, rel = lk - 64 - lq;
                const bool valid = (rel >= -64) && (rel <= 64) && (gk >= 0) && (gk < L_);
                const float sv = valid ? s[kt][r] * scale2 : -1e30f; s[kt][r] = sv; mx[r] = fmaxf(mx[r], sv); } }
#pragma unroll
        for (int r = 0; r < 4; ++r) {
#pragma unroll
            for (int o = 1; o < 16; o <<= 1) mx[r] = fmaxf(mx[r], __shfl_xor(mx[r], o)); }
        float sum[4] = {0.f, 0.f, 0.f, 0.f};
#pragma unroll
        for (int kt = 0; kt < 9; ++kt)
#pragma unroll
            for (int r = 0; r < 4; ++r) { const float pv = __builtin_amdgcn_exp2f(s[kt][r] - mx[r]); sum[r] += pv; s[kt][r] = pv; }
#pragma unroll
        for (int r = 0; r < 4; ++r) {
#pragma unroll
            for (int o = 1; o < 16; o <<= 1) sum[r] += __shfl_xor(sum[r], o); }
        if (fr == 0) {
#pragma unroll
            for (int r = 0; r < 4; ++r) { const size_t t = (size_t)bl_ * SEQ + (size_t)(q0_ + 16 * wave + 4 * fq + r) * dil_ + rr_; (lse + (size_t)g_ * ((size_t)TALL * 4))[t * 4 + h_] = (mx[r] + __builtin_amdgcn_logf(sum[r])) * 0.6931471805599453f; } }
        __syncthreads();
#pragma unroll
        for (int kt = 0; kt < 9; ++kt)
#pragma unroll
            for (int r = 0; r < 4; ++r) *(LAS unsigned short*)(pb + (4 * fq + r) * 336 + (kt * 16 + fr) * 2) = (unsigned short)f2bf(s[kt][r]);
        *(LAS v2u*)(pb + (lane >> 2) * 336 + 288 + (lane & 3) * 8) = (v2u){0u, 0u};
        f32x4 o[8];
#pragma unroll
        for (int nt = 0; nt < 8; ++nt) o[nt] = (f32x4){0.f, 0.f, 0.f, 0.f};
        { const unsigned tq = (unsigned)fr >> 2, tp = (unsigned)fr & 3;
          const unsigned bcom = 2048u * (2u * (unsigned)wave + (unsigned)fq) + 64u * tq + 8u * (tp & 1);
          const LAS unsigned char* vb00 = vimg + bcom + 16u * (((tp >> 1)) ^ ((2u * fq) & 3u));
          const LAS unsigned char* vb01 = vimg + bcom + 256u + 16u * (((tp >> 1)) ^ ((2u * fq + 1u) & 3u));
          const LAS unsigned char* vb10 = vimg + bcom + 16u * ((2u + (tp >> 1)) ^ ((2u * fq) & 3u));
          const LAS unsigned char* vb11 = vimg + bcom + 256u + 16u * ((2u + (tp >> 1)) ^ ((2u * fq + 1u) & 3u));
#pragma unroll
          for (int kk = 0; kk < 5; ++kk) { const bf16x8 a = *(const LAS bf16x8*)(pb + fr * 336 + (kk * 32 + 8 * fq) * 2);
#pragma unroll
            for (int nt = 0; nt < 8; ++nt) {
                const LAS unsigned char* p0 = ((nt & 1) ? vb10 : vb00) + kk * 8192 + (nt >> 1) * 512; const LAS unsigned char* p1 = ((nt & 1) ? vb11 : vb01) + kk * 8192 + (nt >> 1) * 512;
                const v4i16_t b0 = __builtin_amdgcn_ds_read_tr16_b64_v4i16((LAS v4i16_t*)p0);
                const v4i16_t b1 = __builtin_amdgcn_ds_read_tr16_b64_v4i16((LAS v4i16_t*)p1);
                bf16x8 b; b[0] = b0[0]; b[1] = b0[1]; b[2] = b0[2]; b[3] = b0[3]; b[4] = b1[0]; b[5] = b1[1]; b[6] = b1[2]; b[7] = b1[3];
                o[nt] = __builtin_amdgcn_mfma_f32_16x16x32_bf16(a, b, o[nt], 0, 0, 0); } } }
#pragma unroll
        for (int r = 0; r < 4; ++r) { const float inv = 1.0f / sum[r];
#pragma unroll
            for (int nt = 0; nt < 8; ++nt) *(LAS unsigned short*)(pb + (4 * fq + r) * 272 + (nt * 16 + fr) * 2) = (unsigned short)f2bf(o[nt][r] * inv);
 }
        { const int row = lane >> 2; const size_t t = (size_t)bl_ * SEQ + (size_t)(q0_ + 16 * wave + row) * dil_ + rr_; odst = og + (size_t)g_ * ((size_t)TALL * 512) + t * 512 + h_ * 128 + (lane & 3) * 8;
#pragma unroll
          for (int i = 0; i < 4; ++i) ost[i] = *(const LAS v4u*)(pb + row * 272 + (4 * i + (lane & 3)) * 16); }
        __syncthreads();
    }
    if (odst) {
#pragma unroll
        for (int i = 0; i < 4; ++i) *(v4u*)(odst + 32 * i) = ost[i]; }
#undef ATT_LOAD
#undef ATT_DECODE
}

__device__ __forceinline__ unsigned block_sum_u32(unsigned v, LAS unsigned* red, int tid) {
#pragma unroll
    for (int o = 1; o < 64; o <<= 1) v += __shfl_xor(v, o);
    if ((tid & 63) == 0) red[tid >> 6] = v;
    __syncthreads();
    unsigned t = 0;
#pragma unroll
    for (int w = 0; w < 8; ++w) t += red[w];
    __syncthreads();
    return t;
}
__device__ __forceinline__ void topk_unit(const float* aff  , int* idx  , float* gatev  , int* slot  ,
                                          LAS unsigned char* lds, int tid) {
    LAS unsigned* red = (LAS unsigned*)lds;
    LAS unsigned* wtot = (LAS unsigned*)(lds + 64);
    unsigned v[16];
    { const v4u* src = (const v4u*)(aff + tid * 16);
#pragma unroll
      for (int i = 0; i < 4; ++i) { const v4u w = src[i]; v[4 * i] = w.x; v[4 * i + 1] = w.y; v[4 * i + 2] = w.z; v[4 * i + 3] = w.w; } }
    unsigned prefix = 0u;
    for (int bit = 30; bit >= 0; --bit) {
        const unsigned cand = prefix | (1u << bit); unsigned cnt = 0;
#pragma unroll
        for (int k = 0; k < 16; ++k) cnt += (v[k] >= cand) ? 1u : 0u;
        const unsigned tot = block_sum_u32(cnt, red, tid);
        if (tot >= (unsigned)CAP) prefix = cand;
    }
    const unsigned T = prefix;
    unsigned cgt = 0, ceq = 0;
#pragma unroll
    for (int k = 0; k < 16; ++k) { cgt += (v[k] > T) ? 1u : 0u; ceq += (v[k] == T) ? 1u : 0u; }
    const unsigned packed = cgt | (ceq << 16);
    const unsigned total = block_sum_u32(packed, red, tid);
    const unsigned n_gt = total & 0xffffu, need_eq = (unsigned)CAP - n_gt;
    const int lane = tid & 63, wave = tid >> 6;
    unsigned inc = packed;
#pragma unroll
    for (int o = 1; o < 64; o <<= 1) { const unsigned t = __shfl_up(inc, o); if (lane >= o) inc += t; }
    if (lane == 63) wtot[wave] = inc;
    __syncthreads();
    unsigned wpre = 0;
#pragma unroll
    for (int w = 0; w < 8; ++w) if (w < wave) wpre += wtot[w];
    const unsigned excl = wpre + inc - packed;
    unsigned gt_before = excl & 0xffffu, eq_before = excl >> 16;
#pragma unroll
    for (int k = 0; k < 16; ++k) {
        const int t = tid * 16 + k;
        const bool isgt = v[k] > T, iseq = v[k] == T;
        const bool sel = isgt || (iseq && eq_before < need_eq);
        const unsigned c = gt_before + (eq_before < need_eq ? eq_before : need_eq);
        if (sel) { idx[c] = t; gatev[c] = __builtin_bit_cast(float, v[k]); }
        slot[(size_t)t * 16] = sel ? (int)c : -1;
        gt_before += isgt ? 1u : 0u; eq_before += iseq ? 1u : 0u;
    }
    __syncthreads();
}

#ifndef PH_MASK
#define PH_MASK 0xFFFFF
#endif
#define PH_ON(c) (((PH_MASK) >> (c)) & 1)
#ifndef REP_MASK
#define REP_MASK 0
#endif
#define PH_REP(c) for (int rep_ = 0; rep_ < 1 + (((REP_MASK) >> (c)) & 1); ++rep_)
#define PHASE_TID() int tid = threadIdx.x; asm volatile("" : "+v"(tid)); const int lane = tid & 63, wave = __builtin_amdgcn_readfirstlane(tid >> 6); const int gw = blockIdx.x * 8 + wave, NGW = G * 8; (void)lane; (void)gw; (void)NGW
constexpr int N_PHASES = 16;
__global__ void __launch_bounds__(512, 2) mega(Params p) {
    extern __shared__ __attribute__((aligned(16))) unsigned char lds_raw[];
    LAS unsigned char* lds = (LAS unsigned char*)lds_raw;
    const int G = gridDim.x;
    volatile LAS unsigned* MISC = (volatile LAS unsigned*)(lds + MISC_OFF);
    if (threadIdx.x < 32) MISC[threadIdx.x] = 0u;
    __syncthreads();
    const int lo = p.ph_lo, hi = p.ph_hi;
    XcdBarrier bar = xcd_barrier_post((unsigned*)(KWS() + WS_CTL) + CW_BAR + p.li * XCD_BAR_WORDS, MISC + 8);
#define IN(k) (lo <= (k) && (k) < hi)
#define SEAM(k) do { if (IN(k) && IN((k) + 1)) xcd_barrier(bar); } while (0)

    if (PH_ON(0) && IN(0)) PH_REP(0) { PHASE_TID(); phase_prep(lds, tid); }
    SEAM(0);

    if (PH_ON(1) && IN(1)) PH_REP(1) {
        unsigned char* ws = KWS();
        pg8::Gemm g{(const bf16*)(ws + WS_XN), (const bf16*)(ws + WS_WIN), TALL, 6656, DM}; pg8::StaticOrder S; S.init(TALL, 6656, G, (int)blockIdx.x);
        EpiInProj E{KIN(I_B_IN), (bf16*)(ws + WS_XR), (bf16*)(ws + WS_GGR), (bf16*)(ws + WS_QKV), (bf16*)(ws + WS_SGA), (bf16*)(ws + WS_SGB), (const float*)(ws + WS_COS), (const float*)(ws + WS_SIN), 0};
        pg8::gemm_phase<EpiInProj, pg8::StaticOrder, true, true>(lds, g, S, E);
    }
    SEAM(1);

    if (PH_ON(2) && IN(2)) PH_REP(2) { PHASE_TID();
        unsigned char* ws = KWS();
        volatile LAS unsigned* ctl = (volatile LAS unsigned*)(lds + RNN_CTL_OFF);
        if (tid < 16) ctl[tid * 16] = 0u;
        __syncthreads();
        {
            const int vcu = (G % 8 == 0) ? (int)(blockIdx.x % 8) * (G / 8) + (int)blockIdx.x / 8 : (int)blockIdx.x;
            const int ud = wave & 3, pr = ud >> 1, dir = ud & 1, role = wave >> 2;
            LAS unsigned char* ring = lds + ud * RNN_RING_BYTES; LAS unsigned char* queue = lds + RNN_Q_OFF + ud * RNN_Q_BYTES;
            volatile LAS unsigned* head = ctl + (ud * 2 + 0) * 16; volatile LAS unsigned* tail = ctl + (ud * 2 + 1) * 16;
            volatile LAS unsigned* myflag = ctl + (8 + pr * 2 + dir) * 16; volatile LAS unsigned* otherflag = ctl + (8 + pr * 2 + (dir ^ 1)) * 16;
            const int unit = vcu * 2 + pr;
            if (unit < 512) {
                if (role == 0) rnn_producer(ring, queue, head, tail, unit, dir, (const bf16*)(ws + WS_XR), (const v4u*)(ws + WS_RGWF), (const float*)(ws + WS_RGBIAS), lane);
                else rnn_consumer(queue, head, tail, myflag, otherflag, 1u, unit, dir, (const bf16*)(ws + WS_GGR),
                                  (rep_ == 0 && ((REP_MASK >> 2) & 1)) ? (bf16*)KOUT() + (size_t)TALL * DM : (bf16*)(ws + WS_GGR), (unsigned long long*)KOUT(), lane);
            }
        }
        __syncthreads();
    }
    SEAM(2);

    if (PH_ON(3) && IN(3)) PH_REP(3) { PHASE_TID();
        unsigned char* ws = KWS();
        phase_attn((const bf16*)(ws + WS_QKV), (bf16*)KOUT(), (float*)(ws + WS_LSE), lds, tid, G);
    }
    SEAM(3);

    if (PH_ON(4) && IN(4)) PH_REP(4) { PHASE_TID();
        unsigned char* ws = KWS();
        const bf16* og = (const bf16*)KOUT(); const float* lse = (const float*)(ws + WS_LSE); bf16* yatt = (bf16*)KOUT() + (size_t)3 * TALL * 512;
        for (int t = gw; t < TALL; t += NGW) {
            const int h = lane >> 4, d0 = (lane & 15) * 8;
            const float l0 = lse[(size_t)t * 4 + h], l1 = lse[(size_t)TALL * 4 + (size_t)t * 4 + h], l2 = lse[(size_t)TALL * 8 + (size_t)t * 4 + h];
            const float m = fmaxf(l0, fmaxf(l1, l2)); const float e0 = __expf(l0 - m), e1 = __expf(l1 - m), e2 = __expf(l2 - m); const float inv = 1.0f / (e0 + e1 + e2);
            const float w0 = e0 * inv, w1 = e1 * inv, w2 = e2 * inv;
            const size_t o = (size_t)t * 512 + h * 128 + d0;
            const v4u a = *(const v4u*)(og + o), b = *(const v4u*)(og + (size_t)TALL * 512 + o), c = *(const v4u*)(og + (size_t)TALL * 1024 + o);
            v4u r;
            r.x = pk2(w0 * bflo(a.x) + w1 * bflo(b.x) + w2 * bflo(c.x), w0 * bfhi(a.x) + w1 * bfhi(b.x) + w2 * bfhi(c.x));
            r.y = pk2(w0 * bflo(a.y) + w1 * bflo(b.y) + w2 * bflo(c.y), w0 * bfhi(a.y) + w1 * bfhi(b.y) + w2 * bfhi(c.y));
            r.z = pk2(w0 * bflo(a.z) + w1 * bflo(b.z) + w2 * bflo(c.z), w0 * bfhi(a.z) + w1 * bfhi(b.z) + w2 * bfhi(c.z));
            r.w = pk2(w0 * bflo(a.w) + w1 * bflo(b.w) + w2 * bflo(c.w), w0 * bfhi(a.w) + w1 * bfhi(b.w) + w2 * bfhi(c.w));
            *(v4u*)(yatt + o) = r;
        }
    }

    if (PH_ON(5) && IN(5)) PH_REP(5) {
        unsigned char* ws = KWS();
        pg8::Gemm g{(const bf16*)(ws + WS_XN), (const bf16*)(ws + WS_WIN) + (size_t)6656 * DM, TALL, 2048, DM}; pg8::StaticOrder S; S.init(TALL, 2048, G, (int)blockIdx.x);
        EpiInProj E{KIN(I_B_IN), (bf16*)(ws + WS_XR), (bf16*)(ws + WS_GGR), (bf16*)(ws + WS_QKV), (bf16*)(ws + WS_SGA), (bf16*)(ws + WS_SGB), (const float*)(ws + WS_COS), (const float*)(ws + WS_SIN), 26};
        pg8::gemm_phase<EpiInProj, pg8::StaticOrder, true, true>(lds, g, S, E);
    }
    SEAM(5);

    if (PH_ON(6) && IN(6)) PH_REP(6) {
        unsigned char* ws = KWS();
        pg8::Gemm g{(const bf16*)(ws + WS_GGR), (const bf16*)(ws + WS_PRNN), TALL, DM, DM}; pg8::StaticOrder S; S.init(TALL, DM, G, (int)blockIdx.x);
        EpiGate E{(const bf16*)(ws + WS_SGA), nullptr, (bf16*)(ws + WS_MERGED)};
        pg8::gemm_phase<EpiGate, pg8::StaticOrder, true, true>(lds, g, S, E);
    }
    if (PH_ON(7) && IN(7)) {
        unsigned char* ws = KWS();
        pg8::Gemm g{(const bf16*)KOUT() + (size_t)3 * TALL * 512, (const bf16*)(ws + WS_PATT), TALL, DM, 512}; pg8::StaticOrder S; S.init(TALL, DM, G, (int)blockIdx.x);
        EpiGate E{(const bf16*)(ws + WS_SGB), (const bf16*)(ws + WS_MERGED), (bf16*)(ws + WS_MERGED)};
        pg8::gemm_phase<EpiGate, pg8::StaticOrder, true, true>(lds, g, S, E);
    }
    SEAM(7);
    if (PH_ON(8) && IN(8)) PH_REP(8) {
        unsigned char* ws = KWS();
        pg8::Gemm g{(const bf16*)(ws + WS_MERGED), (const bf16*)(ws + WS_WOUT), TALL, DM, DM}; pg8::StaticOrder S; S.init(TALL, DM, G, (int)blockIdx.x);
        EpiResid E{KIN(I_X), KOUT()};
        pg8::gemm_phase<EpiResid, pg8::StaticOrder, true, true>(lds, g, S, E);
    }
    SEAM(8);

    if (PH_ON(9) && IN(9)) PH_REP(9) { PHASE_TID();
        unsigned char* ws = KWS();
        LAS float* scr = (LAS float*)(lds + wave * 16384);
        constexpr int I_E = 16 * 1024;
        { const float* wg = KIN(I_W_GATE); const float* wu = KIN(I_W_UP); const float* wd = KIN(I_W_DOWN);
        for (int it = gw; it < 3 * I_E; it += NGW) {
            int r = it;
            if (r < 2 * I_E) { const int up = r >= I_E; r -= up * I_E; const int e = r >> 10, rr2 = r & 1023, kb = rr2 >> 6, nb = rr2 & 63, n0 = nb * 32;
                tr_item((up ? wu : wg) + (size_t)e * DM * DFF, DFF, kb * 64, n0, (bf16*)(ws + WS_WGU), (size_t)e * 4096 + (n0 >> 7) * 256 + (n0 & 127) + up * 128, 1024, scr, lane); continue; }
            r -= 2 * I_E;
            { const int e = r >> 10, rr2 = r & 1023, kb = rr2 >> 5, nb = rr2 & 31, n0 = nb * 32;
              tr_item(wd + (size_t)e * DFF * DM, DM, kb * 64, n0, (bf16*)(ws + WS_WD), (size_t)e * 1024 + n0, 2048, scr, lane); }
        } }
        __syncthreads();
        LAS float* wrT = (LAS float*)lds;
        { const float* wrt = KIN(I_W_ROUTER);
          for (int i = tid; i < DM * NEXP; i += 512) { const int d = i >> 4, e = i & 15; wrT[e * 1024 + d] = wrt[i]; } }
        __syncthreads();
        const float* x2 = KOUT(); const float* nffn = KIN(I_NORM_FFN); const float* brt = KIN(I_B_ROUTER);
        for (int m = gw; m < TALL; m += NGW) {
            f32x4 o[4]; rms_row(x2 + (size_t)m * DM, nffn, lane, o); store_row_bf16((bf16*)(ws + WS_H2) + (size_t)m * DM, lane, o);
            float mine = -3.0e38f;
#pragma unroll 2
            for (int e = 0; e < 16; ++e) { float s = 0.f;
#pragma unroll
                for (int j = 0; j < 4; ++j) { const f32x4 w = *(const LAS f32x4*)(wrT + e * 1024 + j * 256 + 4 * lane); s += (o[j].x * w.x + o[j].y * w.y) + (o[j].z * w.z + o[j].w * w.w); }
                const float tot = wave_sum(s) + brt[e]; mine = (lane == e) ? tot : mine; }
            float mx = mine;
#pragma unroll
            for (int of = 1; of < 16; of <<= 1) mx = fmaxf(mx, __shfl_xor(mx, of));
            const float ex = expf(mine - mx); float den = ex;
#pragma unroll
            for (int of = 1; of < 16; of <<= 1) den += __shfl_xor(den, of);
            const int b = m >> 13, s = m & (SEQ - 1);
            if (lane < 16) ((float*)(ws + WS_AFF))[((size_t)(b * 16 + lane)) * SEQ + s] = ex / den;
        }
        __syncthreads();
    }
    SEAM(9);

    if (PH_ON(10) && IN(10)) PH_REP(10) { PHASE_TID();
        unsigned char* ws = KWS();
        for (int unit = blockIdx.x; unit < BATCH * NEXP; unit += G) { const int b = unit >> 4, e = unit & 15;
            topk_unit((const float*)(ws + WS_AFF) + (size_t)unit * SEQ, (int*)(ws + WS_IDX) + unit * CAP, (float*)(ws + WS_GATEV) + unit * CAP, (int*)(ws + WS_SLOT) + (size_t)b * SEQ * 16 + e, lds, tid); }
    }
    SEAM(10);

    for (int half = 0; half < 2; ++half) {
        const int pb0 = 11 + 2 * half;
        if (PH_ON(12) && IN(pb0 + 0)) PH_REP(12) {
            unsigned char* ws = KWS();
            pg8::Gemm g{(const bf16*)(ws + WS_H2), (const bf16*)(ws + WS_WGU), 65536, 65536, DM, (const int*)(ws + WS_IDX) + half * 65536, half * 4 * SEQ}; MoeOrder S{G, (int)blockIdx.x, 16, 4096};
            EpiSwiglu E{(bf16*)(ws + WS_HID)};
            pg8::gemm_phase<EpiSwiglu, MoeOrder, true, true, true>(lds, g, S, E);
        }
        SEAM(pb0 + 0);
        if (PH_ON(13) && IN(pb0 + 1)) PH_REP(13) {
            unsigned char* ws = KWS();
            pg8::Gemm g{(const bf16*)(ws + WS_HID), (const bf16*)(ws + WS_WD), 65536, 16384, DFF}; MoeOrder S{G, (int)blockIdx.x, 4, 1024};
            EpiDown E{(bf16*)(ws + WS_EO) + (size_t)half * 65536 * DM, (const float*)(ws + WS_GATEV) + half * 65536};
            pg8::gemm_phase<EpiDown, MoeOrder, true, true>(lds, g, S, E);
        }
        SEAM(pb0 + 1);
    }

    if (PH_ON(14) && IN(15)) { PHASE_TID();
        unsigned char* ws = KWS();
        const bf16* eo = (const bf16*)(ws + WS_EO); float* outp = KOUT(); const float* nfin = KIN(I_NORM_FINAL);
        for (int m = gw; m < TALL; m += NGW) {
            const int b = m >> 13;
            float* xrow = outp + (size_t)m * DM;
            f32x4 v[4];
#pragma unroll
            for (int j = 0; j < 4; ++j) v[j] = ((const f32x4*)xrow)[64 * j + lane];
            const int* sl = (const int*)(ws + WS_SLOT) + (size_t)m * 16;
            for (int e = 0; e < 16; ++e) { const int c = sl[e];
                if (c >= 0) { const unsigned long long* er = (const unsigned long long*)(eo + ((size_t)(b * 16 + e) * CAP + c) * DM) + lane;
#pragma unroll
                    for (int j = 0; j < 4; ++j) { const unsigned long long w = er[64 * j]; const unsigned w0 = (unsigned)w, w1 = (unsigned)(w >> 32);
                        v[j].x += bflo(w0); v[j].y += bfhi(w0); v[j].z += bflo(w1); v[j].w += bfhi(w1); } } }
            float s = 0.f;
#pragma unroll
            for (int j = 0; j < 4; ++j) s += (v[j].x * v[j].x + v[j].y * v[j].y) + (v[j].z * v[j].z + v[j].w * v[j].w);
            const float rstd = 1.0f / sqrtf(wave_sum(s) * (1.0f / DM) + RMS_EPS);
#pragma unroll
            for (int j = 0; j < 4; ++j) { const f32x4 g = ((const f32x4*)nfin)[64 * j + lane]; ((f32x4*)xrow)[64 * j + lane] = v[j] * rstd * g; }
        }
    }
#undef IN
#undef SEAM
}

#ifndef MK_SPLIT
#define MK_SPLIT 0
#endif
extern "C" void kernel_launch(void* const* d_in, const int* in_sizes, int n_in, void* d_out, int out_size, void* d_ws, size_t ws_size, hipStream_t stream) {
    static int grid = 0;
    if (grid == 0) {
        if (n_in != 19 || out_size != TALL * DM || ws_size < WS_END) { fprintf(stderr, "kernel_launch: unexpected shapes (n_in %d out %d ws %zu)\n", n_in, out_size, ws_size); grid = -1; return; }
        int dev = 0, cus = 0, per_cu = 0;
        if (hipGetDevice(&dev) != hipSuccess || hipDeviceGetAttribute(&cus, hipDeviceAttributeMultiprocessorCount, dev) != hipSuccess) { grid = -1; return; }
        if (hipFuncSetAttribute((const void*)mega, hipFuncAttributeMaxDynamicSharedMemorySize, LDS_BYTES) != hipSuccess) { fprintf(stderr, "kernel_launch: hipFuncSetAttribute failed\n"); grid = -1; return; }
        if (hipOccupancyMaxActiveBlocksPerMultiprocessor(&per_cu, (const void*)mega, 512, LDS_BYTES) != hipSuccess || per_cu < 1) { fprintf(stderr, "kernel_launch: occupancy query says %d\n", per_cu); }
        (void)hipGetLastError();
        grid = cus;
    }
    if (grid < 0) return;
    (void)hipMemsetAsync((char*)d_ws + WS_CTL, 0, CTL_ZERO_BYTES, stream);
    Params p{};
    for (int i = 0; i < 19; ++i) p.in[i] = (const float*)d_in[i];
    p.out = (float*)d_out; p.ws = (unsigned char*)d_ws;
#if MK_SPLIT
    for (int k = 0; k < N_PHASES; ++k) { p.ph_lo = k; p.ph_hi = k + 1; p.li = 0; hipLaunchKernelGGL(mega, dim3(grid), dim3(512), LDS_BYTES, stream, p); }
#else
    p.ph_lo = 0; p.ph_hi = N_PHASES; p.li = 0;
    hipLaunchKernelGGL(mega, dim3(grid), dim3(512), LDS_BYTES, stream, p);
#endif
}
```
